# Optimizing an MI355X kernel written in HIP

```python
import math
import jax, jax.numpy as jnp
from jax import lax
import numpy as np

D_MODEL = 1024
BATCH = 8
SEQ = 4096
DEPTH = 2

D_MIX = D_MODEL
D_S5 = D_MIX // 2
S5_GROUP = 16
S5_GROUPS = D_S5 // S5_GROUP
S5_STATE = 64
D_GLA = D_MIX - D_S5
GLA_HEADS = 4
GLA_DV = D_GLA // GLA_HEADS
GLA_DK = GLA_DV // 2
D_GLA_K = GLA_HEADS * GLA_DK
GLA_GATE_RANK = 16
GLA_TAU = 16.0
GLA_CHUNK = 64
D_IN = D_S5 + 2 * D_GLA_K + 2 * D_GLA + GLA_GATE_RANK
SPLITS = (D_S5, D_S5 + D_GLA_K, D_S5 + 2 * D_GLA_K, D_S5 + 2 * D_GLA_K + D_GLA,
          D_S5 + 2 * D_GLA_K + 2 * D_GLA)
D_FF = 2816
N_EXPERTS = 8
TOP_K = 2
D_FF_EXPERT = 3584
N_DENSE = (DEPTH + 1) // 2
N_MOE = DEPTH // 2
EPS = 1e-6
DT_MIN = 1e-3
DT_MAX = 1e-1

kernel_name = "hymba_s5_gla_moe_trunk"


def rms_norm(x, g):
    xf = x.astype(jnp.float32)
    y = xf * lax.rsqrt(jnp.mean(xf * xf, axis=-1, keepdims=True) + EPS)
    return (y * g.astype(jnp.float32)).astype(x.dtype)


def swiglu(h, w_gate, w_up, w_down):
    return (jax.nn.silu(h @ w_gate) * (h @ w_up)) @ w_down


def s5_mixer(u, lam_re, lam_im, log_dt, b_re, b_im, c_re, c_im, d_skip, w_glu, b_glu):
    f32 = jnp.float32
    bsz, seq, _ = u.shape
    uf = u.astype(f32).reshape(bsz, seq, S5_GROUPS, S5_GROUP)
    lr = jnp.minimum(lam_re.astype(f32), -1e-4)
    li = lam_im.astype(f32)
    dt = jnp.exp(log_dt.astype(f32))[:, None]
    mag = jnp.exp(lr * dt)
    ab_re = mag * jnp.cos(li * dt)
    ab_im = mag * jnp.sin(li * dt)
    nr = ab_re - 1.0
    ni = ab_im
    den = lr * lr + li * li
    f_re = (nr * lr + ni * li) / den
    f_im = (ni * lr - nr * li) / den
    br = b_re.astype(f32)
    bi = b_im.astype(f32)
    bb_re = f_re[..., None] * br - f_im[..., None] * bi
    bb_im = f_re[..., None] * bi + f_im[..., None] * br
    bu_re = jnp.einsum('blgc,gpc->blgp', uf, bb_re)
    bu_im = jnp.einsum('blgc,gpc->blgp', uf, bb_im)
    a_re = jnp.broadcast_to(ab_re, bu_re.shape)
    a_im = jnp.broadcast_to(ab_im, bu_im.shape)

    def combine(e1, e2):
        a1r, a1i, b1r, b1i = e1
        a2r, a2i, b2r, b2i = e2
        return (a1r * a2r - a1i * a2i,
                a1r * a2i + a1i * a2r,
                a2r * b1r - a2i * b1i + b2r,
                a2r * b1i + a2i * b1r + b2i)

    _, _, h_re, h_im = lax.associative_scan(combine, (a_re, a_im, bu_re, bu_im), axis=1)
    y = (jnp.einsum('blgp,gcp->blgc', h_re, c_re.astype(f32))
         - jnp.einsum('blgp,gcp->blgc', h_im, c_im.astype(f32)))
    y = y + d_skip.astype(f32).reshape(S5_GROUPS, S5_GROUP) * uf
    y = jax.nn.gelu(y.reshape(bsz, seq, D_S5))
    y = y * jax.nn.sigmoid(y @ w_glu.astype(f32) + b_glu.astype(f32))
    return y


def gla_mixer(q, k, v, r, g_low, w_a2, b_a2, g_norm):
    f32 = jnp.float32
    bsz, seq, _ = q.shape
    n_chunks = seq // GLA_CHUNK
    c = GLA_CHUNK

    def heads(t, dh):
        return t.astype(f32).reshape(bsz, n_chunks, c, GLA_HEADS, dh).transpose(0, 3, 1, 2, 4)

    qh = heads(q, GLA_DK) * (GLA_DK ** -0.5)
    kh = heads(k, GLA_DK)
    vh = heads(v, GLA_DV)
    log_a = jax.nn.log_sigmoid(g_low.astype(f32) @ w_a2.astype(f32) + b_a2.astype(f32)) / GLA_TAU
    cum = jnp.cumsum(heads(log_a, GLA_DK), axis=3)
    cum_last = cum[..., -1:, :]
    q_t = qh * jnp.exp(cum)
    k_t = kh * jnp.exp(-cum)
    k_end = kh * jnp.exp(cum_last - cum)
    causal = jnp.tril(jnp.ones((c, c), dtype=bool))
    scores = jnp.where(causal, jnp.einsum('bhnik,bhnjk->bhnij', q_t, k_t), 0.0)
    o_intra = jnp.einsum('bhnij,bhnjv->bhniv', scores, vh)
    upd = jnp.einsum('bhnjk,bhnjv->bhnkv', k_end, vh)
    decay = jnp.exp(cum_last[..., 0, :])

    def step(state, inp):
        dec, u = inp
        return dec[..., None] * state + u, state

    s0 = jnp.zeros((bsz, GLA_HEADS, GLA_DK, GLA_DV), f32)
    _, s_prev = lax.scan(step, s0, (jnp.moveaxis(decay, 2, 0), jnp.moveaxis(upd, 2, 0)))
    s_prev = jnp.moveaxis(s_prev, 0, 2)
    o = o_intra + jnp.einsum('bhnik,bhnkv->bhniv', q_t, s_prev)
    o = o * lax.rsqrt(jnp.mean(o * o, axis=-1, keepdims=True) + EPS)
    o = o.transpose(0, 2, 3, 1, 4).reshape(bsz, seq, D_GLA) * g_norm.astype(f32)
    return o * jax.nn.silu(r.astype(f32))


def moe_swiglu(h, w_router, w_gate, w_up, w_down):
    f32 = jnp.float32
    logits = h.astype(f32) @ w_router.astype(f32)
    top_v, top_i = lax.top_k(logits, TOP_K)
    wts = jax.nn.softmax(top_v, axis=-1)
    gates = jnp.sum(jax.nn.one_hot(top_i, N_EXPERTS, dtype=f32) * wts[..., None], axis=-2)
    out = jnp.zeros(h.shape, f32)
    for e in range(N_EXPERTS):
        out = out + gates[..., e:e + 1] * swiglu(h, w_gate[e], w_up[e], w_down[e]).astype(f32)
    return out


def setup_inputs(seed: int = 0) -> dict:
    key = jax.random.key(seed)
    ks = jax.random.split(key, 32)
    f32 = jnp.float32

    def nrm(k, shape, scale):
        return jax.random.normal(k, shape, f32) * scale

    n_idx = jnp.arange(S5_STATE, dtype=f32)
    return {
        "x": nrm(ks[0], (BATCH, SEQ, D_MODEL), 1.0),
        "norm_mix": 1.0 + nrm(ks[1], (DEPTH, D_MODEL), 0.02),
        "w_in": nrm(ks[2], (DEPTH, D_MODEL, D_IN), D_MODEL ** -0.5),
        "s5_lambda_re": -0.5 + nrm(ks[3], (DEPTH, S5_GROUPS, S5_STATE), 0.01),
        "s5_lambda_im": math.pi * n_idx + nrm(ks[4], (DEPTH, S5_GROUPS, S5_STATE), 0.01),
        "s5_log_dt": jax.random.uniform(ks[5], (DEPTH, S5_GROUPS), f32,
                                        minval=math.log(DT_MIN), maxval=math.log(DT_MAX)),
        "s5_b_re": nrm(ks[6], (DEPTH, S5_GROUPS, S5_STATE, S5_GROUP), (2 * S5_GROUP) ** -0.5),
        "s5_b_im": nrm(ks[7], (DEPTH, S5_GROUPS, S5_STATE, S5_GROUP), (2 * S5_GROUP) ** -0.5),
        "s5_c_re": nrm(ks[8], (DEPTH, S5_GROUPS, S5_GROUP, S5_STATE), S5_STATE ** -0.5),
        "s5_c_im": nrm(ks[9], (DEPTH, S5_GROUPS, S5_GROUP, S5_STATE), S5_STATE ** -0.5),
        "s5_d": nrm(ks[10], (DEPTH, D_S5), 1.0),
        "s5_w_glu": nrm(ks[11], (DEPTH, D_S5, D_S5), D_S5 ** -0.5),
        "s5_b_glu": nrm(ks[12], (DEPTH, D_S5), 0.02),
        "s5_out_norm": 1.0 + nrm(ks[13], (DEPTH, D_S5), 0.02),
        "gla_w_a2": nrm(ks[14], (DEPTH, GLA_GATE_RANK, D_GLA_K), GLA_GATE_RANK ** -0.5),
        "gla_b_a2": nrm(ks[15], (DEPTH, D_GLA_K), 0.1),
        "gla_out_norm": 1.0 + nrm(ks[16], (DEPTH, D_GLA), 0.02),
        "w_out": nrm(ks[17], (DEPTH, D_MIX, D_MODEL), D_MIX ** -0.5),
        "norm_ffn": 1.0 + nrm(ks[18], (DEPTH, D_MODEL), 0.02),
        "ffn_w_gate": nrm(ks[19], (N_DENSE, D_MODEL, D_FF), D_MODEL ** -0.5),
        "ffn_w_up": nrm(ks[20], (N_DENSE, D_MODEL, D_FF), D_MODEL ** -0.5),
        "ffn_w_down": nrm(ks[21], (N_DENSE, D_FF, D_MODEL), D_FF ** -0.5),
        "moe_w_router": nrm(ks[22], (N_MOE, D_MODEL, N_EXPERTS), D_MODEL ** -0.5),
        "moe_w_gate": nrm(ks[23], (N_MOE, N_EXPERTS, D_MODEL, D_FF_EXPERT), D_MODEL ** -0.5),
        "moe_w_up": nrm(ks[24], (N_MOE, N_EXPERTS, D_MODEL, D_FF_EXPERT), D_MODEL ** -0.5),
        "moe_w_down": nrm(ks[25], (N_MOE, N_EXPERTS, D_FF_EXPERT, D_MODEL), D_FF_EXPERT ** -0.5),
        "norm_final": 1.0 + nrm(ks[26], (D_MODEL,), 0.02),
    }


def reference(x, norm_mix, w_in, s5_lambda_re, s5_lambda_im, s5_log_dt, s5_b_re, s5_b_im,
              s5_c_re, s5_c_im, s5_d, s5_w_glu, s5_b_glu, s5_out_norm, gla_w_a2, gla_b_a2,
              gla_out_norm, w_out, norm_ffn, ffn_w_gate, ffn_w_up, ffn_w_down, moe_w_router,
              moe_w_gate, moe_w_up, moe_w_down, norm_final):
    for l in range(DEPTH):
        h = rms_norm(x, norm_mix[l])
        proj = h @ w_in[l]
        u, q, k, v, r, g_low = jnp.split(proj, SPLITS, axis=-1)
        y_s5 = s5_mixer(u, s5_lambda_re[l], s5_lambda_im[l], s5_log_dt[l], s5_b_re[l],
                        s5_b_im[l], s5_c_re[l], s5_c_im[l], s5_d[l], s5_w_glu[l], s5_b_glu[l])
        y_s5 = rms_norm(y_s5, s5_out_norm[l])
        y_gla = gla_mixer(q, k, v, r, g_low, gla_w_a2[l], gla_b_a2[l], gla_out_norm[l])
        mixed = jnp.concatenate([y_s5, y_gla], axis=-1).astype(x.dtype)
        x = x + mixed @ w_out[l]
        h = rms_norm(x, norm_ffn[l])
        i = l // 2
        if l % 2 == 0:
            x = x + swiglu(h, ffn_w_gate[i], ffn_w_up[i], ffn_w_down[i]).astype(x.dtype)
        else:
            x = x + moe_swiglu(h, moe_w_router[i], moe_w_gate[i], moe_w_up[i],
                               moe_w_down[i]).astype(x.dtype)
    return rms_norm(x, norm_final)
```

```cpp
#include <hip/hip_runtime.h>
#include <cstdio>
#include <cstdint>

#ifndef USE_F8_FFN
#define USE_F8_FFN 0
#endif
#ifndef USE_F8_MOE
#define USE_F8_MOE 1
#endif
#ifndef MK_N_LAUNCHES
#define MK_N_LAUNCHES 1
#endif

#define LAS __attribute__((address_space(3)))
#define GAS __attribute__((address_space(1)))
typedef unsigned short bf16;
typedef short bf16x8 __attribute__((ext_vector_type(8)));
typedef short s16x4 __attribute__((ext_vector_type(4)));
typedef short v4i16_t __attribute__((ext_vector_type(4)));
typedef float f32x4 __attribute__((ext_vector_type(4)));
typedef float f32x2 __attribute__((ext_vector_type(2)));
typedef unsigned u32x4 __attribute__((ext_vector_type(4)));
typedef unsigned u32x2 __attribute__((ext_vector_type(2)));
typedef int i32x4_t __attribute__((ext_vector_type(4)));

constexpr int BATCH = 8, SEQ = 4096, D = 1024, M = BATCH * SEQ;
constexpr int DS5 = 512, NGRP = 32, NST = 64;
constexpr int GH = 4, DK = 64, DV = 128, DGK = 256, DGV = 512, NCH = SEQ / 64;
constexpr int DIN = 2064, NPROJ = 2304;
constexpr int DFF = 2816, NE = 8, DFE = 3584;
constexpr float EPS = 1e-6f;
constexpr int NPHASE = 20;

constexpr size_t MiB = 1u << 20;
constexpr size_t WS_CTL = 0, CTL_ZERO_BYTES = 2 * MiB;
constexpr size_t WS_SSP = 2 * MiB;
constexpr size_t WS_WIN = 4 * MiB;
constexpr size_t WS_WGLU = 13 * MiB;
constexpr size_t WS_WOUT = 14 * MiB;
constexpr size_t WS_WFGU = 18 * MiB;
constexpr size_t WS_WFD = 29 * MiB;
constexpr size_t WS_S5P = 35 * MiB;
constexpr size_t WS_S5MQ = 39 * MiB;
constexpr size_t WS_S5A16 = 51 * MiB;
constexpr size_t WS_WGT = 51 * MiB + 65536;
constexpr size_t WS_WA2T = 51 * MiB + 131072;
constexpr size_t WS_MGU = 52 * MiB;
constexpr size_t WS_MD = (USE_F8_MOE ? 108 : 164) * MiB;
constexpr size_t WS_X8 = (USE_F8_MOE ? 136 : 500) * MiB;
static_assert(USE_F8_MOE || !USE_F8_FFN, "x8 lives in the space the fp8 expert weights leave free");
constexpr size_t WS_XB = 220 * MiB;
constexpr size_t WS_ACT = 284 * MiB;
constexpr size_t WS_UGM = WS_ACT;
constexpr size_t WS_Q = WS_ACT + 32 * MiB;
constexpr size_t WS_K = WS_ACT + 48 * MiB;
constexpr size_t WS_V = WS_ACT + 64 * MiB;
constexpr size_t WS_R = WS_ACT + 96 * MiB;
constexpr size_t WS_GL = WS_ACT + 128 * MiB;
constexpr size_t WS_MIXED = WS_ACT + 144 * MiB;
constexpr size_t WS_HD = WS_ACT;
constexpr size_t WS_H1 = WS_ACT;
constexpr size_t WS_XO = WS_ACT + 120 * MiB;
constexpr size_t WS_TOK = WS_ACT + 184 * MiB;
constexpr size_t WS_WL = WS_ACT + 186 * MiB;
constexpr size_t WS_RL = WS_ACT + 188 * MiB;
constexpr size_t WS_DEC = WS_ACT + 208 * MiB;
constexpr size_t WS_END = WS_ACT + 209 * MiB;
constexpr size_t DO_UT = 0, DO_ST = 64 * MiB, DO_YS5 = 96 * MiB;
constexpr int MOE_CAP_TILES = 68;
constexpr int CW_BAR = 4096;
constexpr int CW_CNT = 16384;

constexpr int RING_BYTES = 131072;
constexpr int MOE_TAB_OFF = 131072;
constexpr int MISC_OFF = 147456;
constexpr int LDS_BYTES = 148480;
constexpr int WAVE_LDS = 18432;

#define LDS_WAIT() asm volatile("s_waitcnt lgkmcnt(0)" ::: "memory")
#define VM_WAIT() asm volatile("s_waitcnt vmcnt(0)" ::: "memory")
#define CFENCE() asm volatile("" ::: "memory")
__device__ __forceinline__ unsigned f2bf(float f) { unsigned u = __builtin_bit_cast(unsigned, f); return (u + 0x7fffu + ((u >> 16) & 1u)) >> 16; }
__device__ __forceinline__ unsigned pk2(float lo, float hi) { return f2bf(lo) | (f2bf(hi) << 16); }
__device__ __forceinline__ float bf2f(unsigned b) { return __builtin_bit_cast(float, b << 16); }
__device__ __forceinline__ float bflo(unsigned w) { return __builtin_bit_cast(float, w << 16); }
__device__ __forceinline__ float bfhi(unsigned w) { return __builtin_bit_cast(float, w & 0xffff0000u); }
typedef __bf16 bf16x2_t __attribute__((ext_vector_type(2)));
__device__ __forceinline__ unsigned cvt_pk_bf16(float lo, float hi) { const f32x2 v = {lo, hi}; return __builtin_bit_cast(unsigned, __builtin_convertvector(v, bf16x2_t)); }
__device__ __forceinline__ unsigned pk4_fp8(float a, float b, float c, float d) {
    a = __builtin_amdgcn_fmed3f(a, -448.f, 448.f); b = __builtin_amdgcn_fmed3f(b, -448.f, 448.f); c = __builtin_amdgcn_fmed3f(c, -448.f, 448.f); d = __builtin_amdgcn_fmed3f(d, -448.f, 448.f);
    int w = 0; w = __builtin_amdgcn_cvt_pk_fp8_f32(a, b, w, false); w = __builtin_amdgcn_cvt_pk_fp8_f32(c, d, w, true); return (unsigned)w;
}
__device__ __forceinline__ f32x2 swiglu2(f32x2 g, f32x2 u, float nrs, float c) {
    const f32x2 t = g * nrs;
    f32x2 d = {__builtin_amdgcn_exp2f(t[0]), __builtin_amdgcn_exp2f(t[1])};
    d = d + 1.0f;
    const f32x2 r = {__builtin_amdgcn_rcpf(d[0]), __builtin_amdgcn_rcpf(d[1])};
    return (g * u) * (r * c);
}
constexpr float F8_SW_UP = 64.f, F8_SH = 4.f, F8_SW_DN = 128.f;
__device__ __forceinline__ float wave_sum(float v) {
#pragma unroll
    for (int o = 1; o < 64; o <<= 1) v += __shfl_xor(v, o);
    return v;
}
__device__ __forceinline__ float sigmoidf_(float z) { return __builtin_amdgcn_rcpf(1.0f + __expf(-z)); }
__device__ __forceinline__ float siluf_(float z) { return z * __builtin_amdgcn_rcpf(1.0f + __expf(-z)); }
__device__ __forceinline__ float gelu_tanh(float y) { const float z = 0.7978845608028654f * (y + 0.044715f * y * y * y); return y * __builtin_amdgcn_rcpf(1.0f + __expf(-2.0f * z)); }

#define XB_TMO      128
#define XB_XCNT(j)  (256  + 64 * (j))
#define XB_XSUB(j)  (1280 + 64 * (j))
#define XB_XGEN(j)  (2304 + 64 * (j))
#define XB_TOP      3328
#define XB_TOPGEN   3392
#define XCD_BAR_WORDS 3456
#define XB_SPIN_CAP (1u << 18)
__device__ __forceinline__ unsigned xb_ld(unsigned* p)              { return __hip_atomic_load(p, __ATOMIC_RELAXED, __HIP_MEMORY_SCOPE_AGENT); }
__device__ __forceinline__ unsigned xb_add(unsigned* p, unsigned v) { return __hip_atomic_fetch_add(p, v, __ATOMIC_RELAXED, __HIP_MEMORY_SCOPE_AGENT); }
__device__ __forceinline__ unsigned xb_xcc_id() { return (unsigned)__builtin_amdgcn_s_getreg((3 << 11) | 20) & 0xFu; }
#define XB_SPIN(cond, bar) do { unsigned _sp = 0; while (cond) { __builtin_amdgcn_s_sleep(1); \
    if ((++_sp & 255u) == 0u) { if (xb_ld(&(bar)[XB_TMO])) break; if (_sp > XB_SPIN_CAP) { atomicAdd(&(bar)[XB_TMO], 1u); break; } } } } while (0)
struct XcdBarrier { unsigned* bar; unsigned x; volatile LAS unsigned* st; };
__device__ __forceinline__ XcdBarrier xcd_barrier_post(unsigned* bar, volatile LAS unsigned* st) {
    XcdBarrier b; b.bar = bar; b.x = xb_xcc_id(); b.st = st;
    if (threadIdx.x == 0) (void)xb_add(&bar[XB_XCNT(b.x)], 1u);
    return b;
}
__device__ __forceinline__ void xcd_barrier_complete(unsigned* bar, unsigned x, unsigned& nloc, unsigned& nx) {
    const unsigned G = gridDim.x * gridDim.y * gridDim.z;
    unsigned sum, cnt, mine, sp = 0u;
    for (;;) {
        sum = 0u; cnt = 0u; mine = 0u;
#pragma unroll
        for (unsigned j = 0; j < 16; ++j) { const unsigned c = xb_ld(&bar[XB_XCNT(j)]); sum += c; cnt += (c > 0u) ? 1u : 0u; mine = (j == x) ? c : mine; }
        if (sum == G) break;
        __builtin_amdgcn_s_sleep(1);
        if ((++sp & 255u) == 0u) { if (xb_ld(&bar[XB_TMO])) break; if (sp > XB_SPIN_CAP) { atomicAdd(&bar[XB_TMO], 1u); break; } }
    }
    nloc = mine > 0u ? mine : 1u; nx = cnt > 0u ? cnt : 1u;
}
__device__ __forceinline__ void xcd_barrier(const XcdBarrier& b) {
    asm volatile("s_waitcnt vmcnt(0)" ::: "memory");
    __syncthreads();
    if (threadIdx.x == 0) {
        unsigned* bar = b.bar;
        __builtin_amdgcn_s_waitcnt(0);
        unsigned nloc = b.st[0], nx = b.st[1];
        if (nloc == 0u) { xcd_barrier_complete(bar, b.x, nloc, nx); b.st[0] = nloc; b.st[1] = nx; }
        const unsigned old = xb_add(&bar[XB_XSUB(b.x)], 1u);
        const unsigned gen = old / nloc;
        if (old + 1u == (gen + 1u) * nloc) {
            __builtin_amdgcn_fence(__ATOMIC_RELEASE, "agent");
            asm volatile("s_waitcnt vmcnt(0)" ::: "memory");
            const unsigned og = xb_add(&bar[XB_TOP], 1u);
            const unsigned tg = og / nx;
            if (og + 1u == (tg + 1u) * nx) xb_add(&bar[XB_TOPGEN], 1u);
            else XB_SPIN(xb_ld(&bar[XB_TOPGEN]) == tg, bar);
            __builtin_amdgcn_fence(__ATOMIC_ACQUIRE, "agent");
            xb_add(&bar[XB_XGEN(b.x)], 1u);
            asm volatile("s_waitcnt vmcnt(0)" ::: "memory");
        } else {
            XB_SPIN(xb_ld(&bar[XB_XGEN(b.x)]) == gen, bar);
            __builtin_amdgcn_fence(__ATOMIC_ACQUIRE, "agent");
            asm volatile("s_waitcnt vmcnt(0)" ::: "memory");
        }
    }
    __syncthreads();
}

namespace pg8 {
constexpr int BM = 256, BK = 64, HALF = 128, HTB = HALF * BK * 2, STAGE_BYTES = 8 * HTB, NXCD = 8, WGM = 8;
constexpr int A_TAB_OFF = 131072 + 8192;
constexpr int EPI_TAB_OFF = 131072 + 4096;
__host__ __device__ __forceinline__ int lds_byte(int r, int c) { const int st = (r >> 4) * 2 + (c >> 5), rr = r & 15, cc = c & 31, ob = rr * 64 + cc * 2; return st * 1024 + (ob ^ (((ob >> 9) & 1) << 5)); }
__host__ __device__ __forceinline__ void stage_rc(int b, int& R, int& C) { const int st = b / 1024, sb = b % 1024, swz = sb ^ (((sb >> 9) & 1) << 5); R = (st >> 1) * 16 + swz / 64; C = (st & 1) * 32 + (swz % 64) / 2; }
__host__ __device__ __forceinline__ int perm32(int rho) { const int n = rho >> 4, i = rho & 15; return 8 * (i >> 2) + 4 * n + (i & 3); }

struct Unit { int pm, pn, e, sub; };

struct StaticOrder {
    int nM, nN, nwg, G, c;
    __device__ __forceinline__ void init(int nM_, int nN_, int G_, int c_) { nM = nM_; nN = nN_; nwg = nM * nN; G = G_; c = c_; }
    __device__ __forceinline__ bool next(int i, Unit& u) const {
        const long L = (long)i * G + c; if (L >= nwg) return false;
        int wgid = (int)L; { const int q = nwg / NXCD, r = nwg % NXCD, xcd = wgid % NXCD, off = wgid / NXCD; wgid = (xcd < r ? xcd * (q + 1) : r * (q + 1) + (xcd - r) * q) + off; }
        const int nig = WGM * nN, gid = wgid / nig, fm = gid * WGM, gsz = (nM - fm) < WGM ? (nM - fm) : WGM;
        u.pm = fm + ((wgid % nig) % gsz); u.pn = (wgid % nig) / gsz; u.e = 0; u.sub = 0; return true;
    }
};

template <class Epi, class Sched, class Prob>
__device__ __forceinline__ void gemm_phase(LAS unsigned char* lds, const Prob& P, const Sched& S, const Epi& E) {
    int tid_ = threadIdx.x; asm volatile("" : "+v"(tid_));
    const int tid = tid_, wid = __builtin_amdgcn_readfirstlane(tid >> 6), lane = tid & 63, wr = wid >> 2, wc = wid & 3, fr = lane & 15, fq = lane >> 4;
    const int K = P.K, nt = K / BK;
    int Rr[2], Cc[2]; unsigned voffB[2];
#pragma unroll
    for (int i = 0; i < 2; ++i) { int R, C; stage_rc(tid * 16 + i * 8192, R, C); Rr[i] = R; Cc[i] = C; const int Rb = (R & ~31) + perm32(R & 31); voffB[i] = (unsigned)(Rb * P.ldb + C) * 2u; }
    const size_t kstep = (size_t)(BK * 2);
    const size_t hstepB = (size_t)HALF * P.ldb * 2;
    const unsigned ldsw = (unsigned)wid * 1024u;
    const int aoff = lds_byte(wr * 64 + fr, fq * 8), boff = lds_byte(wc * 32 + fr, fq * 8);
#define PG8_SA(b, h) (((b) * 2 + (h)) * HTB)
#define PG8_SB(b, h) ((4 + (b) * 2 + (h)) * HTB)
#define PG8_STAGE(bufoff, gbase, voff) do { _Pragma("unroll") for (int _i = 0; _i < 2; ++_i) \
        __builtin_amdgcn_global_load_lds((const unsigned*)((const char*)(gbase) + (voff)[_i]), (LAS unsigned*)(lds + (bufoff) + ldsw + _i * 8192), 16, 0, 0); } while (0)
#define PG8_LDA(dst, b, h) do { _Pragma("unroll") for (int m = 0; m < 4; ++m) _Pragma("unroll") for (int k = 0; k < 2; ++k) dst[m][k] = *(const LAS bf16x8*)(lds + PG8_SA(b, h) + aoff + m * 2048 + k * 1024); } while (0)
#define PG8_LDB(dst, b, h) do { _Pragma("unroll") for (int n = 0; n < 2; ++n) _Pragma("unroll") for (int k = 0; k < 2; ++k) dst[n][k] = *(const LAS bf16x8*)(lds + PG8_SB(b, h) + boff + n * 2048 + k * 1024); } while (0)
#define PG8_CAT(x) __builtin_shufflevector(__builtin_bit_cast(i32x4_t, (x)[0]), __builtin_bit_cast(i32x4_t, (x)[1]), 0, 1, 2, 3, 4, 5, 6, 7)
#define PG8_MMA(ai, bj, At, Bt) do { __builtin_amdgcn_s_setprio(1); _Pragma("unroll") for (int m = 0; m < 4; ++m) _Pragma("unroll") for (int n = 0; n < 2; ++n) { \
        if constexpr (Prob::F8) asm volatile("v_mfma_scale_f32_16x16x128_f8f6f4 %0, %1, %2, %0, %3, %3 op_sel_hi:[0,0,0]" : "+v"(acc[ai][bj][m][n]) : "v"(PG8_CAT(Bt[n])), "v"(PG8_CAT(At[m])), "v"(f8one)); \
        else { _Pragma("unroll") for (int k = 0; k < 2; ++k) acc[ai][bj][m][n] = __builtin_amdgcn_mfma_f32_16x16x32_bf16(Bt[n][k], At[m][k], acc[ai][bj][m][n], 0, 0, 0); } } \
        __builtin_amdgcn_s_setprio(0); } while (0)
#define PG8_WAIT_V(n) asm volatile("s_waitcnt vmcnt(" #n ")" ::: "memory")
#define PG8_WAIT_L(n) asm volatile("s_waitcnt lgkmcnt(" #n ")" ::: "memory")
#define PG8_BAR __builtin_amdgcn_s_barrier()
#define PG8_SCHED __builtin_amdgcn_sched_barrier(0)
    const int f8one = 0x7f7f7f7f;
    Unit cur, nxt; int ui = 0;
    if (!S.next(0, cur)) return;
    f32x4 acc[2][2][4][2];
#pragma unroll
    for (int a = 0; a < 2; ++a)
#pragma unroll
        for (int b = 0; b < 2; ++b)
#pragma unroll
            for (int m = 0; m < 4; ++m)
#pragma unroll
                for (int n = 0; n < 2; ++n) acc[a][b][m][n] = (f32x4){0.f, 0.f, 0.f, 0.f};
    bf16x8 At[4][2], B0[2][2], B1[2][2];
    constexpr bool GA = Prob::GATHER;
    constexpr int NH = GA ? 2 : 1;
    unsigned vA[NH][2], nvA[NH][2];
    const size_t hstepA = GA ? (size_t)0 : P.hstep_a();
    const size_t kstepA = P.kstep_a();
    P.a_off(cur, Rr, Cc, vA);
    const char* cA = P.a_ptr(cur); const char* cB = P.b_ptr(cur);
#define PG8_STAGEA(bufoff, gbase, h, arr) do { _Pragma("unroll") for (int _i = 0; _i < 2; ++_i) \
        __builtin_amdgcn_global_load_lds((const unsigned*)((const char*)(gbase) + (GA ? (size_t)0 : (size_t)(h) * hstepA) + (arr)[GA ? (h) : 0][_i]), (LAS unsigned*)(lds + (bufoff) + ldsw + _i * 8192), 16, 0, 0); } while (0)
    if constexpr (GA) { Unit u1; if (S.next(1, u1)) P.atab_issue(u1, lds + A_TAB_OFF + 1024, wid, lane); }
    PG8_STAGE(PG8_SB(0, 0), cB, voffB); PG8_STAGE(PG8_SB(0, 1), cB + hstepB, voffB); PG8_STAGEA(PG8_SA(0, 0), cA, 0, vA); PG8_STAGEA(PG8_SA(0, 1), cA, 1, vA);
    if (wr == 1) PG8_BAR;
    PG8_WAIT_V(2); PG8_BAR;
    PG8_STAGE(PG8_SB(1, 0), cB + kstep, voffB); PG8_STAGEA(PG8_SA(1, 0), cA + kstepA, 0, vA); PG8_STAGE(PG8_SB(1, 1), cB + hstepB + kstep, voffB);
    PG8_WAIT_V(6); PG8_BAR;
    for (;;) {
        const bool has_next = S.next(ui + 1, nxt);
        const char* nA = has_next ? P.a_ptr(nxt) : cA; const char* nB = has_next ? P.b_ptr(nxt) : cB;
        if constexpr (GA) {
            if (has_next) { int R2[2], C2[2], t2 = tid; asm volatile("" : "+v"(t2));
#pragma unroll
                for (int i = 0; i < 2; ++i) stage_rc(t2 * 16 + i * 8192, R2[i], C2[i]);
                P.a_off_tab(lds + A_TAB_OFF + ((ui + 1) & 1) * 1024, R2, C2, nvA);
                Unit n2; if (S.next(ui + 2, n2)) P.atab_issue(n2, lds + A_TAB_OFF + (ui & 1) * 1024, wid, lane); }
            else {
#pragma unroll
                for (int h = 0; h < NH; ++h)
#pragma unroll
                    for (int i = 0; i < 2; ++i) nvA[h][i] = vA[h][i];
            }
        }
        if constexpr (Epi::HAS_TAB) E.tab_issue(cur, lds + EPI_TAB_OFF + (ui & 1) * 2048, wid, lane);
        for (int t = 0; t < nt; t += 2) {
            const bool last = (t == nt - 2);
            const char* a1 = cA + (size_t)(t + 1) * kstepA;
            const char* a2 = last ? nA : cA + (size_t)(t + 2) * kstepA; const char* b2 = last ? nB : cB + (size_t)(t + 2) * kstep;
            const char* a3 = a2 + kstepA; const char* b3 = b2 + kstep;
            unsigned wA[NH][2];
#pragma unroll
            for (int h = 0; h < NH; ++h)
#pragma unroll
                for (int i = 0; i < 2; ++i) wA[h][i] = (GA && last) ? nvA[h][i] : vA[h][i];
            PG8_LDB(B0, 0, 0); PG8_LDB(B1, 0, 1); PG8_SCHED; PG8_LDA(At, 0, 0); PG8_STAGEA(PG8_SA(1, 1), a1, 1, vA);
            PG8_WAIT_V(8); PG8_WAIT_L(0); PG8_BAR; PG8_MMA(0, 0, At, B0); PG8_MMA(0, 1, At, B1); PG8_BAR; PG8_SCHED;
            PG8_LDA(At, 0, 1); PG8_STAGE(PG8_SB(0, 0), b2, voffB); PG8_STAGE(PG8_SB(0, 1), b2 + hstepB, voffB); PG8_STAGEA(PG8_SA(0, 0), a2, 0, wA);
            PG8_WAIT_V(8); PG8_WAIT_L(0); PG8_BAR; PG8_MMA(1, 0, At, B0); PG8_MMA(1, 1, At, B1); PG8_BAR; PG8_SCHED;
            PG8_LDB(B0, 1, 0); PG8_LDB(B1, 1, 1); PG8_SCHED; PG8_LDA(At, 1, 0); PG8_STAGEA(PG8_SA(0, 1), a2, 1, wA);
            PG8_WAIT_V(8); PG8_WAIT_L(0); PG8_BAR; PG8_MMA(0, 0, At, B0); PG8_MMA(0, 1, At, B1); PG8_BAR; PG8_SCHED;
            PG8_LDA(At, 1, 1); PG8_STAGE(PG8_SB(1, 0), b3, voffB); PG8_STAGE(PG8_SB(1, 1), b3 + hstepB, voffB); PG8_STAGEA(PG8_SA(1, 0), a3, 0, wA);
            PG8_WAIT_V(8); PG8_WAIT_L(0); PG8_BAR; PG8_MMA(1, 0, At, B0); PG8_MMA(1, 1, At, B1); PG8_BAR; PG8_SCHED;
        }
        if (wr == 0) PG8_BAR;
        if constexpr (Prob::F8) asm volatile("s_nop 15\n\ts_nop 7" ::: "memory");
        if constexpr (Epi::HAS_TAB) E(acc, cur, wr, wc, fr, fq, lds + EPI_TAB_OFF + (ui & 1) * 2048);
        else E(acc, cur, wr, wc, fr, fq);
        if (!has_next) break;
#pragma unroll
        for (int a = 0; a < 2; ++a)
#pragma unroll
            for (int b = 0; b < 2; ++b)
#pragma unroll
                for (int m = 0; m < 4; ++m)
#pragma unroll
                    for (int n = 0; n < 2; ++n) acc[a][b][m][n] = (f32x4){0.f, 0.f, 0.f, 0.f};
        cur = nxt; cA = nA; cB = nB; ++ui;
        if constexpr (GA) {
#pragma unroll
            for (int h = 0; h < NH; ++h)
#pragma unroll
                for (int i = 0; i < 2; ++i) vA[h][i] = nvA[h][i];
        }
        if (wr == 1) PG8_BAR;
    }
    PG8_WAIT_V(0);
    PG8_BAR;
#undef PG8_SA
#undef PG8_SB
#undef PG8_STAGE
#undef PG8_STAGEA
#undef PG8_LDA
#undef PG8_LDB
#undef PG8_MMA
#undef PG8_CAT
#undef PG8_WAIT_V
#undef PG8_WAIT_L
#undef PG8_BAR
#undef PG8_SCHED
}

template <bool F8_ = false, bool TILED_ = false> struct ProbPlainT {
    static constexpr bool GATHER = false, F8 = F8_;
    const bf16* A; const bf16* Bt; int lda, ldb, K;
    __device__ __forceinline__ const char* a_ptr(const Unit& u) const { return TILED_ ? (const char*)A + (size_t)u.pm * (K / BK) * 32768 : (const char*)(A + (size_t)u.pm * BM * lda); }
    __device__ __forceinline__ const char* b_ptr(const Unit& u) const { return (const char*)(Bt + (size_t)u.pn * BM * ldb); }
    __device__ __forceinline__ size_t hstep_a() const { return TILED_ ? (size_t)4096 : (size_t)HALF * lda * 2; }
    __device__ __forceinline__ size_t kstep_a() const { return TILED_ ? (size_t)32768 : (size_t)(BK * 2); }
    __device__ __forceinline__ void a_off(const Unit&, const int (&R)[2], const int (&C)[2], unsigned (&off)[1][2]) const {
#pragma unroll
        for (int i = 0; i < 2; ++i) {
            if (TILED_) { const int wr = R[i] >> 6, m = (R[i] >> 4) & 3, fr = R[i] & 15, cb = 2 * C[i]; off[0][i] = (unsigned)((((wr * 2 + (cb >> 6)) * 2) * 4 + m) * 1024 + fr * 64 + (cb & 63)); }
            else off[0][i] = (unsigned)(R[i] * lda + C[i]) * 2u;
        }
    }
};
typedef ProbPlainT<false> ProbPlain;
}

struct Args { const float* in[27]; float* out; unsigned char* ws; int ph_lo, ph_hi; };
struct Frame {
    LAS unsigned char* lds;
    int tid, lane, wave, G, bid;
    const float* const* in; unsigned char* ws; unsigned char* dout;
};
template <class T> __device__ __forceinline__ T* wsp(const Frame& F, size_t off) { return (T*)(F.ws + off); }
__device__ __forceinline__ Frame launder(const Frame& F0) {
    Frame F = F0; int t = F0.tid; asm volatile("" : "+v"(t)); F.tid = t; F.lane = t & 63; F.wave = __builtin_amdgcn_readfirstlane(t >> 6);
    int z = 0; asm volatile("" : "+s"(z));
    F.ws = F0.ws + z; F.dout = F0.dout + z; F.in = (const float* const*)((const char*)F0.in + z); return F;
}

__device__ __forceinline__ float row_rstd(const float* ssp, int r) {
    const f32x4* p = (const f32x4*)(ssp + (size_t)r * 16);
    const f32x4 a = p[0], b = p[1], c = p[2], d = p[3];
    const float s = ((a[0] + a[1]) + (a[2] + a[3])) + ((b[0] + b[1]) + (b[2] + b[3])) + ((c[0] + c[1]) + (c[2] + c[3])) + ((d[0] + d[1]) + (d[2] + d[3]));
    return rsqrtf(s * (1.0f / D) + EPS);
}

typedef pg8::Unit Unit;
struct EpiInproj {
    static constexpr bool HAS_TAB = false;
    const float* ssp; unsigned char* act;
    __device__ __forceinline__ void operator()(const f32x4 (&acc)[2][2][4][2], const Unit& u, int wr, int wc, int fr, int fq) const {
        static_assert(WS_UGM == WS_ACT && WS_Q == WS_ACT + 32 * MiB && WS_K == WS_ACT + 48 * MiB && WS_V == WS_ACT + 64 * MiB && WS_R == WS_ACT + 96 * MiB, "in-proj destination arithmetic");
        const unsigned pn = (unsigned)u.pn;
        const bool isu = pn < 2u;
        bf16* const base = (bf16*)(act + (size_t)((0x66443200u >> (4u * pn)) & 15u) * (16 * MiB));
        const unsigned stride = 512u >> ((0x0Cu >> pn) & 1u);
        const unsigned cb = ((pn >> 2) & pn & 1u) * 256u;
#pragma unroll
        for (int ai = 0; ai < 2; ++ai) {
            float rs4[4];
#pragma unroll
            for (int m = 0; m < 4; ++m) rs4[m] = row_rstd(ssp, u.pm * 256 + ai * 128 + wr * 64 + m * 16 + fr);
            CFENCE();
#pragma unroll
            for (int m = 0; m < 4; ++m) {
                const unsigned row = (unsigned)(u.pm * 256 + ai * 128 + wr * 64 + m * 16 + fr);
                const float rs = rs4[m];
                const unsigned ro = isu ? ((row >> 12) * 2097152u + (row & 4095u) * 16u) : row * stride;
#pragma unroll
                for (int bj = 0; bj < 2; ++bj) {
                    const unsigned cl = (unsigned)(bj * 128 + wc * 32 + 8 * fq);
                    f32x4 v0 = acc[ai][bj][m][0] * rs, v1 = acc[ai][bj][m][1] * rs;
                    const unsigned co = isu ? ((pn * 256u + cl) >> 4) * 65536u + ((cl >> 3) & 1u) * 8u : cb + cl;
                    u32x4 w; w.x = cvt_pk_bf16(v0[0], v0[1]); w.y = cvt_pk_bf16(v0[2], v0[3]); w.z = cvt_pk_bf16(v1[0], v1[1]); w.w = cvt_pk_bf16(v1[2], v1[3]);
                    *(u32x4*)(base + (size_t)(ro + co)) = w;
                }
            }
            CFENCE();
        }
    }
};
struct EpiGlu {
    static constexpr bool HAS_TAB = false;
    const bf16* ys5; bf16* yglu; const float* bglu;
    __device__ __forceinline__ void operator()(const f32x4 (&acc)[2][2][4][2], const Unit& u, int wr, int wc, int fr, int fq) const {
        const int colb = u.pn * 256 + wc * 32 + 8 * fq;
        const bf16* src = ys5 + (size_t)(u.pm * 256 + wr * 64 + fr) * 512 + colb;
        u32x4 nx[2] = {*(const u32x4*)src, *(const u32x4*)(src + 128)};
#pragma unroll
        for (int g = 0; g < 8; ++g) {
            const int ai = g >> 2, m = g & 3;
            const u32x4 a2[2] = {nx[0], nx[1]};
            if (g < 7) { const int g1 = g + 1; const bf16* s1 = src + (size_t)((g1 >> 2) * 128 + (g1 & 3) * 16) * 512; nx[0] = *(const u32x4*)s1; nx[1] = *(const u32x4*)(s1 + 128); }
            CFENCE();
            const int row = u.pm * 256 + ai * 128 + wr * 64 + m * 16 + fr;
#pragma unroll
            for (int bj = 0; bj < 2; ++bj) {
                const int col = colb + bj * 128;
                const u32x4 a = a2[bj];
                const f32x4 b0 = *(const f32x4*)(bglu + col), b1 = *(const f32x4*)(bglu + col + 4);
                const f32x4 v0 = acc[ai][bj][m][0] + b0, v1 = acc[ai][bj][m][1] + b1;
                u32x4 w;
                w.x = cvt_pk_bf16(bflo(a.x) * sigmoidf_(v0[0]), bfhi(a.x) * sigmoidf_(v0[1]));
                w.y = cvt_pk_bf16(bflo(a.y) * sigmoidf_(v0[2]), bfhi(a.y) * sigmoidf_(v0[3]));
                w.z = cvt_pk_bf16(bflo(a.z) * sigmoidf_(v1[0]), bfhi(a.z) * sigmoidf_(v1[1]));
                w.w = cvt_pk_bf16(bflo(a.w) * sigmoidf_(v1[2]), bfhi(a.w) * sigmoidf_(v1[3]));
                *(u32x4*)(yglu + (size_t)row * 512 + col) = w;
            }
        }
        CFENCE();
    }
};
struct EpiResid {
    static constexpr bool HAS_TAB = false;
    bf16* xb; float* ssp; bf16* dst; bool wr_ssp;
    unsigned char* x8;
    float ascale;
    __device__ __forceinline__ void operator()(const f32x4 (&acc)[2][2][4][2], const Unit& u, int wr, int wc, int fr, int fq) const {
        const int colb = u.pn * 256 + wc * 32 + 8 * fq;
        const bf16* src = xb + (size_t)(u.pm * 256 + wr * 64 + fr) * D + colb;
        u32x4 nx[2] = {*(const u32x4*)src, *(const u32x4*)(src + 128)};
#pragma unroll
        for (int g = 0; g < 8; ++g) {
            const int ai = g >> 2, m = g & 3;
            const u32x4 a2[2] = {nx[0], nx[1]};
            if (g < 7) { const int g1 = g + 1; const bf16* s1 = src + (size_t)((g1 >> 2) * 128 + (g1 & 3) * 16) * D; nx[0] = *(const u32x4*)s1; nx[1] = *(const u32x4*)(s1 + 128); }
            CFENCE();
            const int row = u.pm * 256 + ai * 128 + wr * 64 + m * 16 + fr;
            float ss = 0.f;
#pragma unroll
            for (int bj = 0; bj < 2; ++bj) {
                const int col = colb + bj * 128;
                const u32x4 a = a2[bj];
                const f32x4 v0 = acc[ai][bj][m][0] * ascale + (f32x4){bflo(a.x), bfhi(a.x), bflo(a.y), bfhi(a.y)};
                const f32x4 v1 = acc[ai][bj][m][1] * ascale + (f32x4){bflo(a.z), bfhi(a.z), bflo(a.w), bfhi(a.w)};
                ss += (v0[0] * v0[0] + v0[1] * v0[1]) + (v0[2] * v0[2] + v0[3] * v0[3]) + (v1[0] * v1[0] + v1[1] * v1[1]) + (v1[2] * v1[2] + v1[3] * v1[3]);
                u32x4 w; w.x = cvt_pk_bf16(v0[0], v0[1]); w.y = cvt_pk_bf16(v0[2], v0[3]); w.z = cvt_pk_bf16(v1[0], v1[1]); w.w = cvt_pk_bf16(v1[2], v1[3]);
                *(u32x4*)(dst + (size_t)row * D + col) = w;
                if (x8) { u32x2 q; q.x = pk4_fp8(v0[0], v0[1], v0[2], v0[3]); q.y = pk4_fp8(v1[0], v1[1], v1[2], v1[3]); *(u32x2*)(x8 + (size_t)row * D + col) = q; }
            }
            ss += __shfl_xor(ss, 16); ss += __shfl_xor(ss, 32);
            if (fq == 0 && wr_ssp) ssp[(size_t)row * 16 + u.pn * 4 + wc] = ss;
        }
        CFENCE();
    }
};
template <bool F8> struct EpiSwigluT {
    static constexpr bool HAS_TAB = false;
    const float* ssp; bf16* h; int ldh;
    __device__ __forceinline__ void operator()(const f32x4 (&acc)[2][2][4][2], const Unit& u, int wr, int wc, int fr, int fq) const {
#pragma unroll
        for (int ai = 0; ai < 2; ++ai) {
            float rs4[4];
#pragma unroll
            for (int m = 0; m < 4; ++m) rs4[m] = row_rstd(ssp, u.pm * 256 + ai * 128 + wr * 64 + m * 16 + fr);
            CFENCE();
#pragma unroll
            for (int m = 0; m < 4; ++m) {
                const int row = u.pm * 256 + ai * 128 + wr * 64 + m * 16 + fr;
                const float rs = rs4[m] * (F8 ? 1.0f / F8_SW_UP : 1.0f);
                const float hs = F8 ? F8_SH : 1.0f, nrs = rs * -1.4426950408889634f, cc = rs * rs * hs;
                const f32x4 ga = acc[ai][0][m][0], gb = acc[ai][0][m][1], ua = acc[ai][1][m][0], ub = acc[ai][1][m][1];
                const f32x2 p0 = swiglu2((f32x2){ga[0], ga[1]}, (f32x2){ua[0], ua[1]}, nrs, cc), p1 = swiglu2((f32x2){ga[2], ga[3]}, (f32x2){ua[2], ua[3]}, nrs, cc);
                const f32x2 p2 = swiglu2((f32x2){gb[0], gb[1]}, (f32x2){ub[0], ub[1]}, nrs, cc), p3 = swiglu2((f32x2){gb[2], gb[3]}, (f32x2){ub[2], ub[3]}, nrs, cc);
                const f32x4 h0 = {p0[0], p0[1], p1[0], p1[1]}, h1 = {p2[0], p2[1], p3[0], p3[1]};
                const int col = u.pn * 128 + wc * 32 + 8 * fq;
                static_assert(!F8, "the dense tile-major hidden layout is written for bf16");
                const size_t to = ((size_t)u.pm * (2 * ldh / 128) + 2 * u.pn + (wc >> 1)) * 32768 + (size_t)(((((wr * 2 + (wc & 1)) * 2 + ai) * 4 + m) * 1024) + fr * 64 + 16 * fq);
                if constexpr (F8) { u32x2 q; q.x = pk4_fp8(h0[0], h0[1], h0[2], h0[3]); q.y = pk4_fp8(h1[0], h1[1], h1[2], h1[3]); *(u32x2*)((unsigned char*)h + (size_t)row * ldh + col) = q; }
                else { u32x4 w; w.x = cvt_pk_bf16(h0[0], h0[1]); w.y = cvt_pk_bf16(h0[2], h0[3]); w.z = cvt_pk_bf16(h1[0], h1[1]); w.w = cvt_pk_bf16(h1[2], h1[3]); *(u32x4*)((unsigned char*)h + to) = w; }
            }
            CFENCE();
        }
    }
};

struct MoeTab { LAS int* cnt; LAS int* cb; LAS short* tl_list; LAS short* tl_sub; };
__device__ __forceinline__ MoeTab moe_tab(const Frame& F) {
    MoeTab T; T.cnt = (LAS int*)(F.lds + MOE_TAB_OFF); T.cb = T.cnt + 16; T.tl_list = (LAS short*)(T.cb + 8); T.tl_sub = T.tl_list + 288; return T;
}
__device__ __forceinline__ void moe_build_tables(const Frame& F) {
    MoeTab T = moe_tab(F);
    if (F.tid < 16) { const unsigned* gc = wsp<unsigned>(F, WS_CTL) + CW_CNT; int c = (int)__hip_atomic_load(gc + F.tid, __ATOMIC_RELAXED, __HIP_MEMORY_SCOPE_AGENT); if (c > 32768) c = 32768; T.cnt[F.tid] = c; }
    __syncthreads();
    if (F.tid == 0) {
        int tot = 0, tr0 = 0, tr1 = 0;
#pragma unroll 1
        for (int l = 0; l < 16; ++l) {
            const int nt_ = (T.cnt[l] + 255) >> 8; if (l < 8) tr0 += nt_; else tr1 += nt_;
#pragma unroll 1
            for (int s = 0; s < nt_; ++s) { T.tl_list[tot] = (short)l; T.tl_sub[tot] = (short)s; ++tot; }
        }
        const int c0 = (tr0 > 64 + MOE_CAP_TILES) ? tr0 - MOE_CAP_TILES : (tr0 < 64 ? tr0 : 64);
        const int c3 = (tr1 > 64 + MOE_CAP_TILES) ? tr1 - MOE_CAP_TILES : (tr1 < 64 ? tr1 : 64);
        T.cb[0] = 0; T.cb[1] = c0; T.cb[2] = tr0; T.cb[3] = tr0 + tr1 - c3; T.cb[4] = tr0 + tr1;
    }
    __syncthreads();
}
struct MoeOrder {
    MoeTab T; int t0, ntile, nN, lo, nloc, j, nbx, nheavy, skip;
    __device__ __forceinline__ void init(const MoeTab& T_, int chunk, int nN_, int G, int bid, int nheavy_, int skip_) {
        T = T_; t0 = T.cb[chunk]; ntile = T.cb[chunk + 1] - t0; nN = nN_;
        const int total = ntile * nN, x = bid & 7, q = total >> 3, r = total & 7;
        lo = (x < r) ? x * (q + 1) : r * (q + 1) + (x - r) * q; nloc = q + (x < r ? 1 : 0);
        j = bid >> 3; nbx = (G - x + 7) >> 3; nheavy = nheavy_; skip = skip_;
    }
    __device__ __forceinline__ int nheavy_next() const { return nloc % nbx; }
    __device__ __forceinline__ bool next(int i, Unit& u) const {
        int k;
        if (j < nheavy) k = skip * (nbx - nheavy) + i * nbx + j;
        else k = (i < skip) ? i * (nbx - nheavy) + (j - nheavy) : skip * (nbx - nheavy) + (i - skip) * nbx + j;
        if (k >= nloc) return false;
        const int idx = lo + k, nig = 8 * nN, gid = idx / nig, fm = gid * 8, gsz = (ntile - fm) < 8 ? (ntile - fm) : 8, w = idx - gid * nig;
        const int tl = fm + w % gsz; u.pm = tl; u.pn = w / gsz; u.e = T.tl_list[t0 + tl]; u.sub = T.tl_sub[t0 + tl]; return true;
    }
};
constexpr int MOE_ESZ = USE_F8_MOE ? 1 : 2;
struct ProbMoeUp {
    static constexpr bool GATHER = true, F8 = USE_F8_MOE != 0;
    const void* xa; const void* wgu; const int* tok; MoeTab T; int lda, ldb, K;
    __device__ __forceinline__ const char* a_ptr(const Unit&) const { return (const char*)xa; }
    __device__ __forceinline__ size_t hstep_a() const { return 0; }
    __device__ __forceinline__ size_t kstep_a() const { return 128; }
    __device__ __forceinline__ const char* b_ptr(const Unit& u) const { return (const char*)wgu + ((size_t)(u.e & 7) * (2 * DFE) + (size_t)u.pn * 256) * D * MOE_ESZ; }
    __device__ __forceinline__ void a_off(const Unit& u, const int (&R)[2], const int (&C)[2], unsigned (&off)[2][2]) const {
        const int cnt = T.cnt[u.e];
#pragma unroll
        for (int h = 0; h < 2; ++h)
#pragma unroll
            for (int i = 0; i < 2; ++i) { const int p = u.sub * 256 + h * 128 + R[i]; const int t = (p < cnt) ? tok[u.e * 32768 + p] : 0; off[h][i] = (unsigned)(t * lda + C[i]) * 2u; }
    }
    __device__ __forceinline__ void atab_issue(const Unit& u, LAS unsigned char* tab, int wid, int lane) const {
        if (wid < 4) { const int cnt = T.cnt[u.e]; int p = u.sub * 256 + wid * 64 + lane; p = (p < cnt) ? p : 0;
            __builtin_amdgcn_global_load_lds((const unsigned*)(tok + u.e * 32768 + p), (LAS unsigned*)(tab + wid * 256), 4, 0, 0); }
    }
    __device__ __forceinline__ void a_off_tab(const LAS unsigned char* tab, const int (&R)[2], const int (&C)[2], unsigned (&off)[2][2]) const {
#pragma unroll
        for (int h = 0; h < 2; ++h)
#pragma unroll
            for (int i = 0; i < 2; ++i) { const int t = *(const LAS int*)(tab + (h * 128 + R[i]) * 4); off[h][i] = (unsigned)(t * lda + C[i]) * 2u; }
    }
};
struct ProbMoeDown {
    static constexpr bool GATHER = false, F8 = USE_F8_MOE != 0;
    const void* h; const void* wd; int lda, ldb, K;
    static constexpr bool TILED = USE_F8_MOE != 0;
    __device__ __forceinline__ const char* a_ptr(const Unit& u) const { return TILED ? (const char*)h + (size_t)u.pm * (DFE / 128) * 32768 : (const char*)h + (size_t)u.pm * 256 * DFE * MOE_ESZ; }
    __device__ __forceinline__ const char* b_ptr(const Unit& u) const { return (const char*)wd + ((size_t)(u.e & 7) * D + (size_t)u.pn * 256) * DFE * MOE_ESZ; }
    __device__ __forceinline__ size_t hstep_a() const { return TILED ? (size_t)2048 : (size_t)128 * lda * 2; }
    __device__ __forceinline__ size_t kstep_a() const { return TILED ? (size_t)32768 : (size_t)128; }
    __device__ __forceinline__ void a_off(const Unit&, const int (&R)[2], const int (&C)[2], unsigned (&off)[1][2]) const {
#pragma unroll
        for (int i = 0; i < 2; ++i) {
            if (TILED) { const int wr = R[i] >> 6, m = (R[i] >> 4) & 3, fr = R[i] & 15, cb = 2 * C[i]; off[0][i] = (unsigned)((((wr * 4 + (cb >> 5)) * 2) * 4 + m) * 512 + fr * 32 + (cb & 31)); }
            else off[0][i] = (unsigned)(R[i] * lda + C[i]) * 2u;
        }
    }
};
struct EpiSwigluMoe {
    static constexpr bool HAS_TAB = true;
    const float* rl; void* h; MoeTab T;
    __device__ __forceinline__ void tab_issue(const Unit& u, LAS unsigned char* tab, int wid, int lane) const {
        if (wid < 4) { const int cnt = T.cnt[u.e]; int p = u.sub * 256 + wid * 64 + lane; p = (p < cnt) ? p : 0;
            __builtin_amdgcn_global_load_lds((const unsigned*)(rl + u.e * 32768 + p), (LAS unsigned*)(tab + wid * 256), 4, 0, 0); }
    }
    __device__ __forceinline__ void operator()(const f32x4 (&acc)[2][2][4][2], const Unit& u, int wr, int wc, int fr, int fq, const LAS unsigned char* tab) const {
        constexpr bool F8 = USE_F8_MOE != 0;
        const int cnt = T.cnt[u.e];
        float rs8[8];
#pragma unroll
        for (int g = 0; g < 8; ++g) { const int rl_ = (g >> 2) * 128 + wr * 64 + (g & 3) * 16 + fr, p = u.sub * 256 + rl_; const float v = *(const LAS float*)(tab + rl_ * 4); rs8[g] = (p < cnt) ? v * (F8 ? 1.0f / F8_SW_UP : 1.0f) : 0.f; }
        CFENCE();
#pragma unroll
        for (int ai = 0; ai < 2; ++ai)
#pragma unroll
            for (int m = 0; m < 4; ++m) {
                const int rl_ = ai * 128 + wr * 64 + m * 16 + fr;
                const float rs = rs8[ai * 4 + m];
                const float hs = F8 ? F8_SH : 1.0f, nrs = rs * -1.4426950408889634f, cc = rs * rs * hs;
                const f32x4 ga = acc[ai][0][m][0], gb = acc[ai][0][m][1], ua = acc[ai][1][m][0], ub = acc[ai][1][m][1];
                const f32x2 p0 = swiglu2((f32x2){ga[0], ga[1]}, (f32x2){ua[0], ua[1]}, nrs, cc), p1 = swiglu2((f32x2){ga[2], ga[3]}, (f32x2){ua[2], ua[3]}, nrs, cc);
                const f32x2 p2 = swiglu2((f32x2){gb[0], gb[1]}, (f32x2){ub[0], ub[1]}, nrs, cc), p3 = swiglu2((f32x2){gb[2], gb[3]}, (f32x2){ub[2], ub[3]}, nrs, cc);
                const f32x4 h0 = {p0[0], p0[1], p1[0], p1[1]}, h1 = {p2[0], p2[1], p3[0], p3[1]};
                const size_t eo = F8 ? ((size_t)(u.pm * (DFE / 128) + u.pn) * 32768 + (size_t)((((wr * 4 + wc) * 2 + ai) * 4 + m) * 512 + fr * 32 + 8 * fq))
                                     : ((size_t)(u.pm * 256 + rl_) * DFE + u.pn * 128 + wc * 32 + 8 * fq);
                if constexpr (F8) { u32x2 q; q.x = pk4_fp8(h0[0], h0[1], h0[2], h0[3]); q.y = pk4_fp8(h1[0], h1[1], h1[2], h1[3]); *(u32x2*)((unsigned char*)h + eo) = q; }
                else { u32x4 w; w.x = cvt_pk_bf16(h0[0], h0[1]); w.y = cvt_pk_bf16(h0[2], h0[3]); w.z = cvt_pk_bf16(h1[0], h1[1]); w.w = cvt_pk_bf16(h1[2], h1[3]); *(u32x4*)((bf16*)h + eo) = w; }
            }
        CFENCE();
    }
};
struct EpiMoeDown {
    static constexpr bool HAS_TAB = false;
    const int* tok; const float* wl; const bf16* xb; bf16* xo; MoeTab T; bool dry;
    __device__ __forceinline__ void operator()(const f32x4 (&acc)[2][2][4][2], const Unit& u, int wr, int wc, int fr, int fq) const {
        const int cnt = T.cnt[u.e]; const bf16* src = (u.e < 8) ? xb : (const bf16*)xo;
        const int colb = u.pn * 256 + wc * 32 + 8 * fq;
        int t8[8]; float w8[8];
#pragma unroll
        for (int g = 0; g < 8; ++g) { const int p = u.sub * 256 + (g >> 2) * 128 + wr * 64 + (g & 3) * 16 + fr; const bool ok = p < cnt; const int pc = ok ? p : 0;
            const int t_ = tok[u.e * 32768 + pc]; const float w_ = wl[u.e * 32768 + pc];
            t8[g] = ok ? t_ : -1; w8[g] = ok ? w_ * (USE_F8_MOE ? 1.0f / (F8_SH * F8_SW_DN) : 1.0f) : 0.f; }
        CFENCE();
        u32x4 nx[2];
        { const bf16* s0 = src + (size_t)(t8[0] < 0 ? 0 : t8[0]) * D + colb; nx[0] = *(const u32x4*)s0; nx[1] = *(const u32x4*)(s0 + 128); }
#pragma unroll
        for (int g = 0; g < 8; ++g) {
            const int ai = g >> 2, m = g & 3;
            const u32x4 a2[2] = {nx[0], nx[1]};
            if (g < 7) { const bf16* s1 = src + (size_t)(t8[g + 1] < 0 ? 0 : t8[g + 1]) * D + colb; nx[0] = *(const u32x4*)s1; nx[1] = *(const u32x4*)(s1 + 128); }
            CFENCE();
            if (t8[g] >= 0) {
#pragma unroll
                for (int bj = 0; bj < 2; ++bj) {
                    const u32x4 a = a2[bj];
                    const f32x4 v0 = acc[ai][bj][m][0] * w8[g] + (f32x4){bflo(a.x), bfhi(a.x), bflo(a.y), bfhi(a.y)};
                    const f32x4 v1 = acc[ai][bj][m][1] * w8[g] + (f32x4){bflo(a.z), bfhi(a.z), bflo(a.w), bfhi(a.w)};
                    u32x4 w; w.x = cvt_pk_bf16(v0[0], v0[1]); w.y = cvt_pk_bf16(v0[2], v0[3]); w.z = cvt_pk_bf16(v1[0], v1[1]); w.w = cvt_pk_bf16(v1[2], v1[3]);
                    if (!dry) *(u32x4*)(xo + (size_t)t8[g] * D + colb + bj * 128) = w;
                }
            }
        }
        CFENCE();
    }
};

__device__ __forceinline__ void p0_tr_item(const float* src, int ldsrc, int ncol0, int k0, const float* gain, bf16* dst, int K, int drow0, LAS float* scr, int lane) {
    float gv[8]; f32x4 v8[8];
#pragma unroll
    for (int i = 0; i < 8; ++i) gv[i] = 1.0f;
    if (gain) {
#pragma unroll
        for (int i = 0; i < 8; ++i) gv[i] = gain[k0 + 8 * i + (lane >> 3)];
    }
#pragma unroll
    for (int i = 0; i < 8; ++i) v8[i] = *(const f32x4*)(src + (size_t)(k0 + 8 * i + (lane >> 3)) * ldsrc + ncol0 + 4 * (lane & 7));
    CFENCE();
#pragma unroll
    for (int i = 0; i < 8; ++i) { const int kk = 8 * i + (lane >> 3), c4 = lane & 7; *(LAS f32x4*)(scr + kk * 36 + 4 * c4) = v8[i] * gv[i]; }
    LDS_WAIT(); CFENCE();
    const int c = lane & 7;
#pragma unroll
    for (int j = 0; j < 4; ++j) { const int n = (lane >> 3) + 8 * j; const LAS float* s = scr + (8 * c) * 36 + n;
        u32x4 o; o.x = pk2(s[0 * 36], s[1 * 36]); o.y = pk2(s[2 * 36], s[3 * 36]); o.z = pk2(s[4 * 36], s[5 * 36]); o.w = pk2(s[6 * 36], s[7 * 36]);
        *(u32x4*)(dst + (size_t)(drow0 + n) * K + k0 + 8 * c) = o; }
    LDS_WAIT(); CFENCE();
}
__device__ __forceinline__ void p0_tr_item_f8(const float* src, int ldsrc, int ncol0, int k0, const float* gain, float scale, unsigned char* dst, int K, int drow0, LAS float* scr, int lane) {
    float gv[8]; f32x4 v8[8];
#pragma unroll
    for (int i = 0; i < 8; ++i) gv[i] = 1.0f;
    if (gain) {
#pragma unroll
        for (int i = 0; i < 8; ++i) gv[i] = gain[k0 + 8 * i + (lane >> 3)];
    }
#pragma unroll
    for (int i = 0; i < 8; ++i) v8[i] = *(const f32x4*)(src + (size_t)(k0 + 8 * i + (lane >> 3)) * ldsrc + ncol0 + 4 * (lane & 7));
    CFENCE();
#pragma unroll
    for (int i = 0; i < 8; ++i) { const int kk = 8 * i + (lane >> 3), c4 = lane & 7; *(LAS f32x4*)(scr + kk * 36 + 4 * c4) = v8[i] * (gv[i] * scale); }
    LDS_WAIT(); CFENCE();
    const int c = lane & 7;
#pragma unroll
    for (int j = 0; j < 4; ++j) { const int n = (lane >> 3) + 8 * j; const LAS float* s = scr + (8 * c) * 36 + n;
        u32x2 o; o.x = pk4_fp8(s[0 * 36], s[1 * 36], s[2 * 36], s[3 * 36]); o.y = pk4_fp8(s[4 * 36], s[5 * 36], s[6 * 36], s[7 * 36]);
        *(u32x2*)(dst + (size_t)(drow0 + n) * K + k0 + 8 * c) = o; }
    LDS_WAIT(); CFENCE();
}
__device__ __forceinline__ void p0_s5_unit(const Frame& F, int l, int g) {
    LAS float* AP = (LAS float*)F.lds;
    LAS float* BB = AP + 64 * 17 * 2;
    LAS float* CC = BB + 64 * 16 * 2;
    LAS float* KT = CC + 16 * 64 * 2;
    const float* lre = F.in[3] + (l * 32 + g) * 64; const float* lim = F.in[4] + (l * 32 + g) * 64; const float ldt = F.in[5][l * 32 + g];
    const float* bre = F.in[6] + (size_t)(l * 32 + g) * 1024; const float* bim = F.in[7] + (size_t)(l * 32 + g) * 1024;
    const float* cre = F.in[8] + (size_t)(l * 32 + g) * 1024; const float* cim = F.in[9] + (size_t)(l * 32 + g) * 1024;
    const int tid = F.tid;
    for (int i = tid; i < 64 * 17; i += 512) {
        const int p = i / 17, tau = i % 17;
        const double lr = fmin((double)lre[p], -1e-4), li = (double)lim[p], dt = exp((double)ldt);
        const double mg = exp(lr * dt * tau), ph = li * dt * tau;
        AP[i * 2] = (float)(mg * cos(ph)); AP[i * 2 + 1] = (float)(mg * sin(ph));
    }
    for (int i = tid; i < 1024; i += 512) {
        const int p = i >> 4;
        const double lr = fmin((double)lre[p], -1e-4), li = (double)lim[p], dt = exp((double)ldt);
        const double mg = exp(lr * dt), ar = mg * cos(li * dt), ai = mg * sin(li * dt), nr = ar - 1.0, ni = ai, den = lr * lr + li * li;
        const double fr = (nr * lr + ni * li) / den, fi = (ni * lr - nr * li) / den;
        const double br = bre[i], bi = bim[i];
        BB[i * 2] = (float)(fr * br - fi * bi); BB[i * 2 + 1] = (float)(fr * bi + fi * br);
        CC[i * 2] = cre[i]; CC[i * 2 + 1] = cim[i];
    }
    __syncthreads();
    for (int i = tid; i < 4096; i += 512) {
        const int tau = i >> 8, c = (i >> 4) & 15, c2 = i & 15; float s = 0.f;
        for (int p = 0; p < 64; ++p) {
            const float xr = CC[(c * 64 + p) * 2], xi = CC[(c * 64 + p) * 2 + 1], ar = AP[(p * 17 + tau) * 2], ai = AP[(p * 17 + tau) * 2 + 1];
            const float zr = xr * ar - xi * ai, zi = xr * ai + xi * ar;
            s += zr * BB[(p * 16 + c2) * 2] - zi * BB[(p * 16 + c2) * 2 + 1];
        }
        KT[i] = s;
    }
    __syncthreads();
    bf16* MQ = wsp<bf16>(F, WS_S5MQ) + (size_t)(l * 32 + g) * 256 * 384;
    for (int i = tid; i < 256 * 48; i += 512) {
        const int m = i / 48, k8 = (i % 48) * 8, t = m >> 4, c = m & 15; float v[8];
#pragma unroll
        for (int j = 0; j < 8; ++j) {
            const int kc = k8 + j;
            if (kc < 256) { const int s = kc >> 4, c2 = kc & 15; v[j] = (s <= t) ? KT[((t - s) * 16 + c) * 16 + c2] : 0.f; }
            else { const int pp = kc - 256, p = pp & 63; const float xr = CC[(c * 64 + p) * 2], xi = CC[(c * 64 + p) * 2 + 1], ar = AP[(p * 17 + t + 1) * 2], ai = AP[(p * 17 + t + 1) * 2 + 1];
                   v[j] = (pp < 64) ? (xr * ar - xi * ai) : -(xr * ai + xi * ar); }
        }
        u32x4 o; o.x = pk2(v[0], v[1]); o.y = pk2(v[2], v[3]); o.z = pk2(v[4], v[5]); o.w = pk2(v[6], v[7]);
        *(u32x4*)(MQ + (size_t)m * 384 + k8) = o;
    }
    bf16* PM = wsp<bf16>(F, WS_S5P) + (size_t)(l * 32 + g) * 128 * 256;
    for (int i = tid; i < 128 * 32; i += 512) {
        const int pp = i >> 5, k8 = (i & 31) * 8, p = pp & 63; float v[8];
#pragma unroll
        for (int j = 0; j < 8; ++j) {
            const int kc = k8 + j, s = kc >> 4, c2 = kc & 15;
            const float ar = AP[(p * 17 + 15 - s) * 2], ai = AP[(p * 17 + 15 - s) * 2 + 1], br = BB[(p * 16 + c2) * 2], bi = BB[(p * 16 + c2) * 2 + 1];
            v[j] = (pp < 64) ? (ar * br - ai * bi) : (ar * bi + ai * br);
        }
        u32x4 o; o.x = pk2(v[0], v[1]); o.y = pk2(v[2], v[3]); o.z = pk2(v[4], v[5]); o.w = pk2(v[6], v[7]);
        *(u32x4*)(PM + (size_t)pp * 256 + k8) = o;
    }
    float* A16 = wsp<float>(F, WS_S5A16) + (size_t)(l * 32 + g) * 128;
    if (tid < 64) { A16[tid * 2] = AP[(tid * 17 + 16) * 2]; A16[tid * 2 + 1] = AP[(tid * 17 + 16) * 2 + 1]; }
    __syncthreads();
}
__device__ __forceinline__ void p0_prologue(const Frame& F) {
    if (F.bid == 0 && F.tid < 16) __hip_atomic_store(wsp<unsigned>(F, WS_CTL) + CW_CNT + F.tid, 0u, __ATOMIC_RELAXED, __HIP_MEMORY_SCOPE_AGENT);
#ifndef PROBE_S5U
#define PROBE_S5U 1
#endif
#pragma unroll 1
    for (int pr = 0; pr < PROBE_S5U; ++pr) for (int un = F.bid; un < 64; un += F.G) p0_s5_unit(F, un >> 5, un & 31);
    LAS float* scr = (LAS float*)(F.lds + F.wave * 16384);
    const int gw = F.bid * 8 + F.wave, NGW = F.G * 8, lane = F.lane;
    constexpr int I_IN = 16 * 64, I_GLU = 8 * 16, I_OUT = 16 * 32, I_FGU = 16 * 176, I_FD = 44 * 32, I_MGU = 16 * 224, I_MD = 56 * 32;
    constexpr int NITEMS = 2 * (I_IN + I_GLU + I_OUT) + I_FGU + I_FD + 8 * (I_MGU + I_MD);
    const bool split = F.G > 64;
    const int N1 = split ? ((NITEMS / NGW > 4) ? (NITEMS / NGW - 4) * NGW : 0) : NITEMS;
    int step = NGW;
    for (int it = gw; ; it += step) {
        if (step == NGW && it >= N1) { if (!split || F.bid < 64) break; it = N1 + (F.bid - 64) * 8 + F.wave; step = (F.G - 64) * 8; }
        if (it >= NITEMS) break;
        int r = it; bool done = false;
#pragma unroll
        for (int l = 0; l < 2; ++l) {
            if (done) break;
            if (r < I_IN) { p0_tr_item(F.in[2] + (size_t)l * D * DIN, DIN, 32 * (r % 64), 64 * (r / 64), F.in[1] + l * D, wsp<bf16>(F, WS_WIN) + (size_t)l * NPROJ * D, D, 32 * (r % 64), scr, lane); done = true; break; } r -= I_IN;
            if (r < I_GLU) { p0_tr_item(F.in[11] + (size_t)l * 512 * 512, 512, 32 * (r % 16), 64 * (r / 16), nullptr, wsp<bf16>(F, WS_WGLU) + (size_t)l * 512 * 512, 512, 32 * (r % 16), scr, lane); done = true; break; } r -= I_GLU;
            if (r < I_OUT) { p0_tr_item(F.in[17] + (size_t)l * D * D, D, 32 * (r % 32), 64 * (r / 32), nullptr, wsp<bf16>(F, WS_WOUT) + (size_t)l * D * D, D, 32 * (r % 32), scr, lane); done = true; break; } r -= I_OUT;
        }
        if (done) continue;
        if (r < I_FGU) { const int nb = r % 176, kb = r / 176, n0 = 32 * nb, T = n0 >> 8, hf = (n0 >> 7) & 1, j0 = n0 & 127;
            if (USE_F8_FFN) p0_tr_item_f8(hf ? F.in[20] : F.in[19], DFF, 128 * T + j0, 64 * kb, F.in[18], F8_SW_UP, wsp<unsigned char>(F, WS_WFGU), D, n0, scr, lane);
            else p0_tr_item(hf ? F.in[20] : F.in[19], DFF, 128 * T + j0, 64 * kb, F.in[18], wsp<bf16>(F, WS_WFGU), D, n0, scr, lane);
            continue; } r -= I_FGU;
        if (r < I_FD) {
            if (USE_F8_FFN) p0_tr_item_f8(F.in[21], D, 32 * (r % 32), 64 * (r / 32), nullptr, F8_SW_DN, wsp<unsigned char>(F, WS_WFD), DFF, 32 * (r % 32), scr, lane);
            else p0_tr_item(F.in[21], D, 32 * (r % 32), 64 * (r / 32), nullptr, wsp<bf16>(F, WS_WFD), DFF, 32 * (r % 32), scr, lane);
            continue; } r -= I_FD;
        const int e = r / (I_MGU + I_MD); r -= e * (I_MGU + I_MD);
        if (r < I_MGU) { const int nb = r % 224, kb = r / 224, n0 = 32 * nb, T = n0 >> 8, hf = (n0 >> 7) & 1, j0 = n0 & 127;
            if (USE_F8_MOE) p0_tr_item_f8((hf ? F.in[24] : F.in[23]) + (size_t)e * D * DFE, DFE, 128 * T + j0, 64 * kb, F.in[18] + D, F8_SW_UP, wsp<unsigned char>(F, WS_MGU) + (size_t)e * 2 * DFE * D, D, n0, scr, lane);
            else p0_tr_item((hf ? F.in[24] : F.in[23]) + (size_t)e * D * DFE, DFE, 128 * T + j0, 64 * kb, F.in[18] + D, wsp<bf16>(F, WS_MGU) + (size_t)e * 2 * DFE * D, D, n0, scr, lane);
            continue; } r -= I_MGU;
        if (USE_F8_MOE) p0_tr_item_f8(F.in[25] + (size_t)e * DFE * D, D, 32 * (r % 32), 64 * (r / 32), nullptr, F8_SW_DN, wsp<unsigned char>(F, WS_MD) + (size_t)e * D * DFE, DFE, 32 * (r % 32), scr, lane);
        else p0_tr_item(F.in[25] + (size_t)e * DFE * D, D, 32 * (r % 32), 64 * (r / 32), nullptr, wsp<bf16>(F, WS_MD) + (size_t)e * D * DFE, DFE, 32 * (r % 32), scr, lane);
    }
    for (int it = F.bid * 512 + F.tid; it < 2 * 16 * 1024; it += F.G * 512) {
        const int l = it >> 14, r = (it >> 10) & 15, k = it & 1023;
        wsp<bf16>(F, WS_WGT)[it] = (bf16)f2bf(F.in[1][l * D + k] * F.in[2][(size_t)l * D * DIN + (size_t)k * DIN + 2048 + r]);
    }
    for (int it = F.bid * 512 + F.tid; it < 2 * 256 * 16; it += F.G * 512) {
        const int l = it >> 12, k = (it >> 4) & 255, r = it & 15;
        wsp<bf16>(F, WS_WA2T)[it] = (bf16)f2bf(F.in[14][(size_t)l * 16 * 256 + r * 256 + k]);
    }
    bf16* xb = wsp<bf16>(F, WS_XB); float* ssp = wsp<float>(F, WS_SSP);
    f32x4 xn[4];
    if (gw < M) {
#pragma unroll
        for (int j = 0; j < 4; ++j) xn[j] = ((const f32x4*)(F.in[0] + (size_t)gw * D) + lane)[64 * j];
    }
    for (int m = gw; m < M; m += NGW) {
        f32x4 xc[4]; float s = 0.f;
#pragma unroll
        for (int j = 0; j < 4; ++j) xc[j] = xn[j];
        if (m + NGW < M) {
#pragma unroll
            for (int j = 0; j < 4; ++j) xn[j] = ((const f32x4*)(F.in[0] + (size_t)(m + NGW) * D) + lane)[64 * j];
        }
        CFENCE();
        u32x2* o8 = (u32x2*)(xb + (size_t)m * D) + lane;
#pragma unroll
        for (int j = 0; j < 4; ++j) { const f32x4 v = xc[j]; s += (v[0] * v[0] + v[1] * v[1]) + (v[2] * v[2] + v[3] * v[3]); u32x2 w; w.x = pk2(v[0], v[1]); w.y = pk2(v[2], v[3]); o8[64 * j] = w; }
        s = wave_sum(s);
        if (lane < 16) ssp[(size_t)m * 16 + lane] = (lane == 0) ? s : 0.f;
    }
}

__device__ __forceinline__ bf16x8 frag_row(const LAS unsigned char* base, int stride, int row0, int k0, int lane) {
    return *(const LAS bf16x8*)(base + (row0 + (lane & 15)) * stride + (k0 + 8 * (lane >> 4)) * 2);
}
__device__ __forceinline__ s16x4 lds_tr(const LAS unsigned char* p) { return __builtin_bit_cast(s16x4, __builtin_amdgcn_ds_read_tr16_b64_v4i16((LAS v4i16_t*)p)); }
__device__ __forceinline__ bf16x8 frag_tr(const LAS unsigned char* base, int stride, int r0, int c0, int lane) {
    const int i = lane & 15, q = i >> 2, p = i & 3, g = lane >> 4;
    const LAS unsigned char* a = base + (r0 + 8 * g + q) * stride + (c0 + 4 * p) * 2;
    const s16x4 lo = lds_tr(a), hi = lds_tr(a + 4 * stride);
    return (bf16x8){lo[0], lo[1], lo[2], lo[3], hi[0], hi[1], hi[2], hi[3]};
}
__device__ __forceinline__ bf16x8 frag_tr_perm(const LAS unsigned char* base, int stride, int r0, int c0, int lane) {
    const int i = lane & 15, q = i >> 2, p = i & 3, g = lane >> 4;
    const LAS unsigned char* a = base + (r0 + 4 * g + q) * stride + (c0 + 4 * p) * 2;
    const s16x4 lo = lds_tr(a), hi = lds_tr(a + 16 * stride);
    return (bf16x8){lo[0], lo[1], lo[2], lo[3], hi[0], hi[1], hi[2], hi[3]};
}
#define MFMA16(a, b, c) __builtin_amdgcn_mfma_f32_16x16x32_bf16((a), (b), (c), 0, 0, 0)

__device__ __forceinline__ void glow_pass(const Frame& F, int l) {
    const int lane = F.lane, fr = lane & 15, fq = lane >> 4;
    const bf16* wg = wsp<bf16>(F, WS_WGT) + (size_t)l * 16 * 1024;
    bf16x8 wf[32];
#pragma unroll
    for (int ks = 0; ks < 32; ++ks) wf[ks] = *(const bf16x8*)(wg + fr * 1024 + 32 * ks + 8 * fq);
    const bf16* xb = wsp<bf16>(F, WS_XB); const float* ssp = wsp<float>(F, WS_SSP); bf16* gl = wsp<bf16>(F, WS_GL);
    for (int m0 = 16 * (F.bid * 8 + F.wave); m0 < M; m0 += 16 * F.G * 8) {
        f32x4 acc = {0.f, 0.f, 0.f, 0.f};
        const bf16* xr = xb + (size_t)(m0 + fr) * D + 8 * fq;
        const float rs = row_rstd(ssp, m0 + fr);
#pragma unroll
        for (int kg = 0; kg < 4; ++kg) {
            u32x4 a8[8];
#pragma unroll
            for (int kk = 0; kk < 8; ++kk) a8[kk] = *(const u32x4*)(xr + 32 * (8 * kg + kk));
            CFENCE();
#pragma unroll
            for (int kk = 0; kk < 8; ++kk) acc = MFMA16(wf[8 * kg + kk], __builtin_bit_cast(bf16x8, a8[kk]), acc);
        }
        u32x2 o; o.x = cvt_pk_bf16(acc[0] * rs, acc[1] * rs); o.y = cvt_pk_bf16(acc[2] * rs, acc[3] * rs);
        *(u32x2*)(gl + (size_t)(m0 + fr) * 16 + 4 * fq) = o;
    }
}
constexpr int S5_USTR = 528, S5_SSTR = 272, S5_HSTR = 272;
__device__ __forceinline__ void s5_unit(const Frame& F, int l, int un) {
    const int b = un >> 5, g = un & 31, tid = F.tid, lane = F.lane, w = F.wave, fq = lane >> 4, fr = lane & 15;
    LAS unsigned char* hb = F.lds; LAS unsigned char* useg = F.lds + 64 * S5_HSTR; LAS unsigned char* slds = useg + 64 * S5_USTR;
    const bf16* PM = wsp<bf16>(F, WS_S5P) + (size_t)(l * 32 + g) * 128 * 256;
    const bf16* MQ = wsp<bf16>(F, WS_S5MQ) + (size_t)(l * 32 + g) * 256 * 384;
    bf16x8 pf[8], mq0[12], mq1[12];
#pragma unroll
    for (int ks = 0; ks < 8; ++ks) pf[ks] = *(const bf16x8*)(PM + (size_t)(16 * w + fr) * 256 + 32 * ks + 8 * fq);
#pragma unroll
    for (int ks = 0; ks < 12; ++ks) { mq0[ks] = *(const bf16x8*)(MQ + (size_t)(16 * w + fr) * 384 + 32 * ks + 8 * fq); mq1[ks] = *(const bf16x8*)(MQ + (size_t)(16 * (w + 8) + fr) * 384 + 32 * ks + 8 * fq); }
    const float* A16 = wsp<float>(F, WS_S5A16) + (size_t)(l * 32 + g) * 128;
    const float a_re = A16[(lane & 63) * 2], a_im = A16[(lane & 63) * 2 + 1];
    const f32x4 dsk = *(const f32x4*)(F.in[10] + l * 512 + g * 16 + 4 * fq);
    float hr = 0.f, hi = 0.f;
    const bf16* ug = wsp<bf16>(F, WS_UGM) + (size_t)((b * 32 + g) * 4096) * 16;
    bf16* ys5 = (bf16*)(F.dout + DO_YS5);
    u32x4 upre[4];
#pragma unroll
    for (int i = 0; i < 4; ++i) upre[i] = *(const u32x4*)(ug + (size_t)(tid + 512 * i) * 8);
    for (int seg = 0; seg < 4; ++seg) {
#pragma unroll
        for (int i = 0; i < 4; ++i) { const int idx = tid + 512 * i; *(LAS u32x4*)(useg + (idx >> 5) * S5_USTR + (idx & 31) * 16) = upre[i]; }
        if (seg < 3) {
#pragma unroll
            for (int i = 0; i < 4; ++i) upre[i] = *(const u32x4*)(ug + (size_t)(seg + 1) * 16384 + (size_t)(tid + 512 * i) * 8);
        }
        __syncthreads();
#ifndef PROBE_S5
#define PROBE_S5 0
#endif
#pragma unroll 1
        for (int pr1 = 0; pr1 < (PROBE_S5 == 1 ? 2 : 1); ++pr1)
        {
            f32x4 acc4[4];
#pragma unroll
            for (int nt = 0; nt < 4; ++nt) acc4[nt] = (f32x4){0.f, 0.f, 0.f, 0.f};
#pragma unroll
            for (int kb = 0; kb < 8; kb += 2) {
                bf16x8 ub[2][4];
#pragma unroll
                for (int ks = 0; ks < 2; ++ks)
#pragma unroll
                    for (int nt = 0; nt < 4; ++nt) ub[ks][nt] = frag_row(useg, S5_USTR, 16 * nt, 32 * (kb + ks), lane);
                __builtin_amdgcn_sched_barrier(0);
#pragma unroll
                for (int ks = 0; ks < 2; ++ks)
#pragma unroll
                    for (int nt = 0; nt < 4; ++nt) acc4[nt] = MFMA16(ub[ks][nt], pf[kb + ks], acc4[nt]);
                __builtin_amdgcn_sched_barrier(0);
            }
#pragma unroll
            for (int nt = 0; nt < 4; ++nt) *(LAS f32x4*)(slds + (16 * w + fr) * S5_SSTR + (16 * nt + 4 * fq) * 4) = acc4[nt];
        }
        __syncthreads();
        if (w == 0) {
            const LAS unsigned char* sre = slds + lane * S5_SSTR; const LAS unsigned char* sim = slds + (64 + lane) * S5_SSTR;
            const float hr0 = hr, hi0 = hi;
            const f32x2 are2 = {a_re, a_re}, aim2 = {-a_im, a_im};
#pragma unroll 1
            for (int pr2 = 0; pr2 < (PROBE_S5 == 2 ? 2 : 1); ++pr2) { hr = hr0; hi = hi0;
#pragma unroll 1
            for (int n0 = 0; n0 < 64; n0 += 16) {
                LAS unsigned char* hw = hb + n0 * S5_HSTR + lane * 2;
                f32x4 cr4[4], ci4[4];
#pragma unroll
                for (int q = 0; q < 4; ++q) { cr4[q] = *(const LAS f32x4*)(sre + n0 * 4 + q * 16); ci4[q] = *(const LAS f32x4*)(sim + n0 * 4 + q * 16); }
                CFENCE();
#pragma unroll
                for (int j = 0; j < 16; ++j) {
                    const f32x2 s2 = {cr4[j >> 2][j & 3], ci4[j >> 2][j & 3]};
                    const unsigned hp = cvt_pk_bf16(hr, hi);
                    *(LAS unsigned short*)(hw + j * S5_HSTR) = (unsigned short)hp; *(LAS unsigned short*)(hw + j * S5_HSTR + 128) = (unsigned short)(hp >> 16);
                    const f32x2 hv = {hr, hi}, hx = {hi, hr};
                    const f32x2 nh = hv * are2 + (hx * aim2 + s2);
                    hr = nh[0]; hi = nh[1];
                }
            }
            }
        }
        __syncthreads();
#pragma unroll 1
        for (int pr3 = 0; pr3 < (PROBE_S5 == 3 ? 2 : 1); ++pr3)
#pragma unroll
        for (int nt = 0; nt < 4; ++nt) {
            f32x4 a0 = {0.f, 0.f, 0.f, 0.f}, a1 = {0.f, 0.f, 0.f, 0.f};
#pragma unroll
            for (int kb = 0; kb < 12; kb += 4) {
                bf16x8 bb[4];
#pragma unroll
                for (int ks = 0; ks < 4; ++ks) bb[ks] = (kb < 8) ? frag_row(useg, S5_USTR, 16 * nt, 32 * (kb + ks), lane) : frag_row(hb, S5_HSTR, 16 * nt, 32 * ks, lane);
                __builtin_amdgcn_sched_barrier(0);
#pragma unroll
                for (int ks = 0; ks < 4; ++ks) { a0 = MFMA16(mq0[kb + ks], bb[ks], a0); a1 = MFMA16(mq1[kb + ks], bb[ks], a1); }
                __builtin_amdgcn_sched_barrier(0);
            }
            const int chunk = 16 * nt + fr;
#pragma unroll
            for (int hh = 0; hh < 2; ++hh) {
                const int t = w + 8 * hh; const f32x4 a = hh ? a1 : a0;
                const u32x2 uu = *(const LAS u32x2*)(useg + chunk * S5_USTR + (t * 16 + 4 * fq) * 2);
                const float y0 = gelu_tanh(a[0] + dsk[0] * bflo(uu.x)), y1 = gelu_tanh(a[1] + dsk[1] * bfhi(uu.x)), y2 = gelu_tanh(a[2] + dsk[2] * bflo(uu.y)), y3 = gelu_tanh(a[3] + dsk[3] * bfhi(uu.y));
                u32x2 o; o.x = cvt_pk_bf16(y0, y1); o.y = cvt_pk_bf16(y2, y3);
                const int token = b * 4096 + seg * 1024 + chunk * 16 + t;
                *(u32x2*)(ys5 + (size_t)token * 512 + g * 16 + 4 * fq) = o;
            }
        }
        __syncthreads();
    }
}

constexpr int GL_TSTR = 144;
__device__ __forceinline__ void gla_ld_tile(const bf16* g, int pitch, u32x4 (&r)[8], int lane) {
#pragma unroll
    for (int i = 0; i < 8; ++i) { const int idx = lane + 64 * i; r[i] = *(const u32x4*)(g + (size_t)(idx >> 3) * pitch + (idx & 7) * 8); }
}
__device__ __forceinline__ void gla_st_tile(LAS unsigned char* img, const u32x4 (&r)[8], int lane) {
#pragma unroll
    for (int i = 0; i < 8; ++i) { const int idx = lane + 64 * i; *(LAS u32x4*)(img + (idx >> 3) * GL_TSTR + (idx & 7) * 16) = r[i]; }
}
__device__ __forceinline__ void gla_loga_tile(const Frame& F, int l, int row0, int h, LAS unsigned char* img, int lane_) {
    int lane = lane_; asm volatile("" : "+v"(lane));
    const int fr = lane & 15, fq = lane >> 4;
    const bf16* wa = wsp<bf16>(F, WS_WA2T) + (size_t)l * 256 * 16 + (size_t)(h * 64) * 16; const bf16* gl = wsp<bf16>(F, WS_GL) + (size_t)row0 * 16;
    const float* ba = F.in[15] + l * 256 + h * 64;
    bf16x8 af[4], bfr[4];
    const u32x4 zero4 = {0u, 0u, 0u, 0u};
#pragma unroll
    for (int i = 0; i < 4; ++i) {
        const u32x4 a = (fq < 2) ? *(const u32x4*)(wa + (size_t)(16 * i + fr) * 16 + 8 * fq) : zero4;
        const u32x4 b = (fq < 2) ? *(const u32x4*)(gl + (size_t)(16 * i + fr) * 16 + 8 * fq) : zero4;
        af[i] = __builtin_bit_cast(bf16x8, a); bfr[i] = __builtin_bit_cast(bf16x8, b);
    }
    float b44[4];
#pragma unroll
    for (int mt = 0; mt < 4; ++mt) b44[mt] = ba[16 * mt + fr];
    CFENCE();
#pragma unroll
    for (int mt = 0; mt < 4; ++mt) {
        const float b1 = b44[mt];
#pragma unroll
        for (int nt = 0; nt < 4; ++nt) {
            f32x4 z = {0.f, 0.f, 0.f, 0.f};
            z = MFMA16(bfr[nt], af[mt], z);
            float la[4];
#pragma unroll
            for (int j = 0; j < 4; ++j) { const float v = z[j] + b1; la[j] = (fminf(v, 0.f) - __logf(1.0f + __expf(-fabsf(v)))) * 0.0625f; }
            u32x2 o; o.x = cvt_pk_bf16(la[0], la[1]); o.y = cvt_pk_bf16(la[2], la[3]);
            *(LAS u32x2*)(img + (16 * mt + fr) * GL_TSTR + (16 * nt + 4 * fq) * 2) = o;
        }
    }
}
__device__ __forceinline__ void gla_row(const LAS unsigned char* img, int lane, u32x4 (&r)[8]) {
#pragma unroll
    for (int i = 0; i < 8; ++i) r[i] = *(const LAS u32x4*)(img + lane * GL_TSTR + i * 16);
}
#define GLA_ROWV(r, t) ((((t) & 1) ? bfhi((r)[(t) >> 3][((t) >> 1) & 3]) : bflo((r)[(t) >> 3][((t) >> 1) & 3])))
__device__ __forceinline__ float gla_col(const LAS unsigned char* img, int t, int lane) { return bf2f(*(const LAS bf16*)(img + t * GL_TSTR + lane * 2)); }
__device__ __forceinline__ void gla_a_unit(const Frame& F, int l, int wu) {
    const int lane = F.lane, fq = lane >> 4, fr = lane & 15;
    const int bh = wu >> 6, n = wu & 63, b = bh >> 2, h = bh & 3, row0 = b * 4096 + n * 64;
    LAS unsigned char* ra = F.lds + F.wave * WAVE_LDS; LAS unsigned char* rb = ra + 64 * GL_TSTR;
    const bf16* vp = wsp<bf16>(F, WS_V) + (size_t)row0 * 512 + h * 128;
    u32x4 t1[8], tv[8];
    gla_ld_tile(wsp<bf16>(F, WS_K) + (size_t)row0 * 256 + h * 64, 256, t1, lane);
    gla_ld_tile(vp, 512, tv, lane);
    gla_loga_tile(F, l, row0, h, ra, lane);
    gla_st_tile(rb, t1, lane);
    CFENCE();
    u32x4 lg[8]; gla_row(ra, lane, lg);
    float tot = 0.f;
#pragma unroll
    for (int t = 0; t < 64; ++t) tot += GLA_ROWV(lg, t);
    wsp<float>(F, WS_DEC)[(size_t)wu * 64 + lane] = __expf(tot);
    float cum = 0.f; u32x4 pk[8];
#pragma unroll
    for (int t8 = 0; t8 < 8; ++t8) {
        float ke[8], kc[8];
#pragma unroll
        for (int tt = 0; tt < 8; ++tt) kc[tt] = gla_col(rb, t8 * 8 + tt, lane);
        CFENCE();
#pragma unroll
        for (int tt = 0; tt < 8; ++tt) { const int t = t8 * 8 + tt; cum += GLA_ROWV(lg, t); ke[tt] = kc[tt] * __expf(tot - cum); }
        pk[t8].x = cvt_pk_bf16(ke[0], ke[1]); pk[t8].y = cvt_pk_bf16(ke[2], ke[3]); pk[t8].z = cvt_pk_bf16(ke[4], ke[5]); pk[t8].w = cvt_pk_bf16(ke[6], ke[7]);
    }
    CFENCE();
#pragma unroll
    for (int t8 = 0; t8 < 8; ++t8) *(LAS u32x4*)(ra + lane * GL_TSTR + t8 * 16) = pk[t8];
    bf16* ut = (bf16*)(F.dout + DO_UT) + (size_t)wu * 8192;
#pragma unroll
    for (int hv = 0; hv < 2; ++hv) {
        CFENCE();
        gla_st_tile(rb, tv, lane);
        if (hv == 0) gla_ld_tile(vp + 64, 512, tv, lane);
        CFENCE();
#pragma unroll
        for (int mt = 0; mt < 4; ++mt)
#pragma unroll
            for (int nt = 0; nt < 4; ++nt) {
                f32x4 acc = {0.f, 0.f, 0.f, 0.f};
#pragma unroll
                for (int ks = 0; ks < 2; ++ks) acc = MFMA16(frag_row(ra, GL_TSTR, 16 * mt, 32 * ks, lane), frag_tr(rb, GL_TSTR, 32 * ks, 16 * nt, lane), acc);
                { u32x2 o; o.x = cvt_pk_bf16(acc[0], acc[1]); o.y = cvt_pk_bf16(acc[2], acc[3]);
                  *(u32x2*)(ut + (size_t)(hv * 64 + nt * 16 + fr) * 64 + mt * 16 + 4 * fq) = o; }
            }
    }
}
__device__ __forceinline__ void gla_b_scan(const Frame& F) {
    const bf16* ut = (const bf16*)(F.dout + DO_UT); bf16* st = (bf16*)(F.dout + DO_ST); const float* dec = wsp<float>(F, WS_DEC);
    LAS float* dl = (LAS float*)F.lds;
    for (int blk = F.bid; blk < 256; blk += F.G) {
        const int bh = blk >> 3, e = (blk & 7) * 1024 + F.tid * 2, k = e & 63;
        __syncthreads();
#pragma unroll
        for (int i = 0; i < 2; ++i) *(LAS f32x4*)(dl + (F.tid + 512 * i) * 4) = *(const f32x4*)(dec + (size_t)bh * 4096 + (size_t)(F.tid + 512 * i) * 4);
        __syncthreads();
        f32x2 s2 = {0.f, 0.f};
        const bf16* up = ut + (size_t)bh * 64 * 8192 + e; bf16* sp = st + (size_t)bh * 64 * 8192 + e;
#pragma unroll 1
        for (int n0 = 0; n0 < 64; n0 += 16) {
            unsigned u16[16];
#pragma unroll
            for (int j = 0; j < 16; ++j) u16[j] = *(const unsigned*)(up + (size_t)(n0 + j) * 8192);
#pragma unroll
            for (int j = 0; j < 16; ++j) {
                const f32x2 d = *(const LAS f32x2*)(dl + (n0 + j) * 64 + k);
                *(unsigned*)(sp + (size_t)(n0 + j) * 8192) = cvt_pk_bf16(s2[0], s2[1]);
                s2 = d * s2 + (f32x2){bflo(u16[j]), bfhi(u16[j])};
            }
        }
    }
}
__device__ __forceinline__ void gla_c_unit(const Frame& F, int l, int wu) {
    const int lane = F.lane, fq = lane >> 4, fr = lane & 15;
    const int bh = wu >> 6, n = wu & 63, b = bh >> 2, h = bh & 3, row0 = b * 4096 + n * 64;
    LAS unsigned char* qtt = F.lds + F.wave * WAVE_LDS; LAS unsigned char* ktt = qtt + 64 * GL_TSTR;
    const bf16* vp = wsp<bf16>(F, WS_V) + (size_t)row0 * 512 + h * 128;
    u32x4 t1[8], t2[8], tv[8];
    gla_loga_tile(F, l, row0, h, qtt, lane);
    CFENCE();
    gla_ld_tile(wsp<bf16>(F, WS_K) + (size_t)row0 * 256 + h * 64, 256, t1, lane);
    gla_ld_tile(wsp<bf16>(F, WS_Q) + (size_t)row0 * 256 + h * 64, 256, t2, lane);
    gla_st_tile(ktt, t1, lane);
    CFENCE();
    unsigned e1p[32]; float cum = 0.f; u32x4 pkk[8], pkq[8];
    u32x4 lg[8]; gla_row(qtt, lane, lg);
#pragma unroll
    for (int t8 = 0; t8 < 8; ++t8) {
        float kt[8], e8[8], kc[8];
#pragma unroll
        for (int tt = 0; tt < 8; ++tt) kc[tt] = gla_col(ktt, t8 * 8 + tt, lane);
        CFENCE();
#pragma unroll
        for (int tt = 0; tt < 8; ++tt) { const int t = t8 * 8 + tt; cum += GLA_ROWV(lg, t); e8[tt] = __expf(cum); kt[tt] = kc[tt] * __builtin_amdgcn_rcpf(e8[tt]); }
#pragma unroll
        for (int j = 0; j < 4; ++j) e1p[t8 * 4 + j] = cvt_pk_bf16(e8[2 * j], e8[2 * j + 1]);
        pkk[t8].x = cvt_pk_bf16(kt[0], kt[1]); pkk[t8].y = cvt_pk_bf16(kt[2], kt[3]); pkk[t8].z = cvt_pk_bf16(kt[4], kt[5]); pkk[t8].w = cvt_pk_bf16(kt[6], kt[7]);
    }
    CFENCE();
    gla_st_tile(qtt, t2, lane);
    gla_ld_tile(vp, 512, tv, lane);
    CFENCE();
#pragma unroll
    for (int t8 = 0; t8 < 8; ++t8) {
        float qt[8], qc[8];
#pragma unroll
        for (int tt = 0; tt < 8; ++tt) qc[tt] = gla_col(qtt, t8 * 8 + tt, lane);
        CFENCE();
#pragma unroll
        for (int tt = 0; tt < 8; ++tt) { const int t = t8 * 8 + tt; const unsigned ep = e1p[t >> 1]; qt[tt] = qc[tt] * ((t & 1) ? bfhi(ep) : bflo(ep)) * 0.125f; }
        pkq[t8].x = cvt_pk_bf16(qt[0], qt[1]); pkq[t8].y = cvt_pk_bf16(qt[2], qt[3]); pkq[t8].z = cvt_pk_bf16(qt[4], qt[5]); pkq[t8].w = cvt_pk_bf16(qt[6], qt[7]);
    }
    CFENCE();
#pragma unroll
    for (int t8 = 0; t8 < 8; ++t8) { *(LAS u32x4*)(qtt + lane * GL_TSTR + t8 * 16) = pkq[t8]; *(LAS u32x4*)(ktt + lane * GL_TSTR + t8 * 16) = pkk[t8]; }
    CFENCE();
    u32x2 sc[4][4];
#pragma unroll
    for (int mt = 0; mt < 4; ++mt)
#pragma unroll
        for (int nt = 0; nt < 4; ++nt) {
            if (mt > nt) { sc[mt][nt] = (u32x2){0u, 0u}; continue; }
            f32x4 acc = {0.f, 0.f, 0.f, 0.f};
#pragma unroll
            for (int ks = 0; ks < 2; ++ks) acc = MFMA16(frag_tr(ktt, GL_TSTR, 32 * ks, 16 * mt, lane), frag_tr(qtt, GL_TSTR, 32 * ks, 16 * nt, lane), acc);
            if (mt == nt) {
#pragma unroll
                for (int rg = 0; rg < 4; ++rg) if (4 * fq + rg > fr) acc[rg] = 0.f;
            }
            sc[mt][nt].x = cvt_pk_bf16(acc[0], acc[1]); sc[mt][nt].y = cvt_pk_bf16(acc[2], acc[3]);
        }
    const bf16* st = (const bf16*)(F.dout + DO_ST) + (size_t)wu * 8192;
    f32x4 o[8][4];
#pragma unroll
    for (int hv = 0; hv < 2; ++hv) {
        CFENCE();
        gla_st_tile(ktt, tv, lane);
        CFENCE();
#pragma unroll
        for (int dt = 0; dt < 4; ++dt) {
            const int dvt = hv * 4 + dt;
            bf16x8 sfr[2], vfr[2];
#pragma unroll
            for (int ks = 0; ks < 2; ++ks) { sfr[ks] = *(const bf16x8*)(st + (size_t)(dvt * 16 + fr) * 64 + 32 * ks + 8 * fq); vfr[ks] = frag_tr_perm(ktt, GL_TSTR, 32 * ks, 16 * dt, lane); }
#pragma unroll
            for (int nt = 0; nt < 4; ++nt) {
                f32x4 acc = {0.f, 0.f, 0.f, 0.f};
#pragma unroll
                for (int ks = 0; ks < 2; ++ks) {
                    if (2 * ks <= nt) {
                        const u32x4 bw = {sc[2 * ks][nt].x, sc[2 * ks][nt].y, sc[2 * ks + 1][nt].x, sc[2 * ks + 1][nt].y};
                        acc = MFMA16(vfr[ks], __builtin_bit_cast(bf16x8, bw), acc);
                    }
                    acc = MFMA16(sfr[ks], frag_tr(qtt, GL_TSTR, 32 * ks, 16 * nt, lane), acc);
                }
                o[dvt][nt] = acc;
            }
        }
        if (hv == 0) gla_ld_tile(vp + 64, 512, tv, lane);
    }
    const float* gn = F.in[16] + l * 512 + h * 128;
    const bf16* rp = wsp<bf16>(F, WS_R) + (size_t)row0 * 512 + h * 128;
    bf16* mx = wsp<bf16>(F, WS_MIXED) + (size_t)row0 * D + 512 + h * 128;
    float rs4[4];
#pragma unroll
    for (int nt = 0; nt < 4; ++nt) {
        float ss = 0.f;
#pragma unroll
        for (int dvt = 0; dvt < 8; ++dvt) { const f32x4 x = o[dvt][nt]; ss += (x[0] * x[0] + x[1] * x[1]) + (x[2] * x[2] + x[3] * x[3]); }
        ss += __shfl_xor(ss, 16); ss += __shfl_xor(ss, 32);
        rs4[nt] = rsqrtf(ss * (1.0f / 128.0f) + EPS);
    }
    f32x4 gN = *(const f32x4*)(gn + 4 * fq); u32x2 rN[4];
#pragma unroll
    for (int nt = 0; nt < 4; ++nt) rN[nt] = *(const u32x2*)(rp + (size_t)(16 * nt + fr) * 512 + 4 * fq);
#pragma unroll
    for (int dvt = 0; dvt < 8; ++dvt) {
        const int dv = 16 * dvt + 4 * fq;
        const f32x4 g = gN; u32x2 rc[4];
#pragma unroll
        for (int nt = 0; nt < 4; ++nt) rc[nt] = rN[nt];
        if (dvt < 7) {
            gN = *(const f32x4*)(gn + dv + 16);
#pragma unroll
            for (int nt = 0; nt < 4; ++nt) rN[nt] = *(const u32x2*)(rp + (size_t)(16 * nt + fr) * 512 + dv + 16);
        }
        CFENCE();
#pragma unroll
        for (int nt = 0; nt < 4; ++nt) {
            const int i = 16 * nt + fr; const float rs = rs4[nt]; const u32x2 rr = rc[nt]; const f32x4 x = o[dvt][nt];
            u32x2 w; w.x = cvt_pk_bf16(x[0] * rs * g[0] * siluf_(bflo(rr.x)), x[1] * rs * g[1] * siluf_(bfhi(rr.x))); w.y = cvt_pk_bf16(x[2] * rs * g[2] * siluf_(bflo(rr.y)), x[3] * rs * g[3] * siluf_(bfhi(rr.y)));
            *(u32x2*)(mx + (size_t)i * D + dv) = w;
        }
    }
}
__device__ __forceinline__ void s5_fin_row(const Frame& F, int l, int row) {
    const bf16* y = wsp<bf16>(F, WS_UGM) + (size_t)row * 512; const int lane = F.lane;
#ifdef EXP_NO_S5
    const u32x4 a = {0u, 0u, 0u, 0u};
#else
    const u32x4 a = *((const u32x4*)y + lane);
#endif
    float v[8] = {bflo(a.x), bfhi(a.x), bflo(a.y), bfhi(a.y), bflo(a.z), bfhi(a.z), bflo(a.w), bfhi(a.w)}; float s = 0.f;
#pragma unroll
    for (int j = 0; j < 8; ++j) s += v[j] * v[j];
    s = wave_sum(s); const float rs = rsqrtf(s * (1.0f / 512.0f) + EPS);
    const float* gn = F.in[13] + l * 512 + lane * 8; const f32x4 g0 = *(const f32x4*)gn, g1 = *(const f32x4*)(gn + 4);
    u32x4 w; w.x = cvt_pk_bf16(v[0] * rs * g0[0], v[1] * rs * g0[1]); w.y = cvt_pk_bf16(v[2] * rs * g0[2], v[3] * rs * g0[3]); w.z = cvt_pk_bf16(v[4] * rs * g1[0], v[5] * rs * g1[1]); w.w = cvt_pk_bf16(v[6] * rs * g1[2], v[7] * rs * g1[3]);
    *((u32x4*)(wsp<bf16>(F, WS_MIXED) + (size_t)row * D) + lane) = w;
}
__device__ __forceinline__ void moe_router(const Frame& F) {
    const int lane = F.lane, fr = lane & 15, fq = lane >> 4;
    const float* gain = F.in[18] + D; const float* wr_ = F.in[22];
    constexpr int RT_OFF = 16384, RT_STR = 2064;
    {
        const int k0 = 2 * F.tid;
        const f32x2 g2 = *(const f32x2*)(gain + k0);
        const f32x4 wa = *(const f32x4*)(wr_ + k0 * 8), wb = *(const f32x4*)(wr_ + k0 * 8 + 4), wc_ = *(const f32x4*)(wr_ + k0 * 8 + 8), wd = *(const f32x4*)(wr_ + k0 * 8 + 12);
        const float w0[8] = {wa[0], wa[1], wa[2], wa[3], wb[0], wb[1], wb[2], wb[3]}, w1_[8] = {wc_[0], wc_[1], wc_[2], wc_[3], wd[0], wd[1], wd[2], wd[3]};
#pragma unroll
        for (int e = 0; e < 8; ++e) {
            const float a = g2[0] * w0[e], b2 = g2[1] * w1_[e];
            const unsigned ah = f2bf(a), bh = f2bf(b2), al = f2bf(a - bf2f(ah)), bl = f2bf(b2 - bf2f(bh));
            *(LAS unsigned*)(F.lds + RT_OFF + e * RT_STR + k0 * 2) = ah | (bh << 16);
            *(LAS unsigned*)(F.lds + RT_OFF + (8 + e) * RT_STR + k0 * 2) = al | (bl << 16);
        }
    }
    __syncthreads();
    bf16x8 wf[32];
#pragma unroll
    for (int ks = 0; ks < 32; ++ks) wf[ks] = *(const LAS bf16x8*)(F.lds + RT_OFF + fr * RT_STR + (32 * ks + 8 * fq) * 2);
    const bf16* xb = wsp<bf16>(F, WS_XB); int* tok = wsp<int>(F, WS_TOK); float* wl = wsp<float>(F, WS_WL); float* rl = wsp<float>(F, WS_RL);
    unsigned* cnt = wsp<unsigned>(F, WS_CTL) + CW_CNT;
    LAS int* lcnt = (LAS int*)F.lds; LAS int* lbase = lcnt + 16; LAS int* rinfo = lbase + 16; LAS float* rw = (LAS float*)(rinfo + 1024); LAS float* rr = rw + 1024;
    const int rows_per_wg = ((M + F.G - 1) / F.G + 15) & ~15, r0 = F.bid * rows_per_wg, r1 = (r0 + rows_per_wg < M) ? r0 + rows_per_wg : M;
    if (F.tid < 16) lcnt[F.tid] = 0;
    __syncthreads();
    for (int m0 = r0 + 16 * F.wave; m0 < r1; m0 += 128) {
        f32x4 acc = {0.f, 0.f, 0.f, 0.f}; float ss = 0.f;
        const bf16* xr = xb + (size_t)(m0 + fr) * D + 8 * fq;
#pragma unroll
        for (int kg = 0; kg < 4; ++kg) {
            u32x4 a8[8];
#pragma unroll
            for (int kk = 0; kk < 8; ++kk) a8[kk] = *(const u32x4*)(xr + 32 * (8 * kg + kk));
            CFENCE();
#pragma unroll
            for (int kk = 0; kk < 8; ++kk) {
                const u32x4 a = a8[kk];
                const float x0 = bflo(a.x), x1 = bfhi(a.x), x2 = bflo(a.y), x3 = bfhi(a.y), x4 = bflo(a.z), x5 = bfhi(a.z), x6 = bflo(a.w), x7 = bfhi(a.w);
                ss += (x0 * x0 + x1 * x1) + (x2 * x2 + x3 * x3) + (x4 * x4 + x5 * x5) + (x6 * x6 + x7 * x7);
                acc = MFMA16(wf[8 * kg + kk], __builtin_bit_cast(bf16x8, a), acc);
            }
        }
        ss += __shfl_xor(ss, 16); ss += __shfl_xor(ss, 32);
        float lg4[4];
#pragma unroll
        for (int j = 0; j < 4; ++j) lg4[j] = acc[j] + __shfl_xor(acc[j], 32);
        float lg[8];
#pragma unroll
        for (int j = 0; j < 4; ++j) { const float o = __shfl_xor(lg4[j], 16); lg[j] = (fq & 1) ? o : lg4[j]; lg[4 + j] = (fq & 1) ? lg4[j] : o; }
        const float rs = rsqrtf(ss * (1.0f / D) + EPS);
        int e1 = 0; float l1 = lg[0];
#pragma unroll
        for (int e = 1; e < 8; ++e) if (lg[e] > l1) { l1 = lg[e]; e1 = e; }
        int e2 = -1; float l2 = -3.0e38f;
#pragma unroll
        for (int e = 0; e < 8; ++e) if (e != e1 && lg[e] > l2) { l2 = lg[e]; e2 = e; }
        const float w1 = 1.0f / (1.0f + __expf((l2 - l1) * rs));
        if (fq == 0) {
            const int p1 = __hip_atomic_fetch_add(lcnt + e1, 1, __ATOMIC_RELAXED, __HIP_MEMORY_SCOPE_WORKGROUP);
            const int p2 = __hip_atomic_fetch_add(lcnt + 8 + e2, 1, __ATOMIC_RELAXED, __HIP_MEMORY_SCOPE_WORKGROUP);
            const int i = m0 + fr - r0; rinfo[i] = e1 | (e2 << 4) | (p1 << 8) | (p2 << 20); rw[i] = w1; rr[i] = rs;
        }
    }
    __syncthreads();
    if (F.tid < 16) lbase[F.tid] = (int)__hip_atomic_fetch_add(cnt + F.tid, (unsigned)lcnt[F.tid], __ATOMIC_RELAXED, __HIP_MEMORY_SCOPE_AGENT);
    __syncthreads();
    for (int i = F.tid; i < r1 - r0; i += 512) {
        const int inf = rinfo[i], e1 = inf & 15, e2 = (inf >> 4) & 15, p1 = lbase[e1] + ((inf >> 8) & 4095), p2 = lbase[8 + e2] + ((inf >> 20) & 4095);
        const float w1 = rw[i], rs = rr[i];
        tok[e1 * 32768 + p1] = r0 + i; wl[e1 * 32768 + p1] = w1; rl[e1 * 32768 + p1] = rs;
        tok[(8 + e2) * 32768 + p2] = r0 + i; wl[(8 + e2) * 32768 + p2] = 1.0f - w1; rl[(8 + e2) * 32768 + p2] = rs;
    }
    __syncthreads();
}
__device__ __forceinline__ void final_norm(const Frame& F, bool from_xb) {
    const int lane = F.lane, gw = F.bid * 8 + F.wave, NGW = F.G * 8;
    const bf16* xo = from_xb ? wsp<bf16>(F, WS_XB) : wsp<bf16>(F, WS_XO); const float* g = F.in[26]; float* out = (float*)F.dout;
    for (int m = gw; m < M; m += NGW) {
        const u32x4 a0 = *((const u32x4*)(xo + (size_t)m * D) + lane), a1 = *((const u32x4*)(xo + (size_t)m * D + 512) + lane);
        const float x[16] = {bflo(a0.x), bfhi(a0.x), bflo(a0.y), bfhi(a0.y), bflo(a0.z), bfhi(a0.z), bflo(a0.w), bfhi(a0.w), bflo(a1.x), bfhi(a1.x), bflo(a1.y), bfhi(a1.y), bflo(a1.z), bfhi(a1.z), bflo(a1.w), bfhi(a1.w)};
        float ss = 0.f;
#pragma unroll
        for (int j = 0; j < 16; ++j) ss += x[j] * x[j];
        ss = wave_sum(ss); const float rs = rsqrtf(ss * (1.0f / D) + EPS);
#pragma unroll
        for (int hh = 0; hh < 2; ++hh) {
            const f32x4 g0 = *(const f32x4*)(g + hh * 512 + lane * 8), g1 = *(const f32x4*)(g + hh * 512 + lane * 8 + 4);
            f32x4 o0 = {x[hh * 8 + 0] * rs * g0[0], x[hh * 8 + 1] * rs * g0[1], x[hh * 8 + 2] * rs * g0[2], x[hh * 8 + 3] * rs * g0[3]};
            f32x4 o1 = {x[hh * 8 + 4] * rs * g1[0], x[hh * 8 + 5] * rs * g1[1], x[hh * 8 + 6] * rs * g1[2], x[hh * 8 + 7] * rs * g1[3]};
            *(f32x4*)(out + (size_t)m * D + hh * 512 + lane * 8) = o0; *(f32x4*)(out + (size_t)m * D + hh * 512 + lane * 8 + 4) = o1;
        }
    }
}

__global__ void __launch_bounds__(512, 2) mk_fwd(Args args) {
    extern __shared__ __attribute__((aligned(16))) unsigned char lds_raw[];
    Frame F0;
    F0.lds = (LAS unsigned char*)lds_raw; F0.tid = threadIdx.x; F0.lane = F0.tid & 63; F0.wave = __builtin_amdgcn_readfirstlane(F0.tid >> 6);
    F0.G = gridDim.x; F0.bid = blockIdx.x; F0.in = args.in; F0.ws = args.ws; F0.dout = (unsigned char*)args.out;
    const Frame& F = F0;
    volatile LAS unsigned* MISC = (volatile LAS unsigned*)(F.lds + MISC_OFF);
    for (int u = F.tid; u < (LDS_BYTES - MISC_OFF) / 4; u += 512) MISC[u] = 0u;
    __syncthreads();
#if MK_N_LAUNCHES == 1
    XcdBarrier bar = xcd_barrier_post(wsp<unsigned>(F, WS_CTL) + CW_BAR, MISC);
#define GRID_BAR() xcd_barrier(bar)
#else
#define GRID_BAR() do {} while (0)
#endif
    const int lo = args.ph_lo, hi = args.ph_hi;
#ifndef PH_MASK
#define PH_MASK 0xFFFFFFu
#endif
#define IN(k) ((((PH_MASK) >> ((k) > 7 && (k) < 13 ? (k) - 7 : (k))) & 1u) && lo <= (k) && (k) < hi)
#define SEAM(k) do { if (IN(k) && IN((k) + 1)) GRID_BAR(); } while (0)
    LAS unsigned char* ring = F.lds;
#define xb wsp<bf16>(F, WS_XB)
#define ssp wsp<float>(F, WS_SSP)
#ifndef REP_PHASE
#define REP_PHASE (-1)
#endif
#ifndef REP_N
#define REP_N 0
#endif
#define REPS(k) (((k) == REP_PHASE) ? 1 + REP_N : 1)
#define REP_BEGIN(k) for (int rep = 0; rep < REPS(k); ++rep) {
#define REP_END(k) if (rep + 1 < REPS(k)) GRID_BAR(); }
    if (IN(0)) { REP_BEGIN(0) p0_prologue(launder(F0)); REP_END(0) } SEAM(0);

#pragma unroll 1
    for (int l = 0; l < 2; ++l) {
        const int pb = 1 + 7 * l;
        if (IN(pb)) {
            REP_BEGIN(1)
            const Frame F = launder(F0);
            pg8::ProbPlain P{xb, wsp<bf16>(F, WS_WIN) + (size_t)l * NPROJ * D, D, D, D};
            pg8::StaticOrder S; S.init(M / 256, 8, F.G, F.bid);
            EpiInproj E{ssp, F.ws + WS_ACT};
            pg8::gemm_phase(ring, P, S, E);
            glow_pass(launder(F0), l);
            REP_END(1)
        } SEAM(pb);
        if (IN(pb + 1)) {
            REP_BEGIN(2)
            const Frame F = launder(F0);
#ifndef PROBE_SUB
#define PROBE_SUB 0
#endif
#pragma unroll 1
            for (int pr = 0; pr < (PROBE_SUB == 1 ? 2 : 1); ++pr) for (int un = F.bid; un < 256; un += F.G) s5_unit(F, l, un);
#pragma unroll 1
            for (int pr = 0; pr < (PROBE_SUB == 2 ? 2 : 1); ++pr) for (int wu = F.bid * 8 + F.wave; wu < 2048; wu += F.G * 8) gla_a_unit(F, l, wu);
            REP_END(2)
        } SEAM(pb + 1);
        if (IN(pb + 2)) {
            REP_BEGIN(3)
            const Frame F = launder(F0);
            pg8::ProbPlain P{(const bf16*)(F.dout + DO_YS5), wsp<bf16>(F, WS_WGLU) + (size_t)l * 512 * 512, 512, 512, 512};
            pg8::StaticOrder S; S.init(M / 256, 2, F.G, F.bid);
            EpiGlu E{(const bf16*)(F.dout + DO_YS5), wsp<bf16>(F, WS_UGM), F.in[12] + l * 512};
            pg8::gemm_phase(ring, P, S, E);
#pragma unroll 1
            for (int pr = 0; pr < (PROBE_SUB == 3 ? 2 : 1); ++pr) gla_b_scan(launder(F0));
            REP_END(3)
        } SEAM(pb + 2);
        if (IN(pb + 3)) {
            REP_BEGIN(4)
            const Frame F = launder(F0);
#pragma unroll 1
            for (int pr = 0; pr < (PROBE_SUB == 4 ? 2 : 1); ++pr) for (int wu = F.bid * 8 + F.wave; wu < 2048; wu += F.G * 8) gla_c_unit(F, l, wu);
#pragma unroll 1
            for (int pr = 0; pr < (PROBE_SUB == 5 ? 2 : 1); ++pr) { const Frame F2 = launder(F0); for (int m = F2.bid * 8 + F2.wave; m < M; m += F2.G * 8) s5_fin_row(F2, l, m); }
            REP_END(4)
        } SEAM(pb + 3);
        if (IN(pb + 4)) {
            REP_BEGIN(5)
            const Frame F = launder(F0);
            pg8::ProbPlain P{wsp<bf16>(F, WS_MIXED), wsp<bf16>(F, WS_WOUT) + (size_t)l * D * D, D, D, D};
            pg8::StaticOrder S; S.init(M / 256, 4, F.G, F.bid);
            const bool want8 = (l == 0) ? (USE_F8_FFN != 0) : (USE_F8_MOE != 0);
            EpiResid E{xb, ssp, rep ? (bf16*)F.dout : xb, rep == 0, (want8 && rep == 0) ? wsp<unsigned char>(F, WS_X8) : nullptr, 1.0f};
            pg8::gemm_phase(ring, P, S, E);
            REP_END(5)
        } SEAM(pb + 4);
        if (l == 0) {
            if (IN(6)) {
                REP_BEGIN(6)
                const Frame F = launder(F0);
                constexpr int KU = USE_F8_FFN ? D / 2 : D;
                pg8::ProbPlainT<USE_F8_FFN != 0> P{USE_F8_FFN ? wsp<bf16>(F, WS_X8) : xb, wsp<bf16>(F, WS_WFGU), KU, KU, KU};
                pg8::StaticOrder S; S.init(M / 256, 2 * DFF / 256, F.G, F.bid);
                EpiSwigluT<USE_F8_FFN != 0> E{ssp, wsp<bf16>(F, WS_HD), DFF};
                pg8::gemm_phase(ring, P, S, E);
                REP_END(6)
            } SEAM(6);
            if (IN(7)) {
                REP_BEGIN(7)
                const Frame F = launder(F0);
                constexpr int KD = USE_F8_FFN ? DFF / 2 : DFF;
                pg8::ProbPlainT<USE_F8_FFN != 0, true> P{wsp<bf16>(F, WS_HD), wsp<bf16>(F, WS_WFD), KD, KD, KD};
                pg8::StaticOrder S; S.init(M / 256, 4, F.G, F.bid);
                EpiResid E{xb, ssp, rep ? (bf16*)F.dout : xb, rep == 0, nullptr, USE_F8_FFN ? 1.0f / (F8_SH * F8_SW_DN) : 1.0f};
                pg8::gemm_phase(ring, P, S, E);
                REP_END(7)
            } SEAM(7);
        }
    }
    if (IN(13)) { moe_router(launder(F0)); } SEAM(13);
#pragma unroll 1
    for (int s = 0; s < 5; ++s) {
        if (IN(14 + s)) {
            const Frame F = launder(F0);
            moe_build_tables(F);
            const MoeTab T = moe_tab(F);
            int nheavy = 0;
            if (s >= 1) {
                REP_BEGIN(15)
                constexpr int KD = DFE * MOE_ESZ / 2;
                ProbMoeDown P{((s - 1) & 1) ? (void*)wsp<bf16>(F, WS_H1) : (void*)F.dout, wsp<bf16>(F, WS_MD), KD, KD, KD};
                MoeOrder S; S.init(T, s - 1, 4, F.G, F.bid, 0, 0);
                nheavy = S.nheavy_next();
                EpiMoeDown E{wsp<int>(F, WS_TOK), wsp<float>(F, WS_WL), xb, wsp<bf16>(F, WS_XO), T, rep != 0};
                pg8::gemm_phase(ring, P, S, E);
                REP_END(15)
            }
            if (s < 4) {
                REP_BEGIN(14)
                constexpr int KU = D * MOE_ESZ / 2;
                ProbMoeUp P{USE_F8_MOE ? (const void*)wsp<unsigned char>(F, WS_X8) : (const void*)xb, wsp<bf16>(F, WS_MGU), wsp<int>(F, WS_TOK), T, KU, KU, KU};
                MoeOrder S; S.init(T, s, 2 * DFE / 256, F.G, F.bid, nheavy, 3);
                EpiSwigluMoe E{wsp<float>(F, WS_RL), (s & 1) ? (void*)wsp<bf16>(F, WS_H1) : (void*)F.dout, T};
                pg8::gemm_phase(ring, P, S, E);
                REP_END(14)
            }
        } SEAM(14 + s);
    }
    if (IN(19)) { REP_BEGIN(19) final_norm(launder(F0), hi > 50); REP_END(19) }
#undef xb
#undef ssp
#undef IN
#undef SEAM
}

extern "C" void kernel_launch(void* const* d_in, const int* in_sizes, int n_in, void* d_out, int out_size, void* d_ws, size_t ws_size, hipStream_t stream) {
    static int grid = 0;
    if (grid == 0) {
        if (n_in != 27 || in_sizes[0] != M * D || out_size != M * D || ws_size < WS_END) { fprintf(stderr, "kernel_launch: unexpected shapes (n_in %d, ws %zu < %zu?)\n", n_in, ws_size, (size_t)WS_END); grid = -1; return; }
        int dev = 0, cus = 0, per_cu = 0;
        if (hipGetDevice(&dev) != hipSuccess || hipDeviceGetAttribute(&cus, hipDeviceAttributeMultiprocessorCount, dev) != hipSuccess) { grid = -1; return; }
        if (hipFuncSetAttribute((const void*)mk_fwd, hipFuncAttributeMaxDynamicSharedMemorySize, LDS_BYTES) != hipSuccess) { fprintf(stderr, "kernel_launch: hipFuncSetAttribute failed\n"); grid = -1; return; }
        if (hipOccupancyMaxActiveBlocksPerMultiprocessor(&per_cu, (const void*)mk_fwd, 512, LDS_BYTES) != hipSuccess || per_cu < 1) fprintf(stderr, "kernel_launch: occupancy query says %d\n", per_cu);
        (void)hipGetLastError();
        grid = cus;
    }
    if (grid < 0) return;
    if (hipMemsetAsync((char*)d_ws + WS_CTL, 0, CTL_ZERO_BYTES, stream) != hipSuccess) return;
    Args a{};
    for (int i = 0; i < 27; ++i) a.in[i] = (const float*)d_in[i];
    a.out = (float*)d_out; a.ws = (unsigned char*)d_ws;
#if MK_N_LAUNCHES == 1
#ifdef PROBE_PREFIX
    a.ph_lo = 0; a.ph_hi = PROBE_PREFIX + 1;
    hipLaunchKernelGGL(mk_fwd, dim3(grid), dim3(512), LDS_BYTES, stream, a);
    if (hipMemsetAsync((char*)d_ws + WS_CTL, 0, CTL_ZERO_BYTES, stream) != hipSuccess) return;
#endif
    a.ph_lo = 0; a.ph_hi = NPHASE;
    hipLaunchKernelGGL(mk_fwd, dim3(grid), dim3(512), LDS_BYTES, stream, a);
#else
#ifdef EXP_STOP
    for (int p = 0; p <= EXP_STOP; ++p) { a.ph_lo = p; a.ph_hi = p + 1; hipLaunchKernelGGL(mk_fwd, dim3(grid), dim3(512), LDS_BYTES, stream, a); }
    a.ph_lo = 19; a.ph_hi = 100; hipLaunchKernelGGL(mk_fwd, dim3(grid), dim3(512), LDS_BYTES, stream, a);
#else
    for (int p = 0; p < NPHASE; ++p) { a.ph_lo = p; a.ph_hi = p + 1; hipLaunchKernelGGL(mk_fwd, dim3(grid), dim3(512), LDS_BYTES, stream, a); }
#endif
#endif
}
```

```cpp
#include <hip/hip_runtime.h>
#include <cstdio>
#include <cstdint>

#ifndef USE_F8_FFN
#define USE_F8_FFN 0
#endif
#ifndef USE_F8_MOE
#define USE_F8_MOE 1
#endif
#ifndef MK_N_LAUNCHES
#define MK_N_LAUNCHES 1
#endif

#define LAS __attribute__((address_space(3)))
#define GAS __attribute__((address_space(1)))
typedef unsigned short bf16;
typedef short bf16x8 __attribute__((ext_vector_type(8)));
typedef short s16x4 __attribute__((ext_vector_type(4)));
typedef short v4i16_t __attribute__((ext_vector_type(4)));
typedef float f32x4 __attribute__((ext_vector_type(4)));
typedef float f32x2 __attribute__((ext_vector_type(2)));
typedef unsigned u32x4 __attribute__((ext_vector_type(4)));
typedef unsigned u32x2 __attribute__((ext_vector_type(2)));
typedef int i32x4_t __attribute__((ext_vector_type(4)));

constexpr int BATCH = 8, SEQ = 4096, D = 1024, M = BATCH * SEQ;
constexpr int DS5 = 512, NGRP = 32, NST = 64;
constexpr int GH = 4, DK = 64, DV = 128, DGK = 256, DGV = 512, NCH = SEQ / 64;
constexpr int DIN = 2064, NPROJ = 2304;
constexpr int DFF = 2816, NE = 8, DFE = 3584;
constexpr float EPS = 1e-6f;
constexpr int NPHASE = 20;

constexpr size_t MiB = 1u << 20;
constexpr size_t WS_CTL = 0, CTL_ZERO_BYTES = 2 * MiB;
constexpr size_t WS_SSP = 2 * MiB;
constexpr size_t WS_WIN = 4 * MiB;
constexpr size_t WS_WGLU = 13 * MiB;
constexpr size_t WS_WOUT = 14 * MiB;
constexpr size_t WS_WFGU = 18 * MiB;
constexpr size_t WS_WFD = 29 * MiB;
constexpr size_t WS_S5P = 35 * MiB;
constexpr size_t WS_S5MQ = 39 * MiB;
constexpr size_t WS_S5A16 = 51 * MiB;
constexpr size_t WS_WGT = 51 * MiB + 65536;
constexpr size_t WS_WA2T = 51 * MiB + 131072;
constexpr size_t WS_MGU = 52 * MiB;
constexpr size_t WS_MD = (USE_F8_MOE ? 108 : 164) * MiB;
constexpr size_t WS_X8 = (USE_F8_MOE ? 136 : 500) * MiB;
static_assert(USE_F8_MOE || !USE_F8_FFN, "x8 lives in the space the fp8 expert weights leave free");
constexpr size_t WS_XB = 220 * MiB;
constexpr size_t WS_ACT = 284 * MiB;
constexpr size_t WS_UGM = WS_ACT;
constexpr size_t WS_Q = WS_ACT + 32 * MiB;
constexpr size_t WS_K = WS_ACT + 48 * MiB;
constexpr size_t WS_V = WS_ACT + 64 * MiB;
constexpr size_t WS_R = WS_ACT + 96 * MiB;
constexpr size_t WS_GL = WS_ACT + 128 * MiB;
constexpr size_t WS_MIXED = WS_ACT + 144 * MiB;
constexpr size_t WS_HD = WS_ACT;
constexpr size_t WS_H1 = WS_ACT;
constexpr size_t WS_XO = WS_ACT + 120 * MiB;
constexpr size_t WS_TOK = WS_ACT + 184 * MiB;
constexpr size_t WS_WL = WS_ACT + 186 * MiB;
constexpr size_t WS_RL = WS_ACT + 188 * MiB;
constexpr size_t WS_DEC = WS_ACT + 208 * MiB;
constexpr size_t WS_END = WS_ACT + 209 * MiB;
constexpr size_t DO_UT = 0, DO_ST = 64 * MiB, DO_YS5 = 96 * MiB;
constexpr int MOE_CAP_TILES = 68;
constexpr int CW_BAR = 4096;
constexpr int CW_CNT = 16384;

constexpr int RING_BYTES = 131072;
constexpr int MOE_TAB_OFF = 131072;
constexpr int MISC_OFF = 147456;
constexpr int LDS_BYTES = 148480;
constexpr int WAVE_LDS = 18432;

#define LDS_WAIT() asm volatile("s_waitcnt lgkmcnt(0)" ::: "memory")
#define VM_WAIT() asm volatile("s_waitcnt vmcnt(0)" ::: "memory")
#define CFENCE() asm volatile("" ::: "memory")
__device__ __forceinline__ unsigned f2bf(float f) { unsigned u = __builtin_bit_cast(unsigned, f); return (u + 0x7fffu + ((u >> 16) & 1u)) >> 16; }
__device__ __forceinline__ unsigned pk2(float lo, float hi) { return f2bf(lo) | (f2bf(hi) << 16); }
__device__ __forceinline__ float bf2f(unsigned b) { return __builtin_bit_cast(float, b << 16); }
__device__ __forceinline__ float bflo(unsigned w) { return __builtin_bit_cast(float, w << 16); }
__device__ __forceinline__ float bfhi(unsigned w) { return __builtin_bit_cast(float, w & 0xffff0000u); }
typedef __bf16 bf16x2_t __attribute__((ext_vector_type(2)));
__device__ __forceinline__ unsigned cvt_pk_bf16(float lo, float hi) { const f32x2 v = {lo, hi}; return __builtin_bit_cast(unsigned, __builtin_convertvector(v, bf16x2_t)); }
__device__ __forceinline__ unsigned pk4_fp8(float a, float b, float c, float d) {
    a = __builtin_amdgcn_fmed3f(a, -448.f, 448.f); b = __builtin_amdgcn_fmed3f(b, -448.f, 448.f); c = __builtin_amdgcn_fmed3f(c, -448.f, 448.f); d = __builtin_amdgcn_fmed3f(d, -448.f, 448.f);
    int w = 0; w = __builtin_amdgcn_cvt_pk_fp8_f32(a, b, w, false); w = __builtin_amdgcn_cvt_pk_fp8_f32(c, d, w, true); return (unsigned)w;
}
__device__ __forceinline__ f32x2 swiglu2(f32x2 g, f32x2 u, float nrs, float c) {
    const f32x2 t = g * nrs;
    f32x2 d = {__builtin_amdgcn_exp2f(t[0]), __builtin_amdgcn_exp2f(t[1])};
    d = d + 1.0f;
    const f32x2 r = {__builtin_amdgcn_rcpf(d[0]), __builtin_amdgcn_rcpf(d[1])};
    return (g * u) * (r * c);
}
constexpr float F8_SW_UP = 64.f, F8_SH = 4.f, F8_SW_DN = 128.f;
__device__ __forceinline__ float wave_sum(float v) {
#pragma unroll
    for (int o = 1; o < 64; o <<= 1) v += __shfl_xor(v, o);
    return v;
}
__device__ __forceinline__ float sigmoidf_(float z) { return __builtin_amdgcn_rcpf(1.0f + __expf(-z)); }
__device__ __forceinline__ float siluf_(float z) { return z * __builtin_amdgcn_rcpf(1.0f + __expf(-z)); }
__device__ __forceinline__ float gelu_tanh(float y) { const float z = 0.7978845608028654f * (y + 0.044715f * y * y * y); return y * __builtin_amdgcn_rcpf(1.0f + __expf(-2.0f * z)); }

#define XB_TMO      128
#define XB_XCNT(j)  (256  + 64 * (j))
#define XB_XSUB(j)  (1280 + 64 * (j))
#define XB_XGEN(j)  (2304 + 64 * (j))
#define XB_TOP      3328
#define XB_TOPGEN   3392
#define XCD_BAR_WORDS 3456
#define XB_SPIN_CAP (1u << 18)
__device__ __forceinline__ unsigned xb_ld(unsigned* p)              { return __hip_atomic_load(p, __ATOMIC_RELAXED, __HIP_MEMORY_SCOPE_AGENT); }
__device__ __forceinline__ unsigned xb_add(unsigned* p, unsigned v) { return __hip_atomic_fetch_add(p, v, __ATOMIC_RELAXED, __HIP_MEMORY_SCOPE_AGENT); }
__device__ __forceinline__ unsigned xb_xcc_id() { return (unsigned)__builtin_amdgcn_s_getreg((3 << 11) | 20) & 0xFu; }
#define XB_SPIN(cond, bar) do { unsigned _sp = 0; while (cond) { __builtin_amdgcn_s_sleep(1); \
    if ((++_sp & 255u) == 0u) { if (xb_ld(&(bar)[XB_TMO])) break; if (_sp > XB_SPIN_CAP) { atomicAdd(&(bar)[XB_TMO], 1u); break; } } } } while (0)
struct XcdBarrier { unsigned* bar; unsigned x; volatile LAS unsigned* st; };
__device__ __forceinline__ XcdBarrier xcd_barrier_post(unsigned* bar, volatile LAS unsigned* st) {
    XcdBarrier b; b.bar = bar; b.x = xb_xcc_id(); b.st = st;
    if (threadIdx.x == 0) (void)xb_add(&bar[XB_XCNT(b.x)], 1u);
    return b;
}
__device__ __forceinline__ void xcd_barrier_complete(unsigned* bar, unsigned x, unsigned& nloc, unsigned& nx) {
    const unsigned G = gridDim.x * gridDim.y * gridDim.z;
    unsigned sum, cnt, mine, sp = 0u;
    for (;;) {
        sum = 0u; cnt = 0u; mine = 0u;
#pragma unroll
        for (unsigned j = 0; j < 16; ++j) { const unsigned c = xb_ld(&bar[XB_XCNT(j)]); sum += c; cnt += (c > 0u) ? 1u : 0u; mine = (j == x) ? c : mine; }
        if (sum == G) break;
        __builtin_amdgcn_s_sleep(1);
        if ((++sp & 255u) == 0u) { if (xb_ld(&bar[XB_TMO])) break; if (sp > XB_SPIN_CAP) { atomicAdd(&bar[XB_TMO], 1u); break; } }
    }
    nloc = mine > 0u ? mine : 1u; nx = cnt > 0u ? cnt : 1u;
}
__device__ __forceinline__ void xcd_barrier(const XcdBarrier& b) {
    asm volatile("s_waitcnt vmcnt(0)" ::: "memory");
    __syncthreads();
    if (threadIdx.x == 0) {
        unsigned* bar = b.bar;
        __builtin_amdgcn_s_waitcnt(0);
        unsigned nloc = b.st[0], nx = b.st[1];
        if (nloc == 0u) { xcd_barrier_complete(bar, b.x, nloc, nx); b.st[0] = nloc; b.st[1] = nx; }
        const unsigned old = xb_add(&bar[XB_XSUB(b.x)], 1u);
        const unsigned gen = old / nloc;
        if (old + 1u == (gen + 1u) * nloc) {
            __builtin_amdgcn_fence(__ATOMIC_RELEASE, "agent");
            asm volatile("s_waitcnt vmcnt(0)" ::: "memory");
            const unsigned og = xb_add(&bar[XB_TOP], 1u);
            const unsigned tg = og / nx;
            if (og + 1u == (tg + 1u) * nx) xb_add(&bar[XB_TOPGEN], 1u);
            else XB_SPIN(xb_ld(&bar[XB_TOPGEN]) == tg, bar);
            __builtin_amdgcn_fence(__ATOMIC_ACQUIRE, "agent");
            xb_add(&bar[XB_XGEN(b.x)], 1u);
            asm volatile("s_waitcnt vmcnt(0)" ::: "memory");
        } else {
            XB_SPIN(xb_ld(&bar[XB_XGEN(b.x)]) == gen, bar);
            __builtin_amdgcn_fence(__ATOMIC_ACQUIRE, "agent");
            asm volatile("s_waitcnt vmcnt(0)" ::: "memory");
        }
    }
    __syncthreads();
}

namespace pg8 {
constexpr int BM = 256, BK = 64, HALF = 128, HTB = HALF * BK * 2, STAGE_BYTES = 8 * HTB, NXCD = 8, WGM = 8;
constexpr int A_TAB_OFF = 131072 + 8192;
constexpr int EPI_TAB_OFF = 131072 + 4096;
__host__ __device__ __forceinline__ int lds_byte(int r, int c) { const int st = (r >> 4) * 2 + (c >> 5), rr = r & 15, cc = c & 31, ob = rr * 64 + cc * 2; return st * 1024 + (ob ^ (((ob >> 9) & 1) << 5)); }
__host__ __device__ __forceinline__ void stage_rc(int b, int& R, int& C) { const int st = b / 1024, sb = b % 1024, swz = sb ^ (((sb >> 9) & 1) << 5); R = (st >> 1) * 16 + swz / 64; C = (st & 1) * 32 + (swz % 64) / 2; }
__host__ __device__ __forceinline__ int perm32(int rho) { const int n = rho >> 4, i = rho & 15; return 8 * (i >> 2) + 4 * n + (i & 3); }

struct Unit { int pm, pn, e, sub; };

struct StaticOrder {
    int nM, nN, nwg, G, c;
    __device__ __forceinline__ void init(int nM_, int nN_, int G_, int c_) { nM = nM_; nN = nN_; nwg = nM * nN; G = G_; c = c_; }
    __device__ __forceinline__ bool next(int i, Unit& u) const {
        const long L = (long)i * G + c; if (L >= nwg) return false;
        int wgid = (int)L; { const int q = nwg / NXCD, r = nwg % NXCD, xcd = wgid % NXCD, off = wgid / NXCD; wgid = (xcd < r ? xcd * (q + 1) : r * (q + 1) + (xcd - r) * q) + off; }
        const int nig = WGM * nN, gid = wgid / nig, fm = gid * WGM, gsz = (nM - fm) < WGM ? (nM - fm) : WGM;
        u.pm = fm + ((wgid % nig) % gsz); u.pn = (wgid % nig) / gsz; u.e = 0; u.sub = 0; return true;
    }
};

template <class Epi, class Sched, class Prob>
__device__ __forceinline__ void gemm_phase(LAS unsigned char* lds, const Prob& P, const Sched& S, const Epi& E) {
    int tid_ = threadIdx.x; asm volatile("" : "+v"(tid_));
    const int tid = tid_, wid = __builtin_amdgcn_readfirstlane(tid >> 6), lane = tid & 63, wr = wid >> 2, wc = wid & 3, fr = lane & 15, fq = lane >> 4;
    const int K = P.K, nt = K / BK;
    int Rr[2], Cc[2]; unsigned voffB[2];
#pragma unroll
    for (int i = 0; i < 2; ++i) { int R, C; stage_rc(tid * 16 + i * 8192, R, C); Rr[i] = R; Cc[i] = C; const int Rb = (R & ~31) + perm32(R & 31); voffB[i] = (unsigned)(Rb * P.ldb + C) * 2u; }
    const size_t kstep = (size_t)(BK * 2);
    const size_t hstepB = (size_t)HALF * P.ldb * 2;
    const unsigned ldsw = (unsigned)wid * 1024u;
    const int aoff = lds_byte(wr * 64 + fr, fq * 8), boff = lds_byte(wc * 32 + fr, fq * 8);
#define PG8_SA(b, h) (((b) * 2 + (h)) * HTB)
#define PG8_SB(b, h) ((4 + (b) * 2 + (h)) * HTB)
#define PG8_STAGE(bufoff, gbase, voff) do { _Pragma("unroll") for (int _i = 0; _i < 2; ++_i) \
        __builtin_amdgcn_global_load_lds((const unsigned*)((const char*)(gbase) + (voff)[_i]), (LAS unsigned*)(lds + (bufoff) + ldsw + _i * 8192), 16, 0, 0); } while (0)
#define PG8_LDA(dst, b, h) do { _Pragma("unroll") for (int m = 0; m < 4; ++m) _Pragma("unroll") for (int k = 0; k < 2; ++k) dst[m][k] = *(const LAS bf16x8*)(lds + PG8_SA(b, h) + aoff + m * 2048 + k * 1024); } while (0)
#define PG8_LDB(dst, b, h) do { _Pragma("unroll") for (int n = 0; n < 2; ++n) _Pragma("unroll") for (int k = 0; k < 2; ++k) dst[n][k] = *(const LAS bf16x8*)(lds + PG8_SB(b, h) + boff + n * 2048 + k * 1024); } while (0)
#define PG8_CAT(x) __builtin_shufflevector(__builtin_bit_cast(i32x4_t, (x)[0]), __builtin_bit_cast(i32x4_t, (x)[1]), 0, 1, 2, 3, 4, 5, 6, 7)
#define PG8_MMA(ai, bj, At, Bt) do { __builtin_amdgcn_s_setprio(1); _Pragma("unroll") for (int m = 0; m < 4; ++m) _Pragma("unroll") for (int n = 0; n < 2; ++n) { \
        if constexpr (Prob::F8) asm volatile("v_mfma_scale_f32_16x16x128_f8f6f4 %0, %1, %2, %0, %3, %3 op_sel_hi:[0,0,0]" : "+v"(acc[ai][bj][m][n]) : "v"(PG8_CAT(Bt[n])), "v"(PG8_CAT(At[m])), "v"(f8one)); \
        else { _Pragma("unroll") for (int k = 0; k < 2; ++k) acc[ai][bj][m][n] = __builtin_amdgcn_mfma_f32_16x16x32_bf16(Bt[n][k], At[m][k], acc[ai][bj][m][n], 0, 0, 0); } } \
        __builtin_amdgcn_s_setprio(0); } while (0)
#define PG8_WAIT_V(n) asm volatile("s_waitcnt vmcnt(" #n ")" ::: "memory")
#define PG8_WAIT_L(n) asm volatile("s_waitcnt lgkmcnt(" #n ")" ::: "memory")
#define PG8_BAR __builtin_amdgcn_s_barrier()
#define PG8_SCHED __builtin_amdgcn_sched_barrier(0)
    const int f8one = 0x7f7f7f7f;
    Unit cur, nxt; int ui = 0;
    if (!S.next(0, cur)) return;
    f32x4 acc[2][2][4][2];
#pragma unroll
    for (int a = 0; a < 2; ++a)
#pragma unroll
        for (int b = 0; b < 2; ++b)
#pragma unroll
            for (int m = 0; m < 4; ++m)
#pragma unroll
                for (int n = 0; n < 2; ++n) acc[a][b][m][n] = (f32x4){0.f, 0.f, 0.f, 0.f};
    bf16x8 At[4][2], B0[2][2], B1[2][2];
    constexpr bool GA = Prob::GATHER;
    constexpr int NH = GA ? 2 : 1;
    unsigned vA[NH][2], nvA[NH][2];
    const size_t hstepA = GA ? (size_t)0 : P.hstep_a();
    const size_t kstepA = P.kstep_a();
    P.a_off(cur, Rr, Cc, vA);
    const char* cA = P.a_ptr(cur); const char* cB = P.b_ptr(cur);
#define PG8_STAGEA(bufoff, gbase, h, arr) do { _Pragma("unroll") for (int _i = 0; _i < 2; ++_i) \
        __builtin_amdgcn_global_load_lds((const unsigned*)((const char*)(gbase) + (GA ? (size_t)0 : (size_t)(h) * hstepA) + (arr)[GA ? (h) : 0][_i]), (LAS unsigned*)(lds + (bufoff) + ldsw + _i * 8192), 16, 0, 0); } while (0)
    if constexpr (GA) { Unit u1; if (S.next(1, u1)) P.atab_issue(u1, lds + A_TAB_OFF + 1024, wid, lane); }
    PG8_STAGE(PG8_SB(0, 0), cB, voffB); PG8_STAGE(PG8_SB(0, 1), cB + hstepB, voffB); PG8_STAGEA(PG8_SA(0, 0), cA, 0, vA); PG8_STAGEA(PG8_SA(0, 1), cA, 1, vA);
    if (wr == 1) PG8_BAR;
    PG8_WAIT_V(2); PG8_BAR;
    PG8_STAGE(PG8_SB(1, 0), cB + kstep, voffB); PG8_STAGEA(PG8_SA(1, 0), cA + kstepA, 0, vA); PG8_STAGE(PG8_SB(1, 1), cB + hstepB + kstep, voffB);
    PG8_WAIT_V(6); PG8_BAR;
    for (;;) {
        const bool has_next = S.next(ui + 1, nxt);
        const char* nA = has_next ? P.a_ptr(nxt) : cA; const char* nB = has_next ? P.b_ptr(nxt) : cB;
        if constexpr (GA) {
            if (has_next) { int R2[2], C2[2], t2 = tid; asm volatile("" : "+v"(t2));
#pragma unroll
                for (int i = 0; i < 2; ++i) stage_rc(t2 * 16 + i * 8192, R2[i], C2[i]);
                P.a_off_tab(lds + A_TAB_OFF + ((ui + 1) & 1) * 1024, R2, C2, nvA);
                Unit n2; if (S.next(ui + 2, n2)) P.atab_issue(n2, lds + A_TAB_OFF + (ui & 1) * 1024, wid, lane); }
            else {
#pragma unroll
                for (int h = 0; h < NH; ++h)
#pragma unroll
                    for (int i = 0; i < 2; ++i) nvA[h][i] = vA[h][i];
            }
        }
        if constexpr (Epi::HAS_TAB) E.tab_issue(cur, lds + EPI_TAB_OFF + (ui & 1) * 2048, wid, lane);
        for (int t = 0; t < nt; t += 2) {
            const bool last = (t == nt - 2);
            const char* a1 = cA + (size_t)(t + 1) * kstepA;
            const char* a2 = last ? nA : cA + (size_t)(t + 2) * kstepA; const char* b2 = last ? nB : cB + (size_t)(t + 2) * kstep;
            const char* a3 = a2 + kstepA; const char* b3 = b2 + kstep;
            unsigned wA[NH][2];
#pragma unroll
            for (int h = 0; h < NH; ++h)
#pragma unroll
                for (int i = 0; i < 2; ++i) wA[h][i] = (GA && last) ? nvA[h][i] : vA[h][i];
            PG8_LDB(B0, 0, 0); PG8_LDB(B1, 0, 1); PG8_SCHED; PG8_LDA(At, 0, 0); PG8_STAGEA(PG8_SA(1, 1), a1, 1, vA);
            PG8_WAIT_V(8); PG8_WAIT_L(0); PG8_BAR; PG8_MMA(0, 0, At, B0); PG8_MMA(0, 1, At, B1); PG8_BAR; PG8_SCHED;
            PG8_LDA(At, 0, 1); PG8_STAGE(PG8_SB(0, 0), b2, voffB); PG8_STAGE(PG8_SB(0, 1), b2 + hstepB, voffB); PG8_STAGEA(PG8_SA(0, 0), a2, 0, wA);
            PG8_WAIT_V(8); PG8_WAIT_L(0); PG8_BAR; PG8_MMA(1, 0, At, B0); PG8_MMA(1, 1, At, B1); PG8_BAR; PG8_SCHED;
            PG8_LDB(B0, 1, 0); PG8_LDB(B1, 1, 1); PG8_SCHED; PG8_LDA(At, 1, 0); PG8_STAGEA(PG8_SA(0, 1), a2, 1, wA);
            PG8_WAIT_V(8); PG8_WAIT_L(0); PG8_BAR; PG8_MMA(0, 0, At, B0); PG8_MMA(0, 1, At, B1); PG8_BAR; PG8_SCHED;
            PG8_LDA(At, 1, 1); PG8_STAGE(PG8_SB(1, 0), b3, voffB); PG8_STAGE(PG8_SB(1, 1), b3 + hstepB, voffB); PG8_STAGEA(PG8_SA(1, 0), a3, 0, wA);
            PG8_WAIT_V(8); PG8_WAIT_L(0); PG8_BAR; PG8_MMA(1, 0, At, B0); PG8_MMA(1, 1, At, B1); PG8_BAR; PG8_SCHED;
        }
        if (wr == 0) PG8_BAR;
        if constexpr (Prob::F8) asm volatile("s_nop 15\n\ts_nop 7" ::: "memory");
        if constexpr (Epi::HAS_TAB) E(acc, cur, wr, wc, fr, fq, lds + EPI_TAB_OFF + (ui & 1) * 2048);
        else E(acc, cur, wr, wc, fr, fq);
        if (!has_next) break;
#pragma unroll
        for (int a = 0; a < 2; ++a)
#pragma unroll
            for (int b = 0; b < 2; ++b)
#pragma unroll
                for (int m = 0; m < 4; ++m)
#pragma unroll
                    for (int n = 0; n < 2; ++n) acc[a][b][m][n] = (f32x4){0.f, 0.f, 0.f, 0.f};
        cur = nxt; cA = nA; cB = nB; ++ui;
        if constexpr (GA) {
#pragma unroll
            for (int h = 0; h < NH; ++h)
#pragma unroll
                for (int i = 0; i < 2; ++i) vA[h][i] = nvA[h][i];
        }
        if (wr == 1) PG8_BAR;
    }
    PG8_WAIT_V(0);
    PG8_BAR;
#undef PG8_SA
#undef PG8_SB
#undef PG8_STAGE
#undef PG8_STAGEA
#undef PG8_LDA
#undef PG8_LDB
#undef PG8_MMA
#undef PG8_CAT
#undef PG8_WAIT_V
#undef PG8_WAIT_L
#undef PG8_BAR
#undef PG8_SCHED
}

template <bool F8_ = false, bool TILED_ = false> struct ProbPlainT {
    static constexpr bool GATHER = false, F8 = F8_;
    const bf16* A; const bf16* Bt; int lda, ldb, K;
    __device__ __forceinline__ const char* a_ptr(const Unit& u) const { return TILED_ ? (const char*)A + (size_t)u.pm * (K / BK) * 32768 : (const char*)(A + (size_t)u.pm * BM * lda); }
    __device__ __forceinline__ const char* b_ptr(const Unit& u) const { return (const char*)(Bt + (size_t)u.pn * BM * ldb); }
    __device__ __forceinline__ size_t hstep_a() const { return TILED_ ? (size_t)4096 : (size_t)HALF * lda * 2; }
    __device__ __forceinline__ size_t kstep_a() const { return TILED_ ? (size_t)32768 : (size_t)(BK * 2); }
    __device__ __forceinline__ void a_off(const Unit&, const int (&R)[2], const int (&C)[2], unsigned (&off)[1][2]) const {
#pragma unroll
        for (int i = 0; i < 2; ++i) {
            if (TILED_) { const int wr = R[i] >> 6, m = (R[i] >> 4) & 3, fr = R[i] & 15, cb = 2 * C[i]; off[0][i] = (unsigned)((((wr * 2 + (cb >> 6)) * 2) * 4 + m) * 1024 + fr * 64 + (cb & 63)); }
            else off[0][i] = (unsigned)(R[i] * lda + C[i]) * 2u;
        }
    }
};
typedef ProbPlainT<false> ProbPlain;
}

struct Args { const float* in[27]; float* out; unsigned char* ws; int ph_lo, ph_hi; };
struct Frame {
    LAS unsigned char* lds;
    int tid, lane, wave, G, bid;
    const float* const* in; unsigned char* ws; unsigned char* dout;
};
template <class T> __device__ __forceinline__ T* wsp(const Frame& F, size_t off) { return (T*)(F.ws + off); }
__device__ __forceinline__ Frame launder(const Frame& F0) {
    Frame F = F0; int t = F0.tid; asm volatile("" : "+v"(t)); F.tid = t; F.lane = t & 63; F.wave = __builtin_amdgcn_readfirstlane(t >> 6);
    int z = 0; asm volatile("" : "+s"(z));
    F.ws = F0.ws + z; F.dout = F0.dout + z; F.in = (const float* const*)((const char*)F0.in + z); return F;
}

__device__ __forceinline__ float row_rstd(const float* ssp, int r) {
    const f32x4* p = (const f32x4*)(ssp + (size_t)r * 16);
    const f32x4 a = p[0], b = p[1], c = p[2], d = p[3];
    const float s = ((a[0] + a[1]) + (a[2] + a[3])) + ((b[0] + b[1]) + (b[2] + b[3])) + ((c[0] + c[1]) + (c[2] + c[3])) + ((d[0] + d[1]) + (d[2] + d[3]));
    return rsqrtf(s * (1.0f / D) + EPS);
}

typedef pg8::Unit Unit;
struct EpiInproj {
    static constexpr bool HAS_TAB = false;
    const float* ssp; unsigned char* act;
    __device__ __forceinline__ void operator()(const f32x4 (&acc)[2][2][4][2], const Unit& u, int wr, int wc, int fr, int fq) const {
        static_assert(WS_UGM == WS_ACT && WS_Q == WS_ACT + 32 * MiB && WS_K == WS_ACT + 48 * MiB && WS_V == WS_ACT + 64 * MiB && WS_R == WS_ACT + 96 * MiB, "in-proj destination arithmetic");
        const unsigned pn = (unsigned)u.pn;
        const bool isu = pn < 2u;
        bf16* const base = (bf16*)(act + (size_t)((0x66443200u >> (4u * pn)) & 15u) * (16 * MiB));
        const unsigned stride = 512u >> ((0x0Cu >> pn) & 1u);
        const unsigned cb = ((pn >> 2) & pn & 1u) * 256u;
#pragma unroll
        for (int ai = 0; ai < 2; ++ai) {
            float rs4[4];
#pragma unroll
            for (int m = 0; m < 4; ++m) rs4[m] = row_rstd(ssp, u.pm * 256 + ai * 128 + wr * 64 + m * 16 + fr);
            CFENCE();
#pragma unroll
            for (int m = 0; m < 4; ++m) {
                const unsigned row = (unsigned)(u.pm * 256 + ai * 128 + wr * 64 + m * 16 + fr);
                const float rs = rs4[m];
                const unsigned ro = isu ? ((row >> 12) * 2097152u + (row & 4095u) * 16u) : row * stride;
#pragma unroll
                for (int bj = 0; bj < 2; ++bj) {
                    const unsigned cl = (unsigned)(bj * 128 + wc * 32 + 8 * fq);
                    f32x4 v0 = acc[ai][bj][m][0] * rs, v1 = acc[ai][bj][m][1] * rs;
                    const unsigned co = isu ? ((pn * 256u + cl) >> 4) * 65536u + ((cl >> 3) & 1u) * 8u : cb + cl;
                    u32x4 w; w.x = cvt_pk_bf16(v0[0], v0[1]); w.y = cvt_pk_bf16(v0[2], v0[3]); w.z = cvt_pk_bf16(v1[0], v1[1]); w.w = cvt_pk_bf16(v1[2], v1[3]);
                    *(u32x4*)(base + (size_t)(ro + co)) = w;
                }
            }
            CFENCE();
        }
    }
};
struct EpiGlu {
    static constexpr bool HAS_TAB = false;
    const bf16* ys5; bf16* yglu; const float* bglu;
    __device__ __forceinline__ void operator()(const f32x4 (&acc)[2][2][4][2], const Unit& u, int wr, int wc, int fr, int fq) const {
        const int colb = u.pn * 256 + wc * 32 + 8 * fq;
        const bf16* src = ys5 + (size_t)(u.pm * 256 + wr * 64 + fr) * 512 + colb;
        u32x4 nx[2] = {*(const u32x4*)src, *(const u32x4*)(src + 128)};
#pragma unroll
        for (int g = 0; g < 8; ++g) {
            const int ai = g >> 2, m = g & 3;
            const u32x4 a2[2] = {nx[0], nx[1]};
            if (g < 7) { const int g1 = g + 1; const bf16* s1 = src + (size_t)((g1 >> 2) * 128 + (g1 & 3) * 16) * 512; nx[0] = *(const u32x4*)s1; nx[1] = *(const u32x4*)(s1 + 128); }
            CFENCE();
            const int row = u.pm * 256 + ai * 128 + wr * 64 + m * 16 + fr;
#pragma unroll
            for (int bj = 0; bj < 2; ++bj) {
                const int col = colb + bj * 128;
                const u32x4 a = a2[bj];
                const f32x4 b0 = *(const f32x4*)(bglu + col), b1 = *(const f32x4*)(bglu + col + 4);
                const f32x4 v0 = acc[ai][bj][m][0] + b0, v1 = acc[ai][bj][m][1] + b1;
                u32x4 w;
                w.x = cvt_pk_bf16(bflo(a.x) * sigmoidf_(v0[0]), bfhi(a.x) * sigmoidf_(v0[1]));
                w.y = cvt_pk_bf16(bflo(a.y) * sigmoidf_(v0[2]), bfhi(a.y) * sigmoidf_(v0[3]));
                w.z = cvt_pk_bf16(bflo(a.z) * sigmoidf_(v1[0]), bfhi(a.z) * sigmoidf_(v1[1]));
                w.w = cvt_pk_bf16(bflo(a.w) * sigmoidf_(v1[2]), bfhi(a.w) * sigmoidf_(v1[3]));
                *(u32x4*)(yglu + (size_t)row * 512 + col) = w;
            }
        }
        CFENCE();
    }
};
struct EpiResid {
    static constexpr bool HAS_TAB = false;
    bf16* xb; float* ssp; bf16* dst; bool wr_ssp;
    unsigned char* x8;
    float ascale;
    __device__ __forceinline__ void operator()(const f32x4 (&acc)[2][2][4][2], const Unit& u, int wr, int wc, int fr, int fq) const {
        const int colb = u.pn * 256 + wc * 32 + 8 * fq;
        const bf16* src = xb + (size_t)(u.pm * 256 + wr * 64 + fr) * D + colb;
        u32x4 nx[2] = {*(const u32x4*)src, *(const u32x4*)(src + 128)};
#pragma unroll
        for (int g = 0; g < 8; ++g) {
            const int ai = g >> 2, m = g & 3;
            const u32x4 a2[2] = {nx[0], nx[1]};
            if (g < 7) { const int g1 = g + 1; const bf16* s1 = src + (size_t)((g1 >> 2) * 128 + (g1 & 3) * 16) * D; nx[0] = *(const u32x4*)s1; nx[1] = *(const u32x4*)(s1 + 128); }
            CFENCE();
            const int row = u.pm * 256 + ai * 128 + wr * 64 + m * 16 + fr;
            float ss = 0.f;
#pragma unroll
            for (int bj = 0; bj < 2; ++bj) {
                const int col = colb + bj * 128;
                const u32x4 a = a2[bj];
                const f32x4 v0 = acc[ai][bj][m][0] * ascale + (f32x4){bflo(a.x), bfhi(a.x), bflo(a.y), bfhi(a.y)};
                const f32x4 v1 = acc[ai][bj][m][1] * ascale + (f32x4){bflo(a.z), bfhi(a.z), bflo(a.w), bfhi(a.w)};
                ss += (v0[0] * v0[0] + v0[1] * v0[1]) + (v0[2] * v0[2] + v0[3] * v0[3]) + (v1[0] * v1[0] + v1[1] * v1[1]) + (v1[2] * v1[2] + v1[3] * v1[3]);
                u32x4 w; w.x = cvt_pk_bf16(v0[0], v0[1]); w.y = cvt_pk_bf16(v0[2], v0[3]); w.z = cvt_pk_bf16(v1[0], v1[1]); w.w = cvt_pk_bf16(v1[2], v1[3]);
                *(u32x4*)(dst + (size_t)row * D + col) = w;
                if (x8) { u32x2 q; q.x = pk4_fp8(v0[0], v0[1], v0[2], v0[3]); q.y = pk4_fp8(v1[0], v1[1], v1[2], v1[3]); *(u32x2*)(x8 + (size_t)row * D + col) = q; }
            }
            ss += __shfl_xor(ss, 16); ss += __shfl_xor(ss, 32);
            if (fq == 0 && wr_ssp) ssp[(size_t)row * 16 + u.pn * 4 + wc] = ss;
        }
        CFENCE();
    }
};
template <bool F8> struct EpiSwigluT {
    static constexpr bool HAS_TAB = false;
    const float* ssp; bf16* h; int ldh;
    __device__ __forceinline__ void operator()(const f32x4 (&acc)[2][2][4][2], const Unit& u, int wr, int wc, int fr, int fq) const {
#pragma unroll
        for (int ai = 0; ai < 2; ++ai) {
            float rs4[4];
#pragma unroll
            for (int m = 0; m < 4; ++m) rs4[m] = row_rstd(ssp, u.pm * 256 + ai * 128 + wr * 64 + m * 16 + fr);
            CFENCE();
#pragma unroll
            for (int m = 0; m < 4; ++m) {
                const int row = u.pm * 256 + ai * 128 + wr * 64 + m * 16 + fr;
                const float rs = rs4[m] * (F8 ? 1.0f / F8_SW_UP : 1.0f);
                const float hs = F8 ? F8_SH : 1.0f, nrs = rs * -1.4426950408889634f, cc = rs * rs * hs;
                const f32x4 ga = acc[ai][0][m][0], gb = acc[ai][0][m][1], ua = acc[ai][1][m][0], ub = acc[ai][1][m][1];
                const f32x2 p0 = swiglu2((f32x2){ga[0], ga[1]}, (f32x2){ua[0], ua[1]}, nrs, cc), p1 = swiglu2((f32x2){ga[2], ga[3]}, (f32x2){ua[2], ua[3]}, nrs, cc);
                const f32x2 p2 = swiglu2((f32x2){gb[0], gb[1]}, (f32x2){ub[0], ub[1]}, nrs, cc), p3 = swiglu2((f32x2){gb[2], gb[3]}, (f32x2){ub[2], ub[3]}, nrs, cc);
                const f32x4 h0 = {p0[0], p0[1], p1[0], p1[1]}, h1 = {p2[0], p2[1], p3[0], p3[1]};
                const int col = u.pn * 128 + wc * 32 + 8 * fq;
                static_assert(!F8, "the dense tile-major hidden layout is written for bf16");
                const size_t to = ((size_t)u.pm * (2 * ldh / 128) + 2 * u.pn + (wc >> 1)) * 32768 + (size_t)(((((wr * 2 + (wc & 1)) * 2 + ai) * 4 + m) * 1024) + fr * 64 + 16 * fq);
                if constexpr (F8) { u32x2 q; q.x = pk4_fp8(h0[0], h0[1], h0[2], h0[3]); q.y = pk4_fp8(h1[0], h1[1], h1[2], h1[3]); *(u32x2*)((unsigned char*)h + (size_t)row * ldh + col) = q; }
                else { u32x4 w; w.x = cvt_pk_bf16(h0[0], h0[1]); w.y = cvt_pk_bf16(h0[2], h0[3]); w.z = cvt_pk_bf16(h1[0], h1[1]); w.w = cvt_pk_bf16(h1[2], h1[3]); *(u32x4*)((unsigned char*)h + to) = w; }
            }
            CFENCE();
        }
    }
};

struct MoeTab { LAS int* cnt; LAS int* cb; LAS short* tl_list; LAS short* tl_sub; };
__device__ __forceinline__ MoeTab moe_tab(const Frame& F) {
    MoeTab T; T.cnt = (LAS int*)(F.lds + MOE_TAB_OFF); T.cb = T.cnt + 16; T.tl_list = (LAS short*)(T.cb + 8); T.tl_sub = T.tl_list + 288; return T;
}
__device__ __forceinline__ void moe_build_tables(const Frame& F) {
    MoeTab T = moe_tab(F);
    if (F.tid < 16) { const unsigned* gc = wsp<unsigned>(F, WS_CTL) + CW_CNT; int c = (int)__hip_atomic_load(gc + F.tid, __ATOMIC_RELAXED, __HIP_MEMORY_SCOPE_AGENT); if (c > 32768) c = 32768; T.cnt[F.tid] = c; }
    __syncthreads();
    if (F.tid == 0) {
        int tot = 0, tr0 = 0, tr1 = 0;
#pragma unroll 1
        for (int l = 0; l < 16; ++l) {
            const int nt_ = (T.cnt[l] + 255) >> 8; if (l < 8) tr0 += nt_; else tr1 += nt_;
#pragma unroll 1
            for (int s = 0; s < nt_; ++s) { T.tl_list[tot] = (short)l; T.tl_sub[tot] = (short)s; ++tot; }
        }
        const int c0 = (tr0 > 64 + MOE_CAP_TILES) ? tr0 - MOE_CAP_TILES : (tr0 < 64 ? tr0 : 64);
        const int c3 = (tr1 > 64 + MOE_CAP_TILES) ? tr1 - MOE_CAP_TILES : (tr1 < 64 ? tr1 : 64);
        T.cb[0] = 0; T.cb[1] = c0; T.cb[2] = tr0; T.cb[3] = tr0 + tr1 - c3; T.cb[4] = tr0 + tr1;
    }
    __syncthreads();
}
struct MoeOrder {
    MoeTab T; int t0, ntile, nN, lo, nloc, j, nbx, nheavy, skip;
    __device__ __forceinline__ void init(const MoeTab& T_, int chunk, int nN_, int G, int bid, int nheavy_, int skip_) {
        T = T_; t0 = T.cb[chunk]; ntile = T.cb[chunk + 1] - t0; nN = nN_;
        const int total = ntile * nN, x = bid & 7, q = total >> 3, r = total & 7;
        lo = (x < r) ? x * (q + 1) : r * (q + 1) + (x - r) * q; nloc = q + (x < r ? 1 : 0);
        j = bid >> 3; nbx = (G - x + 7) >> 3; nheavy = nheavy_; skip = skip_;
    }
    __device__ __forceinline__ int nheavy_next() const { return nloc % nbx; }
    __device__ __forceinline__ bool next(int i, Unit& u) const {
        int k;
        if (j < nheavy) k = skip * (nbx - nheavy) + i * nbx + j;
        else k = (i < skip) ? i * (nbx - nheavy) + (j - nheavy) : skip * (nbx - nheavy) + (i - skip) * nbx + j;
        if (k >= nloc) return false;
        const int idx = lo + k, nig = 8 * nN, gid = idx / nig, fm = gid * 8, gsz = (ntile - fm) < 8 ? (ntile - fm) : 8, w = idx - gid * nig;
        const int tl = fm + w % gsz; u.pm = tl; u.pn = w / gsz; u.e = T.tl_list[t0 + tl]; u.sub = T.tl_sub[t0 + tl]; return true;
    }
};
constexpr int MOE_ESZ = USE_F8_MOE ? 1 : 2;
struct ProbMoeUp {
    static constexpr bool GATHER = true, F8 = USE_F8_MOE != 0;
    const void* xa; const void* wgu; const int* tok; MoeTab T; int lda, ldb, K;
    __device__ __forceinline__ const char* a_ptr(const Unit&) const { return (const char*)xa; }
    __device__ __forceinline__ size_t hstep_a() const { return 0; }
    __device__ __forceinline__ size_t kstep_a() const { return 128; }
    __device__ __forceinline__ const char* b_ptr(const Unit& u) const { return (const char*)wgu + ((size_t)(u.e & 7) * (2 * DFE) + (size_t)u.pn * 256) * D * MOE_ESZ; }
    __device__ __forceinline__ void a_off(const Unit& u, const int (&R)[2], const int (&C)[2], unsigned (&off)[2][2]) const {
        const int cnt = T.cnt[u.e];
#pragma unroll
        for (int h = 0; h < 2; ++h)
#pragma unroll
            for (int i = 0; i < 2; ++i) { const int p = u.sub * 256 + h * 128 + R[i]; const int t = (p < cnt) ? tok[u.e * 32768 + p] : 0; off[h][i] = (unsigned)(t * lda + C[i]) * 2u; }
    }
    __device__ __forceinline__ void atab_issue(const Unit& u, LAS unsigned char* tab, int wid, int lane) const {
        if (wid < 4) { const int cnt = T.cnt[u.e]; int p = u.sub * 256 + wid * 64 + lane; p = (p < cnt) ? p : 0;
            __builtin_amdgcn_global_load_lds((const unsigned*)(tok + u.e * 32768 + p), (LAS unsigned*)(tab + wid * 256), 4, 0, 0); }
    }
    __device__ __forceinline__ void a_off_tab(const LAS unsigned char* tab, const int (&R)[2], const int (&C)[2], unsigned (&off)[2][2]) const {
#pragma unroll
        for (int h = 0; h < 2; ++h)
#pragma unroll
            for (int i = 0; i < 2; ++i) { const int t = *(const LAS int*)(tab + (h * 128 + R[i]) * 4); off[h][i] = (unsigned)(t * lda + C[i]) * 2u; }
    }
};
struct ProbMoeDown {
    static constexpr bool GATHER = false, F8 = USE_F8_MOE != 0;
    const void* h; const void* wd; int lda, ldb, K;
    static constexpr bool TILED = USE_F8_MOE != 0;
    __device__ __forceinline__ const char* a_ptr(const Unit& u) const { return TILED ? (const char*)h + (size_t)u.pm * (DFE / 128) * 32768 : (const char*)h + (size_t)u.pm * 256 * DFE * MOE_ESZ; }
    __device__ __forceinline__ const char* b_ptr(const Unit& u) const { return (const char*)wd + ((size_t)(u.e & 7) * D + (size_t)u.pn * 256) * DFE * MOE_ESZ; }
    __device__ __forceinline__ size_t hstep_a() const { return TILED ? (size_t)2048 : (size_t)128 * lda * 2; }
    __device__ __forceinline__ size_t kstep_a() const { return TILED ? (size_t)32768 : (size_t)128; }
    __device__ __forceinline__ void a_off(const Unit&, const int (&R)[2], const int (&C)[2], unsigned (&off)[1][2]) const {
#pragma unroll
        for (int i = 0; i < 2; ++i) {
            if (TILED) { const int wr = R[i] >> 6, m = (R[i] >> 4) & 3, fr = R[i] & 15, cb = 2 * C[i]; off[0][i] = (unsigned)((((wr * 4 + (cb >> 5)) * 2) * 4 + m) * 512 + fr * 32 + (cb & 31)); }
            else off[0][i] = (unsigned)(R[i] * lda + C[i]) * 2u;
        }
    }
};
struct EpiSwigluMoe {
    static constexpr bool HAS_TAB = true;
    const float* rl; void* h; MoeTab T;
    __device__ __forceinline__ void tab_issue(const Unit& u, LAS unsigned char* tab, int wid, int lane) const {
        if (wid < 4) { const int cnt = T.cnt[u.e]; int p = u.sub * 256 + wid * 64 + lane; p = (p < cnt) ? p : 0;
            __builtin_amdgcn_global_load_lds((const unsigned*)(rl + u.e * 32768 + p), (LAS unsigned*)(tab + wid * 256), 4, 0, 0); }
    }
    __device__ __forceinline__ void operator()(const f32x4 (&acc)[2][2][4][2], const Unit& u, int wr, int wc, int fr, int fq, const LAS unsigned char* tab) const {
        constexpr bool F8 = USE_F8_MOE != 0;
        const int cnt = T.cnt[u.e];
        float rs8[8];
#pragma unroll
        for (int g = 0; g < 8; ++g) { const int rl_ = (g >> 2) * 128 + wr * 64 + (g & 3) * 16 + fr, p = u.sub * 256 + rl_; const float v = *(const LAS float*)(tab + rl_ * 4); rs8[g] = (p < cnt) ? v * (F8 ? 1.0f / F8_SW_UP : 1.0f) : 0.f; }
        CFENCE();
#pragma unroll
        for (int ai = 0; ai < 2; ++ai)
#pragma unroll
            for (int m = 0; m < 4; ++m) {
                const int rl_ = ai * 128 + wr * 64 + m * 16 + fr;
                const float rs = rs8[ai * 4 + m];
                const float hs = F8 ? F8_SH : 1.0f, nrs = rs * -1.4426950408889634f, cc = rs * rs * hs;
                const f32x4 ga = acc[ai][0][m][0], gb = acc[ai][0][m][1], ua = acc[ai][1][m][0], ub = acc[ai][1][m][1];
                const f32x2 p0 = swiglu2((f32x2){ga[0], ga[1]}, (f32x2){ua[0], ua[1]}, nrs, cc), p1 = swiglu2((f32x2){ga[2], ga[3]}, (f32x2){ua[2], ua[3]}, nrs, cc);
                const f32x2 p2 = swiglu2((f32x2){gb[0], gb[1]}, (f32x2){ub[0], ub[1]}, nrs, cc), p3 = swiglu2((f32x2){gb[2], gb[3]}, (f32x2){ub[2], ub[3]}, nrs, cc);
                const f32x4 h0 = {p0[0], p0[1], p1[0], p1[1]}, h1 = {p2[0], p2[1], p3[0], p3[1]};
                const size_t eo = F8 ? ((size_t)(u.pm * (DFE / 128) + u.pn) * 32768 + (size_t)((((wr * 4 + wc) * 2 + ai) * 4 + m) * 512 + fr * 32 + 8 * fq))
                                     : ((size_t)(u.pm * 256 + rl_) * DFE + u.pn * 128 + wc * 32 + 8 * fq);
                if constexpr (F8) { u32x2 q; q.x = pk4_fp8(h0[0], h0[1], h0[2], h0[3]); q.y = pk4_fp8(h1[0], h1[1], h1[2], h1[3]); *(u32x2*)((unsigned char*)h + eo) = q; }
                else { u32x4 w; w.x = cvt_pk_bf16(h0[0], h0[1]); w.y = cvt_pk_bf16(h0[2], h0[3]); w.z = cvt_pk_bf16(h1[0], h1[1]); w.w = cvt_pk_bf16(h1[2], h1[3]); *(u32x4*)((bf16*)h + eo) = w; }
            }
        CFENCE();
    }
};
struct EpiMoeDown {
    static constexpr bool HAS_TAB = false;
    const int* tok; const float* wl; const bf16* xb; bf16* xo; MoeTab T; bool dry;
    __device__ __forceinline__ void operator()(const f32x4 (&acc)[2][2][4][2], const Unit& u, int wr, int wc, int fr, int fq) const {
        const int cnt = T.cnt[u.e]; const bf16* src = (u.e < 8) ? xb : (const bf16*)xo;
        const int colb = u.pn * 256 + wc * 32 + 8 * fq;
        int t8[8]; float w8[8];
#pragma unroll
        for (int g = 0; g < 8; ++g) { const int p = u.sub * 256 + (g >> 2) * 128 + wr * 64 + (g & 3) * 16 + fr; const bool ok = p < cnt; const int pc = ok ? p : 0;
            const int t_ = tok[u.e * 32768 + pc]; const float w_ = wl[u.e * 32768 + pc];
            t8[g] = ok ? t_ : -1; w8[g] = ok ? w_ * (USE_F8_MOE ? 1.0f / (F8_SH * F8_SW_DN) : 1.0f) : 0.f; }
        CFENCE();
        u32x4 nx[2];
        { const bf16* s0 = src + (size_t)(t8[0] < 0 ? 0 : t8[0]) * D + colb; nx[0] = *(const u32x4*)s0; nx[1] = *(const u32x4*)(s0 + 128); }
#pragma unroll
        for (int g = 0; g < 8; ++g) {
            const int ai = g >> 2, m = g & 3;
            const u32x4 a2[2] = {nx[0], nx[1]};
            if (g < 7) { const bf16* s1 = src + (size_t)(t8[g + 1] < 0 ? 0 : t8[g + 1]) * D + colb; nx[0] = *(const u32x4*)s1; nx[1] = *(const u32x4*)(s1 + 128); }
            CFENCE();
            if (t8[g] >= 0) {
#pragma unroll
                for (int bj = 0; bj < 2; ++bj) {
                    const u32x4 a = a2[bj];
                    const f32x4 v0 = acc[ai][bj][m][0] * w8[g] + (f32x4){bflo(a.x), bfhi(a.x), bflo(a.y), bfhi(a.y)};
                    const f32x4 v1 = acc[ai][bj][m][1] * w8[g] + (f32x4){bflo(a.z), bfhi(a.z), bflo(a.w), bfhi(a.w)};
                    u32x4 w; w.x = cvt_pk_bf16(v0[0], v0[1]); w.y = cvt_pk_bf16(v0[2], v0[3]); w.z = cvt_pk_bf16(v1[0], v1[1]); w.w = cvt_pk_bf16(v1[2], v1[3]);
                    if (!dry) *(u32x4*)(xo + (size_t)t8[g] * D + colb + bj * 128) = w;
                }
            }
        }
        CFENCE();
    }
};

__device__ __forceinline__ void p0_tr_item(const float* src, int ldsrc, int ncol0, int k0, const float* gain, bf16* dst, int K, int drow0, LAS float* scr, int lane) {
    float gv[8]; f32x4 v8[8];
#pragma unroll
    for (int i = 0; i < 8; ++i) gv[i] = 1.0f;
    if (gain) {
#pragma unroll
        for (int i = 0; i < 8; ++i) gv[i] = gain[k0 + 8 * i + (lane >> 3)];
    }
#pragma unroll
    for (int i = 0; i < 8; ++i) v8[i] = *(const f32x4*)(src + (size_t)(k0 + 8 * i + (lane >> 3)) * ldsrc + ncol0 + 4 * (lane & 7));
    CFENCE();
#pragma unroll
    for (int i = 0; i < 8; ++i) { const int kk = 8 * i + (lane >> 3), c4 = lane & 7; *(LAS f32x4*)(scr + kk * 36 + 4 * c4) = v8[i] * gv[i]; }
    LDS_WAIT(); CFENCE();
    const int c = lane & 7;
#pragma unroll
    for (int j = 0; j < 4; ++j) { const int n = (lane >> 3) + 8 * j; const LAS float* s = scr + (8 * c) * 36 + n;
        u32x4 o; o.x = pk2(s[0 * 36], s[1 * 36]); o.y = pk2(s[2 * 36], s[3 * 36]); o.z = pk2(s[4 * 36], s[5 * 36]); o.w = pk2(s[6 * 36], s[7 * 36]);
        *(u32x4*)(dst + (size_t)(drow0 + n) * K + k0 + 8 * c) = o; }
    LDS_WAIT(); CFENCE();
}
__device__ __forceinline__ void p0_tr_item_f8(const float* src, int ldsrc, int ncol0, int k0, const float* gain, float scale, unsigned char* dst, int K, int drow0, LAS float* scr, int lane) {
    float gv[8]; f32x4 v8[8];
#pragma unroll
    for (int i = 0; i < 8; ++i) gv[i] = 1.0f;
    if (gain) {
#pragma unroll
        for (int i = 0; i < 8; ++i) gv[i] = gain[k0 + 8 * i + (lane >> 3)];
    }
#pragma unroll
    for (int i = 0; i < 8; ++i) v8[i] = *(const f32x4*)(src + (size_t)(k0 + 8 * i + (lane >> 3)) * ldsrc + ncol0 + 4 * (lane & 7));
    CFENCE();
#pragma unroll
    for (int i = 0; i < 8; ++i) { const int kk = 8 * i + (lane >> 3), c4 = lane & 7; *(LAS f32x4*)(scr + kk * 36 + 4 * c4) = v8[i] * (gv[i] * scale); }
    LDS_WAIT(); CFENCE();
    const int c = lane & 7;
#pragma unroll
    for (int j = 0; j < 4; ++j) { const int n = (lane >> 3) + 8 * j; const LAS float* s = scr + (8 * c) * 36 + n;
        u32x2 o; o.x = pk4_fp8(s[0 * 36], s[1 * 36], s[2 * 36], s[3 * 36]); o.y = pk4_fp8(s[4 * 36], s[5 * 36], s[6 * 36], s[7 * 36]);
        *(u32x2*)(dst + (size_t)(drow0 + n) * K + k0 + 8 * c) = o; }
    LDS_WAIT(); CFENCE();
}
__device__ __forceinline__ void p0_s5_unit(const Frame& F, int l, int g) {
    LAS float* AP = (LAS float*)F.lds;
    LAS float* BB = AP + 64 * 17 * 2;
    LAS float* CC = BB + 64 * 16 * 2;
    LAS float* KT = CC + 16 * 64 * 2;
    const float* lre = F.in[3] + (l * 32 + g) * 64; const float* lim = F.in[4] + (l * 32 + g) * 64; const float ldt = F.in[5][l * 32 + g];
    const float* bre = F.in[6] + (size_t)(l * 32 + g) * 1024; const float* bim = F.in[7] + (size_t)(l * 32 + g) * 1024;
    const float* cre = F.in[8] + (size_t)(l * 32 + g) * 1024; const float* cim = F.in[9] + (size_t)(l * 32 + g) * 1024;
    const int tid = F.tid;
    for (int i = tid; i < 64 * 17; i += 512) {
        const int p = i / 17, tau = i % 17;
        const double lr = fmin((double)lre[p], -1e-4), li = (double)lim[p], dt = exp((double)ldt);
        const double mg = exp(lr * dt * tau), ph = li * dt * tau;
        AP[i * 2] = (float)(mg * cos(ph)); AP[i * 2 + 1] = (float)(mg * sin(ph));
    }
    for (int i = tid; i < 1024; i += 512) {
        const int p = i >> 4;
        const double lr = fmin((double)lre[p], -1e-4), li = (double)lim[p], dt = exp((double)ldt);
        const double mg = exp(lr * dt), ar = mg * cos(li * dt), ai = mg * sin(li * dt), nr = ar - 1.0, ni = ai, den = lr * lr + li * li;
        const double fr = (nr * lr + ni * li) / den, fi = (ni * lr - nr * li) / den;
        const double br = bre[i], bi = bim[i];
        BB[i * 2] = (float)(fr * br - fi * bi); BB[i * 2 + 1] = (float)(fr * bi + fi * br);
        CC[i * 2] = cre[i]; CC[i * 2 + 1] = cim[i];
    }
    __syncthreads();
    for (int i = tid; i < 4096; i += 512) {
        const int tau = i >> 8, c = (i >> 4) & 15, c2 = i & 15; float s = 0.f;
        for (int p = 0; p < 64; ++p) {
            const float xr = CC[(c * 64 + p) * 2], xi = CC[(c * 64 + p) * 2 + 1], ar = AP[(p * 17 + tau) * 2], ai = AP[(p * 17 + tau) * 2 + 1];
            const float zr = xr * ar - xi * ai, zi = xr * ai + xi * ar;
            s += zr * BB[(p * 16 + c2) * 2] - zi * BB[(p * 16 + c2) * 2 + 1];
        }
        KT[i] = s;
    }
    __syncthreads();
    bf16* MQ = wsp<bf16>(F, WS_S5MQ) + (size_t)(l * 32 + g) * 256 * 384;
    for (int i = tid; i < 256 * 48; i += 512) {
        const int m = i / 48, k8 = (i % 48) * 8, t = m >> 4, c = m & 15; float v[8];
#pragma unroll
        for (int j = 0; j < 8; ++j) {
            const int kc = k8 + j;
            if (kc < 256) { const int s = kc >> 4, c2 = kc & 15; v[j] = (s <= t) ? KT[((t - s) * 16 + c) * 16 + c2] : 0.f; }
            else { const int pp = kc - 256, p = pp & 63; const float xr = CC[(c * 64 + p) * 2], xi = CC[(c * 64 + p) * 2 + 1], ar = AP[(p * 17 + t + 1) * 2], ai = AP[(p * 17 + t + 1) * 2 + 1];
                   v[j] = (pp < 64) ? (xr * ar - xi * ai) : -(xr * ai + xi * ar); }
        }
        u32x4 o; o.x = pk2(v[0], v[1]); o.y = pk2(v[2], v[3]); o.z = pk2(v[4], v[5]); o.w = pk2(v[6], v[7]);
        *(u32x4*)(MQ + (size_t)m * 384 + k8) = o;
    }
    bf16* PM = wsp<bf16>(F, WS_S5P) + (size_t)(l * 32 + g) * 128 * 256;
    for (int i = tid; i < 128 * 32; i += 512) {
        const int pp = i >> 5, k8 = (i & 31) * 8, p = pp & 63; float v[8];
#pragma unroll
        for (int j = 0; j < 8; ++j) {
            const int kc = k8 + j, s = kc >> 4, c2 = kc & 15;
            const float ar = AP[(p * 17 + 15 - s) * 2], ai = AP[(p * 17 + 15 - s) * 2 + 1], br = BB[(p * 16 + c2) * 2], bi = BB[(p * 16 + c2) * 2 + 1];
            v[j] = (pp < 64) ? (ar * br - ai * bi) : (ar * bi + ai * br);
        }
        u32x4 o; o.x = pk2(v[0], v[1]); o.y = pk2(v[2], v[3]); o.z = pk2(v[4], v[5]); o.w = pk2(v[6], v[7]);
        *(u32x4*)(PM + (size_t)pp * 256 + k8) = o;
    }
    float* A16 = wsp<float>(F, WS_S5A16) + (size_t)(l * 32 + g) * 128;
    if (tid < 64) { A16[tid * 2] = AP[(tid * 17 + 16) * 2]; A16[tid * 2 + 1] = AP[(tid * 17 + 16) * 2 + 1]; }
    __syncthreads();
}
__device__ __forceinline__ void p0_prologue(const Frame& F) {
    if (F.bid == 0 && F.tid < 16) __hip_atomic_store(wsp<unsigned>(F, WS_CTL) + CW_CNT + F.tid, 0u, __ATOMIC_RELAXED, __HIP_MEMORY_SCOPE_AGENT);
#ifndef PROBE_S5U
#define PROBE_S5U 1
#endif
#pragma unroll 1
    for (int pr = 0; pr < PROBE_S5U; ++pr) for (int un = F.bid; un < 64; un += F.G) p0_s5_unit(F, un >> 5, un & 31);
    LAS float* scr = (LAS float*)(F.lds + F.wave * 16384);
    const int gw = F.bid * 8 + F.wave, NGW = F.G * 8, lane = F.lane;
    constexpr int I_IN = 16 * 64, I_GLU = 8 * 16, I_OUT = 16 * 32, I_FGU = 16 * 176, I_FD = 44 * 32, I_MGU = 16 * 224, I_MD = 56 * 32;
    constexpr int NITEMS = 2 * (I_IN + I_GLU + I_OUT) + I_FGU + I_FD + 8 * (I_MGU + I_MD);
    const bool split = F.G > 64;
    const int N1 = split ? ((NITEMS / NGW > 4) ? (NITEMS / NGW - 4) * NGW : 0) : NITEMS;
    int step = NGW;
    for (int it = gw; ; it += step) {
        if (step == NGW && it >= N1) { if (!split || F.bid < 64) break; it = N1 + (F.bid - 64) * 8 + F.wave; step = (F.G - 64) * 8; }
        if (it >= NITEMS) break;
        int r = it; bool done = false;
#pragma unroll
        for (int l = 0; l < 2; ++l) {
            if (done) break;
            if (r < I_IN) { p0_tr_item(F.in[2] + (size_t)l * D * DIN, DIN, 32 * (r % 64), 64 * (r / 64), F.in[1] + l * D, wsp<bf16>(F, WS_WIN) + (size_t)l * NPROJ * D, D, 32 * (r % 64), scr, lane); done = true; break; } r -= I_IN;
            if (r < I_GLU) { p0_tr_item(F.in[11] + (size_t)l * 512 * 512, 512, 32 * (r % 16), 64 * (r / 16), nullptr, wsp<bf16>(F, WS_WGLU) + (size_t)l * 512 * 512, 512, 32 * (r % 16), scr, lane); done = true; break; } r -= I_GLU;
            if (r < I_OUT) { p0_tr_item(F.in[17] + (size_t)l * D * D, D, 32 * (r % 32), 64 * (r / 32), nullptr, wsp<bf16>(F, WS_WOUT) + (size_t)l * D * D, D, 32 * (r % 32), scr, lane); done = true; break; } r -= I_OUT;
        }
        if (done) continue;
        if (r < I_FGU) { const int nb = r % 176, kb = r / 176, n0 = 32 * nb, T = n0 >> 8, hf = (n0 >> 7) & 1, j0 = n0 & 127;
            if (USE_F8_FFN) p0_tr_item_f8(hf ? F.in[20] : F.in[19], DFF, 128 * T + j0, 64 * kb, F.in[18], F8_SW_UP, wsp<unsigned char>(F, WS_WFGU), D, n0, scr, lane);
            else p0_tr_item(hf ? F.in[20] : F.in[19], DFF, 128 * T + j0, 64 * kb, F.in[18], wsp<bf16>(F, WS_WFGU), D, n0, scr, lane);
            continue; } r -= I_FGU;
        if (r < I_FD) {
            if (USE_F8_FFN) p0_tr_item_f8(F.in[21], D, 32 * (r % 32), 64 * (r / 32), nullptr, F8_SW_DN, wsp<unsigned char>(F, WS_WFD), DFF, 32 * (r % 32), scr, lane);
            else p0_tr_item(F.in[21], D, 32 * (r % 32), 64 * (r / 32), nullptr, wsp<bf16>(F, WS_WFD), DFF, 32 * (r % 32), scr, lane);
            continue; } r -= I_FD;
        const int e = r / (I_MGU + I_MD); r -= e * (I_MGU + I_MD);
        if (r < I_MGU) { const int nb = r % 224, kb = r / 224, n0 = 32 * nb, T = n0 >> 8, hf = (n0 >> 7) & 1, j0 = n0 & 127;
            if (USE_F8_MOE) p0_tr_item_f8((hf ? F.in[24] : F.in[23]) + (size_t)e * D * DFE, DFE, 128 * T + j0, 64 * kb, F.in[18] + D, F8_SW_UP, wsp<unsigned char>(F, WS_MGU) + (size_t)e * 2 * DFE * D, D, n0, scr, lane);
            else p0_tr_item((hf ? F.in[24] : F.in[23]) + (size_t)e * D * DFE, DFE, 128 * T + j0, 64 * kb, F.in[18] + D, wsp<bf16>(F, WS_MGU) + (size_t)e * 2 * DFE * D, D, n0, scr, lane);
            continue; } r -= I_MGU;
        if (USE_F8_MOE) p0_tr_item_f8(F.in[25] + (size_t)e * DFE * D, D, 32 * (r % 32), 64 * (r / 32), nullptr, F8_SW_DN, wsp<unsigned char>(F, WS_MD) + (size_t)e * D * DFE, DFE, 32 * (r % 32), scr, lane);
        else p0_tr_item(F.in[25] + (size_t)e * DFE * D, D, 32 * (r % 32), 64 * (r / 32), nullptr, wsp<bf16>(F, WS_MD) + (size_t)e * D * DFE, DFE, 32 * (r % 32), scr, lane);
    }
    for (int it = F.bid * 512 + F.tid; it < 2 * 16 * 1024; it += F.G * 512) {
        const int l = it >> 14, r = (it >> 10) & 15, k = it & 1023;
        wsp<bf16>(F, WS_WGT)[it] = (bf16)f2bf(F.in[1][l * D + k] * F.in[2][(size_t)l * D * DIN + (size_t)k * DIN + 2048 + r]);
    }
    for (int it = F.bid * 512 + F.tid; it < 2 * 256 * 16; it += F.G * 512) {
        const int l = it >> 12, k = (it >> 4) & 255, r = it & 15;
        wsp<bf16>(F, WS_WA2T)[it] = (bf16)f2bf(F.in[14][(size_t)l * 16 * 256 + r * 256 + k]);
    }
    bf16* xb = wsp<bf16>(F, WS_XB); float* ssp = wsp<float>(F, WS_SSP);
    f32x4 xn[4];
    if (gw < M) {
#pragma unroll
        for (int j = 0; j < 4; ++j) xn[j] = ((const f32x4*)(F.in[0] + (size_t)gw * D) + lane)[64 * j];
    }
    for (int m = gw; m < M; m += NGW) {
        f32x4 xc[4]; float s = 0.f;
#pragma unroll
        for (int j = 0; j < 4; ++j) xc[j] = xn[j];
        if (m + NGW < M) {
#pragma unroll
            for (int j = 0; j < 4; ++j) xn[j] = ((const f32x4*)(F.in[0] + (size_t)(m + NGW) * D) + lane)[64 * j];
        }
        CFENCE();
        u32x2* o8 = (u32x2*)(xb + (size_t)m * D) + lane;
#pragma unroll
        for (int j = 0; j < 4; ++j) { const f32x4 v = xc[j]; s += (v[0] * v[0] + v[1] * v[1]) + (v[2] * v[2] + v[3] * v[3]); u32x2 w; w.x = pk2(v[0], v[1]); w.y = pk2(v[2], v[3]); o8[64 * j] = w; }
        s = wave_sum(s);
        if (lane < 16) ssp[(size_t)m * 16 + lane] = (lane == 0) ? s : 0.f;
    }
}

__device__ __forceinline__ bf16x8 frag_row(const LAS unsigned char* base, int stride, int row0, int k0, int lane) {
    return *(const LAS bf16x8*)(base + (row0 + (lane & 15)) * stride + (k0 + 8 * (lane >> 4)) * 2);
}
__device__ __forceinline__ s16x4 lds_tr(const LAS unsigned char* p) { return __builtin_bit_cast(s16x4, __builtin_amdgcn_ds_read_tr16_b64_v4i16((LAS v4i16_t*)p)); }
__device__ __forceinline__ bf16x8 frag_tr(const LAS unsigned char* base, int stride, int r0, int c0, int lane) {
    const int i = lane & 15, q = i >> 2, p = i & 3, g = lane >> 4;
    const LAS unsigned char* a = base + (r0 + 8 * g + q) * stride + (c0 + 4 * p) * 2;
    const s16x4 lo = lds_tr(a), hi = lds_tr(a + 4 * stride);
    return (bf16x8){lo[0], lo[1], lo[2], lo[3], hi[0], hi[1], hi[2], hi[3]};
}
__device__ __forceinline__ bf16x8 frag_tr_perm(const LAS unsigned char* base, int stride, int r0, int c0, int lane) {
    const int i = lane & 15, q = i >> 2, p = i & 3, g = lane >> 4;
    const LAS unsigned char* a = base + (r0 + 4 * g + q) * stride + (c0 + 4 * p) * 2;
    const s16x4 lo = lds_tr(a), hi = lds_tr(a + 16 * stride);
    return (bf16x8){lo[0], lo[1], lo[2], lo[3], hi[0], hi[1], hi[2], hi[3]};
}
#define MFMA16(a, b, c) __builtin_amdgcn_mfma_f32_16x16x32_bf16((a), (b), (c), 0, 0, 0)

__device__ __forceinline__ void glow_pass(const Frame& F, int l) {
    const int lane = F.lane, fr = lane & 15, fq = lane >> 4;
    const bf16* wg = wsp<bf16>(F, WS_WGT) + (size_t)l * 16 * 1024;
    bf16x8 wf[32];
#pragma unroll
    for (int ks = 0; ks < 32; ++ks) wf[ks] = *(const bf16x8*)(wg + fr * 1024 + 32 * ks + 8 * fq);
    const bf16* xb = wsp<bf16>(F, WS_XB); const float* ssp = wsp<float>(F, WS_SSP); bf16* gl = wsp<bf16>(F, WS_GL);
    for (int m0 = 16 * (F.bid * 8 + F.wave); m0 < M; m0 += 16 * F.G * 8) {
        f32x4 acc = {0.f, 0.f, 0.f, 0.f};
        const bf16* xr = xb + (size_t)(m0 + fr) * D + 8 * fq;
        const float rs = row_rstd(ssp, m0 + fr);
#pragma unroll
        for (int kg = 0; kg < 4; ++kg) {
            u32x4 a8[8];
#pragma unroll
            for (int kk = 0; kk < 8; ++kk) a8[kk] = *(const u32x4*)(xr + 32 * (8 * kg + kk));
            CFENCE();
#pragma unroll
            for (int kk = 0; kk < 8; ++kk) acc = MFMA16(wf[8 * kg + kk], __builtin_bit_cast(bf16x8, a8[kk]), acc);
        }
        u32x2 o; o.x = cvt_pk_bf16(acc[0] * rs, acc[1] * rs); o.y = cvt_pk_bf16(acc[2] * rs, acc[3] * rs);
        *(u32x2*)(gl + (size_t)(m0 + fr) * 16 + 4 * fq) = o;
    }
}
constexpr int S5_USTR = 528, S5_SSTR = 272, S5_HSTR = 272;
__device__ __forceinline__ void s5_unit(const Frame& F, int l, int un) {
    const int b = un >> 5, g = un & 31, tid = F.tid, lane = F.lane, w = F.wave, fq = lane >> 4, fr = lane & 15;
    LAS unsigned char* hb = F.lds; LAS unsigned char* useg = F.lds + 64 * S5_HSTR; LAS unsigned char* slds = useg + 64 * S5_USTR;
    const bf16* PM = wsp<bf16>(F, WS_S5P) + (size_t)(l * 32 + g) * 128 * 256;
    const bf16* MQ = wsp<bf16>(F, WS_S5MQ) + (size_t)(l * 32 + g) * 256 * 384;
    bf16x8 pf[8], mq0[12], mq1[12];
#pragma unroll
    for (int ks = 0; ks < 8; ++ks) pf[ks] = *(const bf16x8*)(PM + (size_t)(16 * w + fr) * 256 + 32 * ks + 8 * fq);
#pragma unroll
    for (int ks = 0; ks < 12; ++ks) { mq0[ks] = *(const bf16x8*)(MQ + (size_t)(16 * w + fr) * 384 + 32 * ks + 8 * fq); mq1[ks] = *(const bf16x8*)(MQ + (size_t)(16 * (w + 8) + fr) * 384 + 32 * ks + 8 * fq); }
    const float* A16 = wsp<float>(F, WS_S5A16) + (size_t)(l * 32 + g) * 128;
    const float a_re = A16[(lane & 63) * 2], a_im = A16[(lane & 63) * 2 + 1];
    const f32x4 dsk = *(const f32x4*)(F.in[10] + l * 512 + g * 16 + 4 * fq);
    float hr = 0.f, hi = 0.f;
    const bf16* ug = wsp<bf16>(F, WS_UGM) + (size_t)((b * 32 + g) * 4096) * 16;
    bf16* ys5 = (bf16*)(F.dout + DO_YS5);
    u32x4 upre[4];
#pragma unroll
    for (int i = 0; i < 4; ++i) upre[i] = *(const u32x4*)(ug + (size_t)(tid + 512 * i) * 8);
    for (int seg = 0; seg < 4; ++seg) {
#pragma unroll
        for (int i = 0; i < 4; ++i) { const int idx = tid + 512 * i; *(LAS u32x4*)(useg + (idx >> 5) * S5_USTR + (idx & 31) * 16) = upre[i]; }
        if (seg < 3) {
#pragma unroll
            for (int i = 0; i < 4; ++i) upre[i] = *(const u32x4*)(ug + (size_t)(seg + 1) * 16384 + (size_t)(tid + 512 * i) * 8);
        }
        __syncthreads();
#ifndef PROBE_S5
#define PROBE_S5 0
#endif
#pragma unroll 1
        for (int pr1 = 0; pr1 < (PROBE_S5 == 1 ? 2 : 1); ++pr1)
        {
            f32x4 acc4[4];
#pragma unroll
            for (int nt = 0; nt < 4; ++nt) acc4[nt] = (f32x4){0.f, 0.f, 0.f, 0.f};
#pragma unroll
            for (int kb = 0; kb < 8; kb += 2) {
                bf16x8 ub[2][4];
#pragma unroll
                for (int ks = 0; ks < 2; ++ks)
#pragma unroll
                    for (int nt = 0; nt < 4; ++nt) ub[ks][nt] = frag_row(useg, S5_USTR, 16 * nt, 32 * (kb + ks), lane);
                __builtin_amdgcn_sched_barrier(0);
#pragma unroll
                for (int ks = 0; ks < 2; ++ks)
#pragma unroll
                    for (int nt = 0; nt < 4; ++nt) acc4[nt] = MFMA16(ub[ks][nt], pf[kb + ks], acc4[nt]);
                __builtin_amdgcn_sched_barrier(0);
            }
#pragma unroll
            for (int nt = 0; nt < 4; ++nt) *(LAS f32x4*)(slds + (16 * w + fr) * S5_SSTR + (16 * nt + 4 * fq) * 4) = acc4[nt];
        }
        __syncthreads();
        if (w == 0) {
            const LAS unsigned char* sre = slds + lane * S5_SSTR; const LAS unsigned char* sim = slds + (64 + lane) * S5_SSTR;
            const float hr0 = hr, hi0 = hi;
            const f32x2 are2 = {a_re, a_re}, aim2 = {-a_im, a_im};
#pragma unroll 1
            for (int pr2 = 0; pr2 < (PROBE_S5 == 2 ? 2 : 1); ++pr2) { hr = hr0; hi = hi0;
#pragma unroll 1
            for (int n0 = 0; n0 < 64; n0 += 16) {
                LAS unsigned char* hw = hb + n0 * S5_HSTR + lane * 2;
                f32x4 cr4[4], ci4[4];
#pragma unroll
                for (int q = 0; q < 4; ++q) { cr4[q] = *(const LAS f32x4*)(sre + n0 * 4 + q * 16); ci4[q] = *(const LAS f32x4*)(sim + n0 * 4 + q * 16); }
                CFENCE();
#pragma unroll
                for (int j = 0; j < 16; ++j) {
                    const f32x2 s2 = {cr4[j >> 2][j & 3], ci4[j >> 2][j & 3]};
                    const unsigned hp = cvt_pk_bf16(hr, hi);
                    *(LAS unsigned short*)(hw + j * S5_HSTR) = (unsigned short)hp; *(LAS unsigned short*)(hw + j * S5_HSTR + 128) = (unsigned short)(hp >> 16);
                    const f32x2 hv = {hr, hi}, hx = {hi, hr};
                    const f32x2 nh = hv * are2 + (hx * aim2 + s2);
                    hr = nh[0]; hi = nh[1];
                }
            }
            }
        }
        __syncthreads();
#pragma unroll 1
        for (int pr3 = 0; pr3 < (PROBE_S5 == 3 ? 2 : 1); ++pr3)
#pragma unroll
        for (int nt = 0; nt < 4; ++nt) {
            f32x4 a0 = {0.f, 0.f, 0.f, 0.f}, a1 = {0.f, 0.f, 0.f, 0.f};
#pragma unroll
            for (int kb = 0; kb < 12; kb += 4) {
                bf16x8 bb[4];
#pragma unroll
                for (int ks = 0; ks < 4; ++ks) bb[ks] = (kb < 8) ? frag_row(useg, S5_USTR, 16 * nt, 32 * (kb + ks), lane) : frag_row(hb, S5_HSTR, 16 * nt, 32 * ks, lane);
                __builtin_amdgcn_sched_barrier(0);
#pragma unroll
                for (int ks = 0; ks < 4; ++ks) { a0 = MFMA16(mq0[kb + ks], bb[ks], a0); a1 = MFMA16(mq1[kb + ks], bb[ks], a1); }
                __builtin_amdgcn_sched_barrier(0);
            }
            const int chunk = 16 * nt + fr;
#pragma unroll
            for (int hh = 0; hh < 2; ++hh) {
                const int t = w + 8 * hh; const f32x4 a = hh ? a1 : a0;
                const u32x2 uu = *(const LAS u32x2*)(useg + chunk * S5_USTR + (t * 16 + 4 * fq) * 2);
                const float y0 = gelu_tanh(a[0] + dsk[0] * bflo(uu.x)), y1 = gelu_tanh(a[1] + dsk[1] * bfhi(uu.x)), y2 = gelu_tanh(a[2] + dsk[2] * bflo(uu.y)), y3 = gelu_tanh(a[3] + dsk[3] * bfhi(uu.y));
                u32x2 o; o.x = cvt_pk_bf16(y0, y1); o.y = cvt_pk_bf16(y2, y3);
                const int token = b * 4096 + seg * 1024 + chunk * 16 + t;
                *(u32x2*)(ys5 + (size_t)token * 512 + g * 16 + 4 * fq) = o;
            }
        }
        __syncthreads();
    }
}

constexpr int GL_TSTR = 144;
__device__ __forceinline__ void gla_ld_tile(const bf16* g, int pitch, u32x4 (&r)[8], int lane) {
#pragma unroll
    for (int i = 0; i < 8; ++i) { const int idx = lane + 64 * i; r[i] = *(const u32x4*)(g + (size_t)(idx >> 3) * pitch + (idx & 7) * 8); }
}
__device__ __forceinline__ void gla_st_tile(LAS unsigned char* img, const u32x4 (&r)[8], int lane) {
#pragma unroll
    for (int i = 0; i < 8; ++i) { const int idx = lane + 64 * i; *(LAS u32x4*)(img + (idx >> 3) * GL_TSTR + (idx & 7) * 16) = r[i]; }
}
__device__ __forceinline__ void gla_loga_tile(const Frame& F, int l, int row0, int h, LAS unsigned char* img, int lane_) {
    int lane = lane_; asm volatile("" : "+v"(lane));
    const int fr = lane & 15, fq = lane >> 4;
    const bf16* wa = wsp<bf16>(F, WS_WA2T) + (size_t)l * 256 * 16 + (size_t)(h * 64) * 16; const bf16* gl = wsp<bf16>(F, WS_GL) + (size_t)row0 * 16;
    const float* ba = F.in[15] + l * 256 + h * 64;
    bf16x8 af[4], bfr[4];
    const u32x4 zero4 = {0u, 0u, 0u, 0u};
#pragma unroll
    for (int i = 0; i < 4; ++i) {
        const u32x4 a = (fq < 2) ? *(const u32x4*)(wa + (size_t)(16 * i + fr) * 16 + 8 * fq) : zero4;
        const u32x4 b = (fq < 2) ? *(const u32x4*)(gl + (size_t)(16 * i + fr) * 16 + 8 * fq) : zero4;
        af[i] = __builtin_bit_cast(bf16x8, a); bfr[i] = __builtin_bit_cast(bf16x8, b);
    }
    float b44[4];
#pragma unroll
    for (int mt = 0; mt < 4; ++mt) b44[mt] = ba[16 * mt + fr];
    CFENCE();
#pragma unroll
    for (int mt = 0; mt < 4; ++mt) {
        const float b1 = b44[mt];
#pragma unroll
        for (int nt = 0; nt < 4; ++nt) {
            f32x4 z = {0.f, 0.f, 0.f, 0.f};
            z = MFMA16(bfr[nt], af[mt], z);
            float la[4];
#pragma unroll
            for (int j = 0; j < 4; ++j) { const float v = z[j] + b1; la[j] = (fminf(v, 0.f) - __logf(1.0f + __expf(-fabsf(v)))) * 0.0625f; }
            u32x2 o; o.x = cvt_pk_bf16(la[0], la[1]); o.y = cvt_pk_bf16(la[2], la[3]);
            *(LAS u32x2*)(img + (16 * mt + fr) * GL_TSTR + (16 * nt + 4 * fq) * 2) = o;
        }
    }
}
__device__ __forceinline__ void gla_row(const LAS unsigned char* img, int lane, u32x4 (&r)[8]) {
#pragma unroll
    for (int i = 0; i < 8; ++i) r[i] = *(const LAS u32x4*)(img + lane * GL_TSTR + i * 16);
}
#define GLA_ROWV(r, t) ((((t) & 1) ? bfhi((r)[(t) >> 3][((t) >> 1) & 3]) : bflo((r)[(t) >> 3][((t) >> 1) & 3])))
__device__ __forceinline__ float gla_col(const LAS unsigned char* img, int t, int lane) { return bf2f(*(const LAS bf16*)(img + t * GL_TSTR + lane * 2)); }
__device__ __forceinline__ void gla_a_unit(const Frame& F, int l, int wu) {
    const int lane = F.lane, fq = lane >> 4, fr = lane & 15;
    const int bh = wu >> 6, n = wu & 63, b = bh >> 2, h = bh & 3, row0 = b * 4096 + n * 64;
    LAS unsigned char* ra = F.lds + F.wave * WAVE_LDS; LAS unsigned char* rb = ra + 64 * GL_TSTR;
    const bf16* vp = wsp<bf16>(F, WS_V) + (size_t)row0 * 512 + h * 128;
    u32x4 t1[8], tv[8];
    gla_ld_tile(wsp<bf16>(F, WS_K) + (size_t)row0 * 256 + h * 64, 256, t1, lane);
    gla_ld_tile(vp, 512, tv, lane);
    gla_loga_tile(F, l, row0, h, ra, lane);
    gla_st_tile(rb, t1, lane);
    CFENCE();
    u32x4 lg[8]; gla_row(ra, lane, lg);
    float tot = 0.f;
#pragma unroll
    for (int t = 0; t < 64; ++t) tot += GLA_ROWV(lg, t);
    wsp<float>(F, WS_DEC)[(size_t)wu * 64 + lane] = __expf(tot);
    float cum = 0.f; u32x4 pk[8];
#pragma unroll
    for (int t8 = 0; t8 < 8; ++t8) {
        float ke[8], kc[8];
#pragma unroll
        for (int tt = 0; tt < 8; ++tt) kc[tt] = gla_col(rb, t8 * 8 + tt, lane);
        CFENCE();
#pragma unroll
        for (int tt = 0; tt < 8; ++tt) { const int t = t8 * 8 + tt; cum += GLA_ROWV(lg, t); ke[tt] = kc[tt] * __expf(tot - cum); }
        pk[t8].x = cvt_pk_bf16(ke[0], ke[1]); pk[t8].y = cvt_pk_bf16(ke[2], ke[3]); pk[t8].z = cvt_pk_bf16(ke[4], ke[5]); pk[t8].w = cvt_pk_bf16(ke[6], ke[7]);
    }
    CFENCE();
#pragma unroll
    for (int t8 = 0; t8 < 8; ++t8) *(LAS u32x4*)(ra + lane * GL_TSTR + t8 * 16) = pk[t8];
    bf16* ut = (bf16*)(F.dout + DO_UT) + (size_t)wu * 8192;
#pragma unroll
    for (int hv = 0; hv < 2; ++hv) {
        CFENCE();
        gla_st_tile(rb, tv, lane);
        if (hv == 0) gla_ld_tile(vp + 64, 512, tv, lane);
        CFENCE();
#pragma unroll
        for (int mt = 0; mt < 4; ++mt)
#pragma unroll
            for (int nt = 0; nt < 4; ++nt) {
                f32x4 acc = {0.f, 0.f, 0.f, 0.f};
#pragma unroll
                for (int ks = 0; ks < 2; ++ks) acc = MFMA16(frag_row(ra, GL_TSTR, 16 * mt, 32 * ks, lane), frag_tr(rb, GL_TSTR, 32 * ks, 16 * nt, lane), acc);
                { u32x2 o; o.x = cvt_pk_bf16(acc[0], acc[1]); o.y = cvt_pk_bf16(acc[2], acc[3]);
                  *(u32x2*)(ut + (size_t)(hv * 64 + nt * 16 + fr) * 64 + mt * 16 + 4 * fq) = o; }
            }
    }
}
__device__ __forceinline__ void gla_b_scan(const Frame& F) {
    const bf16* ut = (const bf16*)(F.dout + DO_UT); bf16* st = (bf16*)(F.dout + DO_ST); const float* dec = wsp<float>(F, WS_DEC);
    LAS float* dl = (LAS float*)F.lds;
    for (int blk = F.bid; blk < 256; blk += F.G) {
        const int bh = blk >> 3, e = (blk & 7) * 1024 + F.tid * 2, k = e & 63;
        __syncthreads();
#pragma unroll
        for (int i = 0; i < 2; ++i) *(LAS f32x4*)(dl + (F.tid + 512 * i) * 4) = *(const f32x4*)(dec + (size_t)bh * 4096 + (size_t)(F.tid + 512 * i) * 4);
        __syncthreads();
        f32x2 s2 = {0.f, 0.f};
        const bf16* up = ut + (size_t)bh * 64 * 8192 + e; bf16* sp = st + (size_t)bh * 64 * 8192 + e;
#pragma unroll 1
        for (int n0 = 0; n0 < 64; n0 += 16) {
            unsigned u16[16];
#pragma unroll
            for (int j = 0; j < 16; ++j) u16[j] = *(const unsigned*)(up + (size_t)(n0 + j) * 8192);
#pragma unroll
            for (int j = 0; j < 16; ++j) {
                const f32x2 d = *(const LAS f32x2*)(dl + (n0 + j) * 64 + k);
                *(unsigned*)(sp + (size_t)(n0 + j) * 8192) = cvt_pk_bf16(s2[0], s2[1]);
                s2 = d * s2 + (f32x2){bflo(u16[j]), bfhi(u16[j])};
            }
        }
    }
}
__device__ __forceinline__ void gla_c_unit(const Frame& F, int l, int wu) {
    const int lane = F.lane, fq = lane >> 4, fr = lane & 15;
    const int bh = wu >> 6, n = wu & 63, b = bh >> 2, h = bh & 3, row0 = b * 4096 + n * 64;
    LAS unsigned char* qtt = F.lds + F.wave * WAVE_LDS; LAS unsigned char* ktt = qtt + 64 * GL_TSTR;
    const bf16* vp = wsp<bf16>(F, WS_V) + (size_t)row0 * 512 + h * 128;
    u32x4 t1[8], t2[8], tv[8];
    gla_loga_tile(F, l, row0, h, qtt, lane);
    CFENCE();
    gla_ld_tile(wsp<bf16>(F, WS_K) + (size_t)row0 * 256 + h * 64, 256, t1, lane);
    gla_ld_tile(wsp<bf16>(F, WS_Q) + (size_t)row0 * 256 + h * 64, 256, t2, lane);
    gla_st_tile(ktt, t1, lane);
    CFENCE();
    unsigned e1p[32]; float cum = 0.f; u32x4 pkk[8], pkq[8];
    u32x4 lg[8]; gla_row(qtt, lane, lg);
#pragma unroll
    for (int t8 = 0; t8 < 8; ++t8) {
        float kt[8], e8[8], kc[8];
#pragma unroll
        for (int tt = 0; tt < 8; ++tt) kc[tt] = gla_col(ktt, t8 * 8 + tt, lane);
        CFENCE();
#pragma unroll
        for (int tt = 0; tt < 8; ++tt) { const int t = t8 * 8 + tt; cum += GLA_ROWV(lg, t); e8[tt] = __expf(cum); kt[tt] = kc[tt] * __builtin_amdgcn_rcpf(e8[tt]); }
#pragma unroll
        for (int j = 0; j < 4; ++j) e1p[t8 * 4 + j] = cvt_pk_bf16(e8[2 * j], e8[2 * j + 1]);
        pkk[t8].x = cvt_pk_bf16(kt[0], kt[1]); pkk[t8].y = cvt_pk_bf16(kt[2], kt[3]); pkk[t8].z = cvt_pk_bf16(kt[4], kt[5]); pkk[t8].w = cvt_pk_bf16(kt[6], kt[7]);
    }
    CFENCE();
    gla_st_tile(qtt, t2, lane);
    gla_ld_tile(vp, 512, tv, lane);
    CFENCE();
#pragma unroll
    for (int t8 = 0; t8 < 8; ++t8) {
        float qt[8], qc[8];
#pragma unroll
        for (int tt = 0; tt < 8; ++tt) qc[tt] = gla_col(qtt, t8 * 8 + tt, lane);
        CFENCE();
#pragma unroll
        for (int tt = 0; tt < 8; ++tt) { const int t = t8 * 8 + tt; const unsigned ep = e1p[t >> 1]; qt[tt] = qc[tt] * ((t & 1) ? bfhi(ep) : bflo(ep)) * 0.125f; }
        pkq[t8].x = cvt_pk_bf16(qt[0], qt[1]); pkq[t8].y = cvt_pk_bf16(qt[2], qt[3]); pkq[t8].z = cvt_pk_bf16(qt[4], qt[5]); pkq[t8].w = cvt_pk_bf16(qt[6], qt[7]);
    }
    CFENCE();
#pragma unroll
    for (int t8 = 0; t8 < 8; ++t8) { *(LAS u32x4*)(qtt + lane * GL_TSTR + t8 * 16) = pkq[t8]; *(LAS u32x4*)(ktt + lane * GL_TSTR + t8 * 16) = pkk[t8]; }
    CFENCE();
    u32x2 sc[4][4];
#pragma unroll
    for (int mt = 0; mt < 4; ++mt)
#pragma unroll
        for (int nt = 0; nt < 4; ++nt) {
            if (mt > nt) { sc[mt][nt] = (u32x2){0u, 0u}; continue; }
            f32x4 acc = {0.f, 0.f, 0.f, 0.f};
#pragma unroll
            for (int ks = 0; ks < 2; ++ks) acc = MFMA16(frag_tr(ktt, GL_TSTR, 32 * ks, 16 * mt, lane), frag_tr(qtt, GL_TSTR, 32 * ks, 16 * nt, lane), acc);
            if (mt == nt) {
#pragma unroll
                for (int rg = 0; rg < 4; ++rg) if (4 * fq + rg > fr) acc[rg] = 0.f;
            }
            sc[mt][nt].x = cvt_pk_bf16(acc[0], acc[1]); sc[mt][nt].y = cvt_pk_bf16(acc[2], acc[3]);
        }
    const bf16* st = (const bf16*)(F.dout + DO_ST) + (size_t)wu * 8192;
    f32x4 o[8][4];
#pragma unroll
    for (int hv = 0; hv < 2; ++hv) {
        CFENCE();
        gla_st_tile(ktt, tv, lane);
        CFENCE();
#pragma unroll
        for (int dt = 0; dt < 4; ++dt) {
            const int dvt = hv * 4 + dt;
            bf16x8 sfr[2], vfr[2];
#pragma unroll
            for (int ks = 0; ks < 2; ++ks) { sfr[ks] = *(const bf16x8*)(st + (size_t)(dvt * 16 + fr) * 64 + 32 * ks + 8 * fq); vfr[ks] = frag_tr_perm(ktt, GL_TSTR, 32 * ks, 16 * dt, lane); }
#pragma unroll
            for (int nt = 0; nt < 4; ++nt) {
                f32x4 acc = {0.f, 0.f, 0.f, 0.f};
#pragma unroll
                for (int ks = 0; ks < 2; ++ks) {
                    if (2 * ks <= nt) {
                        const u32x4 bw = {sc[2 * ks][nt].x, sc[2 * ks][nt].y, sc[2 * ks + 1][nt].x, sc[2 * ks + 1][nt].y};
                        acc = MFMA16(vfr[ks], __builtin_bit_cast(bf16x8, bw), acc);
                    }
                    acc = MFMA16(sfr[ks], frag_tr(qtt, GL_TSTR, 32 * ks, 16 * nt, lane), acc);
                }
                o[dvt][nt] = acc;
            }
        }
        if (hv == 0) gla_ld_tile(vp + 64, 512, tv, lane);
    }
    const float* gn = F.in[16] + l * 512 + h * 128;
    const bf16* rp = wsp<bf16>(F, WS_R) + (size_t)row0 * 512 + h * 128;
    bf16* mx = wsp<bf16>(F, WS_MIXED) + (size_t)row0 * D + 512 + h * 128;
    float rs4[4];
#pragma unroll
    for (int nt = 0; nt < 4; ++nt) {
        float ss = 0.f;
#pragma unroll
        for (int dvt = 0; dvt < 8; ++dvt) { const f32x4 x = o[dvt][nt]; ss += (x[0] * x[0] + x[1] * x[1]) + (x[2] * x[2] + x[3] * x[3]); }
        ss += __shfl_xor(ss, 16); ss += __shfl_xor(ss, 32);
        rs4[nt] = rsqrtf(ss * (1.0f / 128.0f) + EPS);
    }
    f32x4 gN = *(const f32x4*)(gn + 4 * fq); u32x2 rN[4];
#pragma unroll
    for (int nt = 0; nt < 4; ++nt) rN[nt] = *(const u32x2*)(rp + (size_t)(16 * nt + fr) * 512 + 4 * fq);
#pragma unroll
    for (int dvt = 0; dvt < 8; ++dvt) {
        const int dv = 16 * dvt + 4 * fq;
        const f32x4 g = gN; u32x2 rc[4];
#pragma unroll
        for (int nt = 0; nt < 4; ++nt) rc[nt] = rN[nt];
        if (dvt < 7) {
            gN = *(const f32x4*)(gn + dv + 16);
#pragma unroll
            for (int nt = 0; nt < 4; ++nt) rN[nt] = *(const u32x2*)(rp + (size_t)(16 * nt + fr) * 512 + dv + 16);
        }
        CFENCE();
#pragma unroll
        for (int nt = 0; nt < 4; ++nt) {
            const int i = 16 * nt + fr; const float rs = rs4[nt]; const u32x2 rr = rc[nt]; const f32x4 x = o[dvt][nt];
            u32x2 w; w.x = cvt_pk_bf16(x[0] * rs * g[0] * siluf_(bflo(rr.x)), x[1] * rs * g[1] * siluf_(bfhi(rr.x))); w.y = cvt_pk_bf16(x[2] * rs * g[2] * siluf_(bflo(rr.y)), x[3] * rs * g[3] * siluf_(bfhi(rr.y)));
            *(u32x2*)(mx + (size_t)i * D + dv) = w;
        }
    }
}
__device__ __forceinline__ void s5_fin_rows(const Frame& F, int l) {
    const int lane = F.lane, gw = F.bid * 8 + F.wave, NGW = F.G * 8;
    const bf16* y = wsp<bf16>(F, WS_UGM); bf16* mx = wsp<bf16>(F, WS_MIXED);
    const float* gn = F.in[13] + l * 512 + lane * 8; const f32x4 g0 = *(const f32x4*)gn, g1 = *(const f32x4*)(gn + 4);
    u32x4 an = {0u, 0u, 0u, 0u};
    if (gw < M) an = *((const u32x4*)(y + (size_t)gw * 512) + lane);
    for (int row = gw; row < M; row += NGW) {
        const u32x4 a = an;
        if (row + NGW < M) an = *((const u32x4*)(y + (size_t)(row + NGW) * 512) + lane);
        CFENCE();
        float v[8] = {bflo(a.x), bfhi(a.x), bflo(a.y), bfhi(a.y), bflo(a.z), bfhi(a.z), bflo(a.w), bfhi(a.w)}; float s = 0.f;
#pragma unroll
        for (int j = 0; j < 8; ++j) s += v[j] * v[j];
        s = wave_sum(s); const float rs = rsqrtf(s * (1.0f / 512.0f) + EPS);
        u32x4 w; w.x = cvt_pk_bf16(v[0] * rs * g0[0], v[1] * rs * g0[1]); w.y = cvt_pk_bf16(v[2] * rs * g0[2], v[3] * rs * g0[3]); w.z = cvt_pk_bf16(v[4] * rs * g1[0], v[5] * rs * g1[1]); w.w = cvt_pk_bf16(v[6] * rs * g1[2], v[7] * rs * g1[3]);
        *((u32x4*)(mx + (size_t)row * D) + lane) = w;
    }
}
__device__ __forceinline__ void moe_router(const Frame& F) {
    const int lane = F.lane, fr = lane & 15, fq = lane >> 4;
    const float* gain = F.in[18] + D; const float* wr_ = F.in[22];
    constexpr int RT_OFF = 16384, RT_STR = 2064;
    {
        const int k0 = 2 * F.tid;
        const f32x2 g2 = *(const f32x2*)(gain + k0);
        const f32x4 wa = *(const f32x4*)(wr_ + k0 * 8), wb = *(const f32x4*)(wr_ + k0 * 8 + 4), wc_ = *(const f32x4*)(wr_ + k0 * 8 + 8), wd = *(const f32x4*)(wr_ + k0 * 8 + 12);
        const float w0[8] = {wa[0], wa[1], wa[2], wa[3], wb[0], wb[1], wb[2], wb[3]}, w1_[8] = {wc_[0], wc_[1], wc_[2], wc_[3], wd[0], wd[1], wd[2], wd[3]};
#pragma unroll
        for (int e = 0; e < 8; ++e) {
            const float a = g2[0] * w0[e], b2 = g2[1] * w1_[e];
            const unsigned ah = f2bf(a), bh = f2bf(b2), al = f2bf(a - bf2f(ah)), bl = f2bf(b2 - bf2f(bh));
            *(LAS unsigned*)(F.lds + RT_OFF + e * RT_STR + k0 * 2) = ah | (bh << 16);
            *(LAS unsigned*)(F.lds + RT_OFF + (8 + e) * RT_STR + k0 * 2) = al | (bl << 16);
        }
    }
    __syncthreads();
    bf16x8 wf[32];
#pragma unroll
    for (int ks = 0; ks < 32; ++ks) wf[ks] = *(const LAS bf16x8*)(F.lds + RT_OFF + fr * RT_STR + (32 * ks + 8 * fq) * 2);
    const bf16* xb = wsp<bf16>(F, WS_XB); int* tok = wsp<int>(F, WS_TOK); float* wl = wsp<float>(F, WS_WL); float* rl = wsp<float>(F, WS_RL);
    unsigned* cnt = wsp<unsigned>(F, WS_CTL) + CW_CNT;
    LAS int* lcnt = (LAS int*)F.lds; LAS int* lbase = lcnt + 16; LAS int* rinfo = lbase + 16; LAS float* rw = (LAS float*)(rinfo + 1024); LAS float* rr = rw + 1024;
    const int rows_per_wg = ((M + F.G - 1) / F.G + 15) & ~15, r0 = F.bid * rows_per_wg, r1 = (r0 + rows_per_wg < M) ? r0 + rows_per_wg : M;
    if (F.tid < 16) lcnt[F.tid] = 0;
    __syncthreads();
    for (int m0 = r0 + 16 * F.wave; m0 < r1; m0 += 128) {
        f32x4 acc = {0.f, 0.f, 0.f, 0.f}; float ss = 0.f;
        const bf16* xr = xb + (size_t)(m0 + fr) * D + 8 * fq;
#pragma unroll
        for (int kg = 0; kg < 4; ++kg) {
            u32x4 a8[8];
#pragma unroll
            for (int kk = 0; kk < 8; ++kk) a8[kk] = *(const u32x4*)(xr + 32 * (8 * kg + kk));
            CFENCE();
#pragma unroll
            for (int kk = 0; kk < 8; ++kk) {
                const u32x4 a = a8[kk];
                const float x0 = bflo(a.x), x1 = bfhi(a.x), x2 = bflo(a.y), x3 = bfhi(a.y), x4 = bflo(a.z), x5 = bfhi(a.z), x6 = bflo(a.w), x7 = bfhi(a.w);
                ss += (x0 * x0 + x1 * x1) + (x2 * x2 + x3 * x3) + (x4 * x4 + x5 * x5) + (x6 * x6 + x7 * x7);
                acc = MFMA16(wf[8 * kg + kk], __builtin_bit_cast(bf16x8, a), acc);
            }
        }
        ss += __shfl_xor(ss, 16); ss += __shfl_xor(ss, 32);
        float lg4[4];
#pragma unroll
        for (int j = 0; j < 4; ++j) lg4[j] = acc[j] + __shfl_xor(acc[j], 32);
        float lg[8];
#pragma unroll
        for (int j = 0; j < 4; ++j) { const float o = __shfl_xor(lg4[j], 16); lg[j] = (fq & 1) ? o : lg4[j]; lg[4 + j] = (fq & 1) ? lg4[j] : o; }
        const float rs = rsqrtf(ss * (1.0f / D) + EPS);
        int e1 = 0; float l1 = lg[0];
#pragma unroll
        for (int e = 1; e < 8; ++e) if (lg[e] > l1) { l1 = lg[e]; e1 = e; }
        int e2 = -1; float l2 = -3.0e38f;
#pragma unroll
        for (int e = 0; e < 8; ++e) if (e != e1 && lg[e] > l2) { l2 = lg[e]; e2 = e; }
        const float w1 = 1.0f / (1.0f + __expf((l2 - l1) * rs));
        if (fq == 0) {
            const int p1 = __hip_atomic_fetch_add(lcnt + e1, 1, __ATOMIC_RELAXED, __HIP_MEMORY_SCOPE_WORKGROUP);
            const int p2 = __hip_atomic_fetch_add(lcnt + 8 + e2, 1, __ATOMIC_RELAXED, __HIP_MEMORY_SCOPE_WORKGROUP);
            const int i = m0 + fr - r0; rinfo[i] = e1 | (e2 << 4) | (p1 << 8) | (p2 << 20); rw[i] = w1; rr[i] = rs;
        }
    }
    __syncthreads();
    if (F.tid < 16) lbase[F.tid] = (int)__hip_atomic_fetch_add(cnt + F.tid, (unsigned)lcnt[F.tid], __ATOMIC_RELAXED, __HIP_MEMORY_SCOPE_AGENT);
    __syncthreads();
    for (int i = F.tid; i < r1 - r0; i += 512) {
        const int inf = rinfo[i], e1 = inf & 15, e2 = (inf >> 4) & 15, p1 = lbase[e1] + ((inf >> 8) & 4095), p2 = lbase[8 + e2] + ((inf >> 20) & 4095);
        const float w1 = rw[i], rs = rr[i];
        tok[e1 * 32768 + p1] = r0 + i; wl[e1 * 32768 + p1] = w1; rl[e1 * 32768 + p1] = rs;
        tok[(8 + e2) * 32768 + p2] = r0 + i; wl[(8 + e2) * 32768 + p2] = 1.0f - w1; rl[(8 + e2) * 32768 + p2] = rs;
    }
    __syncthreads();
}
__device__ __forceinline__ void final_norm(const Frame& F, bool from_xb) {
    const int lane = F.lane, gw = F.bid * 8 + F.wave, NGW = F.G * 8;
    const bf16* xo = from_xb ? wsp<bf16>(F, WS_XB) : wsp<bf16>(F, WS_XO); const float* g = F.in[26]; float* out = (float*)F.dout;
    f32x4 gv[4];
#pragma unroll
    for (int hh = 0; hh < 2; ++hh) { gv[2 * hh] = *(const f32x4*)(g + hh * 512 + lane * 8); gv[2 * hh + 1] = *(const f32x4*)(g + hh * 512 + lane * 8 + 4); }
    u32x4 n0 = {0u, 0u, 0u, 0u}, n1 = n0;
    if (gw < M) { n0 = *((const u32x4*)(xo + (size_t)gw * D) + lane); n1 = *((const u32x4*)(xo + (size_t)gw * D + 512) + lane); }
    for (int m = gw; m < M; m += NGW) {
        const u32x4 a0 = n0, a1 = n1;
        if (m + NGW < M) { n0 = *((const u32x4*)(xo + (size_t)(m + NGW) * D) + lane); n1 = *((const u32x4*)(xo + (size_t)(m + NGW) * D + 512) + lane); }
        CFENCE();
        const float x[16] = {bflo(a0.x), bfhi(a0.x), bflo(a0.y), bfhi(a0.y), bflo(a0.z), bfhi(a0.z), bflo(a0.w), bfhi(a0.w), bflo(a1.x), bfhi(a1.x), bflo(a1.y), bfhi(a1.y), bflo(a1.z), bfhi(a1.z), bflo(a1.w), bfhi(a1.w)};
        float ss = 0.f;
#pragma unroll
        for (int j = 0; j < 16; ++j) ss += x[j] * x[j];
        ss = wave_sum(ss); const float rs = rsqrtf(ss * (1.0f / D) + EPS);
#pragma unroll
        for (int hh = 0; hh < 2; ++hh) {
            const f32x4 g0 = gv[2 * hh], g1 = gv[2 * hh + 1];
            f32x4 o0 = {x[hh * 8 + 0] * rs * g0[0], x[hh * 8 + 1] * rs * g0[1], x[hh * 8 + 2] * rs * g0[2], x[hh * 8 + 3] * rs * g0[3]};
            f32x4 o1 = {x[hh * 8 + 4] * rs * g1[0], x[hh * 8 + 5] * rs * g1[1], x[hh * 8 + 6] * rs * g1[2], x[hh * 8 + 7] * rs * g1[3]};
            *(f32x4*)(out + (size_t)m * D + hh * 512 + lane * 8) = o0; *(f32x4*)(out + (size_t)m * D + hh * 512 + lane * 8 + 4) = o1;
        }
    }
}

__global__ void __launch_bounds__(512, 2) mk_fwd(Args args) {
    extern __shared__ __attribute__((aligned(16))) unsigned char lds_raw[];
    Frame F0;
    F0.lds = (LAS unsigned char*)lds_raw; F0.tid = threadIdx.x; F0.lane = F0.tid & 63; F0.wave = __builtin_amdgcn_readfirstlane(F0.tid >> 6);
    F0.G = gridDim.x; F0.bid = blockIdx.x; F0.in = args.in; F0.ws = args.ws; F0.dout = (unsigned char*)args.out;
    const Frame& F = F0;
    volatile LAS unsigned* MISC = (volatile LAS unsigned*)(F.lds + MISC_OFF);
    for (int u = F.tid; u < (LDS_BYTES - MISC_OFF) / 4; u += 512) MISC[u] = 0u;
    __syncthreads();
#if MK_N_LAUNCHES == 1
    XcdBarrier bar = xcd_barrier_post(wsp<unsigned>(F, WS_CTL) + CW_BAR, MISC);
#define GRID_BAR() xcd_barrier(bar)
#else
#define GRID_BAR() do {} while (0)
#endif
    const int lo = args.ph_lo, hi = args.ph_hi;
#ifndef PH_MASK
#define PH_MASK 0xFFFFFFu
#endif
#define IN(k) ((((PH_MASK) >> ((k) > 7 && (k) < 13 ? (k) - 7 : (k))) & 1u) && lo <= (k) && (k) < hi)
#define SEAM(k) do { if (IN(k) && IN((k) + 1)) GRID_BAR(); } while (0)
    LAS unsigned char* ring = F.lds;
#define xb wsp<bf16>(F, WS_XB)
#define ssp wsp<float>(F, WS_SSP)
#ifndef REP_PHASE
#define REP_PHASE (-1)
#endif
#ifndef REP_N
#define REP_N 0
#endif
#define REPS(k) (((k) == REP_PHASE) ? 1 + REP_N : 1)
#define REP_BEGIN(k) for (int rep = 0; rep < REPS(k); ++rep) {
#define REP_END(k) if (rep + 1 < REPS(k)) GRID_BAR(); }
    if (IN(0)) { REP_BEGIN(0) p0_prologue(launder(F0)); REP_END(0) } SEAM(0);

#pragma unroll 1
    for (int l = 0; l < 2; ++l) {
        const int pb = 1 + 7 * l;
        if (IN(pb)) {
            REP_BEGIN(1)
            const Frame F = launder(F0);
            pg8::ProbPlain P{xb, wsp<bf16>(F, WS_WIN) + (size_t)l * NPROJ * D, D, D, D};
            pg8::StaticOrder S; S.init(M / 256, 8, F.G, F.bid);
            EpiInproj E{ssp, F.ws + WS_ACT};
            pg8::gemm_phase(ring, P, S, E);
            glow_pass(launder(F0), l);
            REP_END(1)
        } SEAM(pb);
        if (IN(pb + 1)) {
            REP_BEGIN(2)
            const Frame F = launder(F0);
#ifndef PROBE_SUB
#define PROBE_SUB 0
#endif
#pragma unroll 1
            for (int pr = 0; pr < (PROBE_SUB == 1 ? 2 : 1); ++pr) for (int un = F.bid; un < 256; un += F.G) s5_unit(F, l, un);
#pragma unroll 1
            for (int pr = 0; pr < (PROBE_SUB == 2 ? 2 : 1); ++pr) for (int wu = F.bid * 8 + F.wave; wu < 2048; wu += F.G * 8) gla_a_unit(F, l, wu);
            REP_END(2)
        } SEAM(pb + 1);
        if (IN(pb + 2)) {
            REP_BEGIN(3)
            const Frame F = launder(F0);
            pg8::ProbPlain P{(const bf16*)(F.dout + DO_YS5), wsp<bf16>(F, WS_WGLU) + (size_t)l * 512 * 512, 512, 512, 512};
            pg8::StaticOrder S; S.init(M / 256, 2, F.G, F.bid);
            EpiGlu E{(const bf16*)(F.dout + DO_YS5), wsp<bf16>(F, WS_UGM), F.in[12] + l * 512};
            pg8::gemm_phase(ring, P, S, E);
#pragma unroll 1
            for (int pr = 0; pr < (PROBE_SUB == 3 ? 2 : 1); ++pr) gla_b_scan(launder(F0));
            REP_END(3)
        } SEAM(pb + 2);
        if (IN(pb + 3)) {
            REP_BEGIN(4)
            const Frame F = launder(F0);
#pragma unroll 1
            for (int pr = 0; pr < (PROBE_SUB == 4 ? 2 : 1); ++pr) for (int wu = F.bid * 8 + F.wave; wu < 2048; wu += F.G * 8) gla_c_unit(F, l, wu);
#pragma unroll 1
            for (int pr = 0; pr < (PROBE_SUB == 5 ? 2 : 1); ++pr) { s5_fin_rows(launder(F0), l); }
            REP_END(4)
        } SEAM(pb + 3);
        if (IN(pb + 4)) {
            REP_BEGIN(5)
            const Frame F = launder(F0);
            pg8::ProbPlain P{wsp<bf16>(F, WS_MIXED), wsp<bf16>(F, WS_WOUT) + (size_t)l * D * D, D, D, D};
            pg8::StaticOrder S; S.init(M / 256, 4, F.G, F.bid);
            const bool want8 = (l == 0) ? (USE_F8_FFN != 0) : (USE_F8_MOE != 0);
            EpiResid E{xb, ssp, rep ? (bf16*)F.dout : xb, rep == 0, (want8 && rep == 0) ? wsp<unsigned char>(F, WS_X8) : nullptr, 1.0f};
            pg8::gemm_phase(ring, P, S, E);
            REP_END(5)
        } SEAM(pb + 4);
        if (l == 0) {
            if (IN(6)) {
                REP_BEGIN(6)
                const Frame F = launder(F0);
                constexpr int KU = USE_F8_FFN ? D / 2 : D;
                pg8::ProbPlainT<USE_F8_FFN != 0> P{USE_F8_FFN ? wsp<bf16>(F, WS_X8) : xb, wsp<bf16>(F, WS_WFGU), KU, KU, KU};
                pg8::StaticOrder S; S.init(M / 256, 2 * DFF / 256, F.G, F.bid);
                EpiSwigluT<USE_F8_FFN != 0> E{ssp, wsp<bf16>(F, WS_HD), DFF};
                pg8::gemm_phase(ring, P, S, E);
                REP_END(6)
            } SEAM(6);
            if (IN(7)) {
                REP_BEGIN(7)
                const Frame F = launder(F0);
                constexpr int KD = USE_F8_FFN ? DFF / 2 : DFF;
                pg8::ProbPlainT<USE_F8_FFN != 0, true> P{wsp<bf16>(F, WS_HD), wsp<bf16>(F, WS_WFD), KD, KD, KD};
                pg8::StaticOrder S; S.init(M / 256, 4, F.G, F.bid);
                EpiResid E{xb, ssp, rep ? (bf16*)F.dout : xb, rep == 0, nullptr, USE_F8_FFN ? 1.0f / (F8_SH * F8_SW_DN) : 1.0f};
                pg8::gemm_phase(ring, P, S, E);
                REP_END(7)
            } SEAM(7);
        }
    }
    if (IN(13)) { moe_router(launder(F0)); } SEAM(13);
#pragma unroll 1
    for (int s = 0; s < 5; ++s) {
        if (IN(14 + s)) {
            const Frame F = launder(F0);
            moe_build_tables(F);
            const MoeTab T = moe_tab(F);
            int nheavy = 0;
            if (s >= 1) {
                REP_BEGIN(15)
                constexpr int KD = DFE * MOE_ESZ / 2;
                ProbMoeDown P{((s - 1) & 1) ? (void*)wsp<bf16>(F, WS_H1) : (void*)F.dout, wsp<bf16>(F, WS_MD), KD, KD, KD};
                MoeOrder S; S.init(T, s - 1, 4, F.G, F.bid, 0, 0);
                nheavy = S.nheavy_next();
                EpiMoeDown E{wsp<int>(F, WS_TOK), wsp<float>(F, WS_WL), xb, wsp<bf16>(F, WS_XO), T, rep != 0};
                pg8::gemm_phase(ring, P, S, E);
                REP_END(15)
            }
            if (s < 4) {
                REP_BEGIN(14)
                constexpr int KU = D * MOE_ESZ / 2;
                ProbMoeUp P{USE_F8_MOE ? (const void*)wsp<unsigned char>(F, WS_X8) : (const void*)xb, wsp<bf16>(F, WS_MGU), wsp<int>(F, WS_TOK), T, KU, KU, KU};
                MoeOrder S; S.init(T, s, 2 * DFE / 256, F.G, F.bid, nheavy, 3);
                EpiSwigluMoe E{wsp<float>(F, WS_RL), (s & 1) ? (void*)wsp<bf16>(F, WS_H1) : (void*)F.dout, T};
                pg8::gemm_phase(ring, P, S, E);
                REP_END(14)
            }
        } SEAM(14 + s);
    }
    if (IN(19)) { REP_BEGIN(19) final_norm(launder(F0), hi > 50); REP_END(19) }
#undef xb
#undef ssp
#undef IN
#undef SEAM
}

extern "C" void kernel_launch(void* const* d_in, const int* in_sizes, int n_in, void* d_out, int out_size, void* d_ws, size_t ws_size, hipStream_t stream) {
    static int grid = 0;
    if (grid == 0) {
        if (n_in != 27 || in_sizes[0] != M * D || out_size != M * D || ws_size < WS_END) { fprintf(stderr, "kernel_launch: unexpected shapes (n_in %d, ws %zu < %zu?)\n", n_in, ws_size, (size_t)WS_END); grid = -1; return; }
        int dev = 0, cus = 0, per_cu = 0;
        if (hipGetDevice(&dev) != hipSuccess || hipDeviceGetAttribute(&cus, hipDeviceAttributeMultiprocessorCount, dev) != hipSuccess) { grid = -1; return; }
        if (hipFuncSetAttribute((const void*)mk_fwd, hipFuncAttributeMaxDynamicSharedMemorySize, LDS_BYTES) != hipSuccess) { fprintf(stderr, "kernel_launch: hipFuncSetAttribute failed\n"); grid = -1; return; }
        if (hipOccupancyMaxActiveBlocksPerMultiprocessor(&per_cu, (const void*)mk_fwd, 512, LDS_BYTES) != hipSuccess || per_cu < 1) fprintf(stderr, "kernel_launch: occupancy query says %d\n", per_cu);
        (void)hipGetLastError();
        grid = cus;
    }
    if (grid < 0) return;
    if (hipMemsetAsync((char*)d_ws + WS_CTL, 0, CTL_ZERO_BYTES, stream) != hipSuccess) return;
    Args a{};
    for (int i = 0; i < 27; ++i) a.in[i] = (const float*)d_in[i];
    a.out = (float*)d_out; a.ws = (unsigned char*)d_ws;
#if MK_N_LAUNCHES == 1
#ifdef PROBE_PREFIX
    a.ph_lo = 0; a.ph_hi = PROBE_PREFIX + 1;
    hipLaunchKernelGGL(mk_fwd, dim3(grid), dim3(512), LDS_BYTES, stream, a);
    if (hipMemsetAsync((char*)d_ws + WS_CTL, 0, CTL_ZERO_BYTES, stream) != hipSuccess) return;
#endif
    a.ph_lo = 0; a.ph_hi = NPHASE;
    hipLaunchKernelGGL(mk_fwd, dim3(grid), dim3(512), LDS_BYTES, stream, a);
#else
#ifdef EXP_STOP
    for (int p = 0; p <= EXP_STOP; ++p) { a.ph_lo = p; a.ph_hi = p + 1; hipLaunchKernelGGL(mk_fwd, dim3(grid), dim3(512), LDS_BYTES, stream, a); }
    a.ph_lo = 19; a.ph_hi = 100; hipLaunchKernelGGL(mk_fwd, dim3(grid), dim3(512), LDS_BYTES, stream, a);
#else
    for (int p = 0; p < NPHASE; ++p) { a.ph_lo = p; a.ph_hi = p + 1; hipLaunchKernelGGL(mk_fwd, dim3(grid), dim3(512), LDS_BYTES, stream, a); }
#endif
#endif
}
```

```cpp
#include <hip/hip_runtime.h>
#include <cstdio>
#include <cstdint>

#ifndef USE_F8_FFN
#define USE_F8_FFN 0
#endif
#ifndef USE_F8_MOE
#define USE_F8_MOE 1
#endif
#ifndef MK_N_LAUNCHES
#define MK_N_LAUNCHES 1
#endif

#define LAS __attribute__((address_space(3)))
#define GAS __attribute__((address_space(1)))
typedef unsigned short bf16;
typedef short bf16x8 __attribute__((ext_vector_type(8)));
typedef short s16x4 __attribute__((ext_vector_type(4)));
typedef short v4i16_t __attribute__((ext_vector_type(4)));
typedef float f32x4 __attribute__((ext_vector_type(4)));
typedef float f32x2 __attribute__((ext_vector_type(2)));
typedef unsigned u32x4 __attribute__((ext_vector_type(4)));
typedef unsigned u32x2 __attribute__((ext_vector_type(2)));
typedef int i32x4_t __attribute__((ext_vector_type(4)));

constexpr int BATCH = 8, SEQ = 4096, D = 1024, M = BATCH * SEQ;
constexpr int DS5 = 512, NGRP = 32, NST = 64;
constexpr int GH = 4, DK = 64, DV = 128, DGK = 256, DGV = 512, NCH = SEQ / 64;
constexpr int DIN = 2064, NPROJ = 2304;
constexpr int DFF = 2816, NE = 8, DFE = 3584;
constexpr float EPS = 1e-6f;
constexpr int NPHASE = 20;

constexpr size_t MiB = 1u << 20;
constexpr size_t WS_CTL = 0, CTL_ZERO_BYTES = 2 * MiB;
constexpr size_t WS_SSP = 2 * MiB;
constexpr size_t WS_WIN = 4 * MiB;
constexpr size_t WS_WGLU = 13 * MiB;
constexpr size_t WS_WOUT = 14 * MiB;
constexpr size_t WS_WFGU = 18 * MiB;
constexpr size_t WS_WFD = 29 * MiB;
constexpr size_t WS_S5P = 35 * MiB;
constexpr size_t WS_S5MQ = 39 * MiB;
constexpr size_t WS_S5A16 = 51 * MiB;
constexpr size_t WS_WGT = 51 * MiB + 65536;
constexpr size_t WS_WA2T = 51 * MiB + 131072;
constexpr size_t WS_MGU = 52 * MiB;
constexpr size_t WS_MD = (USE_F8_MOE ? 108 : 164) * MiB;
constexpr size_t WS_X8 = (USE_F8_MOE ? 136 : 500) * MiB;
static_assert(USE_F8_MOE || !USE_F8_FFN, "x8 lives in the space the fp8 expert weights leave free");
constexpr size_t WS_XB = 220 * MiB;
constexpr size_t WS_ACT = 284 * MiB;
constexpr size_t WS_UGM = WS_ACT;
constexpr size_t WS_Q = WS_ACT + 32 * MiB;
constexpr size_t WS_K = WS_ACT + 48 * MiB;
constexpr size_t WS_V = WS_ACT + 64 * MiB;
constexpr size_t WS_R = WS_ACT + 96 * MiB;
constexpr size_t WS_GL = WS_ACT + 128 * MiB;
constexpr size_t WS_MIXED = WS_ACT + 144 * MiB;
constexpr size_t WS_HD = WS_ACT;
constexpr size_t WS_H1 = WS_ACT;
constexpr size_t WS_XO = WS_ACT + 120 * MiB;
constexpr size_t WS_TOK = WS_ACT + 184 * MiB;
constexpr size_t WS_WL = WS_ACT + 186 * MiB;
constexpr size_t WS_RL = WS_ACT + 188 * MiB;
constexpr size_t WS_DEC = WS_ACT + 208 * MiB;
constexpr size_t WS_END = WS_ACT + 209 * MiB;
constexpr size_t DO_UT = 0, DO_ST = 64 * MiB, DO_YS5 = 96 * MiB;
constexpr int MOE_CAP_TILES = 68;
constexpr int CW_BAR = 4096;
constexpr int CW_CNT = 16384;

constexpr int RING_BYTES = 131072;
constexpr int MOE_TAB_OFF = 131072;
constexpr int MISC_OFF = 147456;
constexpr int LDS_BYTES = 148480;
constexpr int WAVE_LDS = 18432;

#define LDS_WAIT() asm volatile("s_waitcnt lgkmcnt(0)" ::: "memory")
#define VM_WAIT() asm volatile("s_waitcnt vmcnt(0)" ::: "memory")
#define CFENCE() asm volatile("" ::: "memory")
__device__ __forceinline__ unsigned f2bf(float f) { unsigned u = __builtin_bit_cast(unsigned, f); return (u + 0x7fffu + ((u >> 16) & 1u)) >> 16; }
__device__ __forceinline__ unsigned pk2(float lo, float hi) { return f2bf(lo) | (f2bf(hi) << 16); }
__device__ __forceinline__ float bf2f(unsigned b) { return __builtin_bit_cast(float, b << 16); }
__device__ __forceinline__ float bflo(unsigned w) { return __builtin_bit_cast(float, w << 16); }
__device__ __forceinline__ float bfhi(unsigned w) { return __builtin_bit_cast(float, w & 0xffff0000u); }
typedef __bf16 bf16x2_t __attribute__((ext_vector_type(2)));
__device__ __forceinline__ unsigned cvt_pk_bf16(float lo, float hi) { const f32x2 v = {lo, hi}; return __builtin_bit_cast(unsigned, __builtin_convertvector(v, bf16x2_t)); }
__device__ __forceinline__ unsigned pk4_fp8(float a, float b, float c, float d) {
    a = __builtin_amdgcn_fmed3f(a, -448.f, 448.f); b = __builtin_amdgcn_fmed3f(b, -448.f, 448.f); c = __builtin_amdgcn_fmed3f(c, -448.f, 448.f); d = __builtin_amdgcn_fmed3f(d, -448.f, 448.f);
    int w = 0; w = __builtin_amdgcn_cvt_pk_fp8_f32(a, b, w, false); w = __builtin_amdgcn_cvt_pk_fp8_f32(c, d, w, true); return (unsigned)w;
}
__device__ __forceinline__ f32x2 swiglu2(f32x2 g, f32x2 u, float nrs, float c) {
    const f32x2 t = g * nrs;
    f32x2 d = {__builtin_amdgcn_exp2f(t[0]), __builtin_amdgcn_exp2f(t[1])};
    d = d + 1.0f;
    const f32x2 r = {__builtin_amdgcn_rcpf(d[0]), __builtin_amdgcn_rcpf(d[1])};
    return (g * u) * (r * c);
}
constexpr float F8_SW_UP = 64.f, F8_SH = 4.f, F8_SW_DN = 128.f;
__device__ __forceinline__ float wave_sum(float v) {
#pragma unroll
    for (int o = 1; o < 64; o <<= 1) v += __shfl_xor(v, o);
    return v;
}
__device__ __forceinline__ float sigmoidf_(float z) { return __builtin_amdgcn_rcpf(1.0f + __expf(-z)); }
__device__ __forceinline__ float siluf_(float z) { return z * __builtin_amdgcn_rcpf(1.0f + __expf(-z)); }
__device__ __forceinline__ float gelu_tanh(float y) { const float z = 0.7978845608028654f * (y + 0.044715f * y * y * y); return y * __builtin_amdgcn_rcpf(1.0f + __expf(-2.0f * z)); }

#define XB_TMO      128
#define XB_XCNT(j)  (256  + 64 * (j))
#define XB_XSUB(j)  (1280 + 64 * (j))
#define XB_XGEN(j)  (2304 + 64 * (j))
#define XB_TOP      3328
#define XB_TOPGEN   3392
#define XCD_BAR_WORDS 3456
#define XB_SPIN_CAP (1u << 18)
__device__ __forceinline__ unsigned xb_ld(unsigned* p)              { return __hip_atomic_load(p, __ATOMIC_RELAXED, __HIP_MEMORY_SCOPE_AGENT); }
__device__ __forceinline__ unsigned xb_add(unsigned* p, unsigned v) { return __hip_atomic_fetch_add(p, v, __ATOMIC_RELAXED, __HIP_MEMORY_SCOPE_AGENT); }
__device__ __forceinline__ unsigned xb_xcc_id() { return (unsigned)__builtin_amdgcn_s_getreg((3 << 11) | 20) & 0xFu; }
#define XB_SPIN(cond, bar) do { unsigned _sp = 0; while (cond) { __builtin_amdgcn_s_sleep(1); \
    if ((++_sp & 255u) == 0u) { if (xb_ld(&(bar)[XB_TMO])) break; if (_sp > XB_SPIN_CAP) { atomicAdd(&(bar)[XB_TMO], 1u); break; } } } } while (0)
struct XcdBarrier { unsigned* bar; unsigned x; volatile LAS unsigned* st; };
__device__ __forceinline__ XcdBarrier xcd_barrier_post(unsigned* bar, volatile LAS unsigned* st) {
    XcdBarrier b; b.bar = bar; b.x = xb_xcc_id(); b.st = st;
    if (threadIdx.x == 0) (void)xb_add(&bar[XB_XCNT(b.x)], 1u);
    return b;
}
__device__ __forceinline__ void xcd_barrier_complete(unsigned* bar, unsigned x, unsigned& nloc, unsigned& nx) {
    const unsigned G = gridDim.x * gridDim.y * gridDim.z;
    unsigned sum, cnt, mine, sp = 0u;
    for (;;) {
        sum = 0u; cnt = 0u; mine = 0u;
#pragma unroll
        for (unsigned j = 0; j < 16; ++j) { const unsigned c = xb_ld(&bar[XB_XCNT(j)]); sum += c; cnt += (c > 0u) ? 1u : 0u; mine = (j == x) ? c : mine; }
        if (sum == G) break;
        __builtin_amdgcn_s_sleep(1);
        if ((++sp & 255u) == 0u) { if (xb_ld(&bar[XB_TMO])) break; if (sp > XB_SPIN_CAP) { atomicAdd(&bar[XB_TMO], 1u); break; } }
    }
    nloc = mine > 0u ? mine : 1u; nx = cnt > 0u ? cnt : 1u;
}
__device__ __forceinline__ void xcd_barrier(const XcdBarrier& b) {
    asm volatile("s_waitcnt vmcnt(0)" ::: "memory");
    __syncthreads();
    if (threadIdx.x == 0) {
        unsigned* bar = b.bar;
        __builtin_amdgcn_s_waitcnt(0);
        unsigned nloc = b.st[0], nx = b.st[1];
        if (nloc == 0u) { xcd_barrier_complete(bar, b.x, nloc, nx); b.st[0] = nloc; b.st[1] = nx; }
        const unsigned old = xb_add(&bar[XB_XSUB(b.x)], 1u);
        const unsigned gen = old / nloc;
        if (old + 1u == (gen + 1u) * nloc) {
            __builtin_amdgcn_fence(__ATOMIC_RELEASE, "agent");
            asm volatile("s_waitcnt vmcnt(0)" ::: "memory");
            const unsigned og = xb_add(&bar[XB_TOP], 1u);
            const unsigned tg = og / nx;
            if (og + 1u == (tg + 1u) * nx) xb_add(&bar[XB_TOPGEN], 1u);
            else XB_SPIN(xb_ld(&bar[XB_TOPGEN]) == tg, bar);
            __builtin_amdgcn_fence(__ATOMIC_ACQUIRE, "agent");
            xb_add(&bar[XB_XGEN(b.x)], 1u);
            asm volatile("s_waitcnt vmcnt(0)" ::: "memory");
        } else {
            XB_SPIN(xb_ld(&bar[XB_XGEN(b.x)]) == gen, bar);
            __builtin_amdgcn_fence(__ATOMIC_ACQUIRE, "agent");
            asm volatile("s_waitcnt vmcnt(0)" ::: "memory");
        }
    }
    __syncthreads();
}

namespace pg8 {
constexpr int BM = 256, BK = 64, HALF = 128, HTB = HALF * BK * 2, STAGE_BYTES = 8 * HTB, NXCD = 8, WGM = 8;
constexpr int A_TAB_OFF = 131072 + 8192;
constexpr int EPI_TAB_OFF = 131072 + 4096;
__host__ __device__ __forceinline__ int lds_byte(int r, int c) { const int st = (r >> 4) * 2 + (c >> 5), rr = r & 15, cc = c & 31, ob = rr * 64 + cc * 2; return st * 1024 + (ob ^ (((ob >> 9) & 1) << 5)); }
__host__ __device__ __forceinline__ void stage_rc(int b, int& R, int& C) { const int st = b / 1024, sb = b % 1024, swz = sb ^ (((sb >> 9) & 1) << 5); R = (st >> 1) * 16 + swz / 64; C = (st & 1) * 32 + (swz % 64) / 2; }
__host__ __device__ __forceinline__ int perm32(int rho) { const int n = rho >> 4, i = rho & 15; return 8 * (i >> 2) + 4 * n + (i & 3); }

struct Unit { int pm, pn, e, sub; };

struct StaticOrder {
    int nM, nN, nwg, G, c;
    __device__ __forceinline__ void init(int nM_, int nN_, int G_, int c_) { nM = nM_; nN = nN_; nwg = nM * nN; G = G_; c = c_; }
    __device__ __forceinline__ bool next(int i, Unit& u) const {
        const long L = (long)i * G + c; if (L >= nwg) return false;
        int wgid = (int)L; { const int q = nwg / NXCD, r = nwg % NXCD, xcd = wgid % NXCD, off = wgid / NXCD; wgid = (xcd < r ? xcd * (q + 1) : r * (q + 1) + (xcd - r) * q) + off; }
        const int nig = WGM * nN, gid = wgid / nig, fm = gid * WGM, gsz = (nM - fm) < WGM ? (nM - fm) : WGM;
        u.pm = fm + ((wgid % nig) % gsz); u.pn = (wgid % nig) / gsz; u.e = 0; u.sub = 0; return true;
    }
};

template <class Epi, class Sched, class Prob>
__device__ __forceinline__ void gemm_phase(LAS unsigned char* lds, const Prob& P, const Sched& S, const Epi& E) {
    int tid_ = threadIdx.x; asm volatile("" : "+v"(tid_));
    const int tid = tid_, wid = __builtin_amdgcn_readfirstlane(tid >> 6), lane = tid & 63, wr = wid >> 2, wc = wid & 3, fr = lane & 15, fq = lane >> 4;
    const int K = P.K, nt = K / BK;
    int Rr[2], Cc[2]; unsigned voffB[2];
#pragma unroll
    for (int i = 0; i < 2; ++i) { int R, C; stage_rc(tid * 16 + i * 8192, R, C); Rr[i] = R; Cc[i] = C; const int Rb = (R & ~31) + perm32(R & 31); voffB[i] = (unsigned)(Rb * P.ldb + C) * 2u; }
    const size_t kstep = (size_t)(BK * 2);
    const size_t hstepB = (size_t)HALF * P.ldb * 2;
    const unsigned ldsw = (unsigned)wid * 1024u;
    const int aoff = lds_byte(wr * 64 + fr, fq * 8), boff = lds_byte(wc * 32 + fr, fq * 8);
#define PG8_SA(b, h) (((b) * 2 + (h)) * HTB)
#define PG8_SB(b, h) ((4 + (b) * 2 + (h)) * HTB)
#define PG8_STAGE(bufoff, gbase, voff) do { _Pragma("unroll") for (int _i = 0; _i < 2; ++_i) \
        __builtin_amdgcn_global_load_lds((const unsigned*)((const char*)(gbase) + (voff)[_i]), (LAS unsigned*)(lds + (bufoff) + ldsw + _i * 8192), 16, 0, 0); } while (0)
#define PG8_LDA(dst, b, h) do { _Pragma("unroll") for (int m = 0; m < 4; ++m) _Pragma("unroll") for (int k = 0; k < 2; ++k) dst[m][k] = *(const LAS bf16x8*)(lds + PG8_SA(b, h) + aoff + m * 2048 + k * 1024); } while (0)
#define PG8_LDB(dst, b, h) do { _Pragma("unroll") for (int n = 0; n < 2; ++n) _Pragma("unroll") for (int k = 0; k < 2; ++k) dst[n][k] = *(const LAS bf16x8*)(lds + PG8_SB(b, h) + boff + n * 2048 + k * 1024); } while (0)
#define PG8_CAT(x) __builtin_shufflevector(__builtin_bit_cast(i32x4_t, (x)[0]), __builtin_bit_cast(i32x4_t, (x)[1]), 0, 1, 2, 3, 4, 5, 6, 7)
#define PG8_MMA(ai, bj, At, Bt) do { __builtin_amdgcn_s_setprio(1); _Pragma("unroll") for (int m = 0; m < 4; ++m) _Pragma("unroll") for (int n = 0; n < 2; ++n) { \
        if constexpr (Prob::F8) asm volatile("v_mfma_scale_f32_16x16x128_f8f6f4 %0, %1, %2, %0, %3, %3 op_sel_hi:[0,0,0]" : "+v"(acc[ai][bj][m][n]) : "v"(PG8_CAT(Bt[n])), "v"(PG8_CAT(At[m])), "v"(f8one)); \
        else { _Pragma("unroll") for (int k = 0; k < 2; ++k) acc[ai][bj][m][n] = __builtin_amdgcn_mfma_f32_16x16x32_bf16(Bt[n][k], At[m][k], acc[ai][bj][m][n], 0, 0, 0); } } \
        __builtin_amdgcn_s_setprio(0); } while (0)
#define PG8_WAIT_V(n) asm volatile("s_waitcnt vmcnt(" #n ")" ::: "memory")
#define PG8_WAIT_L(n) asm volatile("s_waitcnt lgkmcnt(" #n ")" ::: "memory")
#define PG8_BAR __builtin_amdgcn_s_barrier()
#define PG8_SCHED __builtin_amdgcn_sched_barrier(0)
    const int f8one = 0x7f7f7f7f;
    Unit cur, nxt; int ui = 0;
    if (!S.next(0, cur)) return;
    f32x4 acc[2][2][4][2];
#pragma unroll
    for (int a = 0; a < 2; ++a)
#pragma unroll
        for (int b = 0; b < 2; ++b)
#pragma unroll
            for (int m = 0; m < 4; ++m)
#pragma unroll
                for (int n = 0; n < 2; ++n) acc[a][b][m][n] = (f32x4){0.f, 0.f, 0.f, 0.f};
    bf16x8 At[4][2], B0[2][2], B1[2][2];
    constexpr bool GA = Prob::GATHER;
    constexpr int NH = GA ? 2 : 1;
    unsigned vA[NH][2], nvA[NH][2];
    const size_t hstepA = GA ? (size_t)0 : P.hstep_a();
    const size_t kstepA = P.kstep_a();
    P.a_off(cur, Rr, Cc, vA);
    const char* cA = P.a_ptr(cur); const char* cB = P.b_ptr(cur);
#define PG8_STAGEA(bufoff, gbase, h, arr) do { _Pragma("unroll") for (int _i = 0; _i < 2; ++_i) \
        __builtin_amdgcn_global_load_lds((const unsigned*)((const char*)(gbase) + (GA ? (size_t)0 : (size_t)(h) * hstepA) + (arr)[GA ? (h) : 0][_i]), (LAS unsigned*)(lds + (bufoff) + ldsw + _i * 8192), 16, 0, 0); } while (0)
    if constexpr (GA) { Unit u1; if (S.next(1, u1)) P.atab_issue(u1, lds + A_TAB_OFF + 1024, wid, lane); }
    PG8_STAGE(PG8_SB(0, 0), cB, voffB); PG8_STAGE(PG8_SB(0, 1), cB + hstepB, voffB); PG8_STAGEA(PG8_SA(0, 0), cA, 0, vA); PG8_STAGEA(PG8_SA(0, 1), cA, 1, vA);
    if (wr == 1) PG8_BAR;
    PG8_WAIT_V(2); PG8_BAR;
    PG8_STAGE(PG8_SB(1, 0), cB + kstep, voffB); PG8_STAGEA(PG8_SA(1, 0), cA + kstepA, 0, vA); PG8_STAGE(PG8_SB(1, 1), cB + hstepB + kstep, voffB);
    PG8_WAIT_V(6); PG8_BAR;
    for (;;) {
        const bool has_next = S.next(ui + 1, nxt);
        const char* nA = has_next ? P.a_ptr(nxt) : cA; const char* nB = has_next ? P.b_ptr(nxt) : cB;
        if constexpr (GA) {
            if (has_next) { int R2[2], C2[2], t2 = tid; asm volatile("" : "+v"(t2));
#pragma unroll
                for (int i = 0; i < 2; ++i) stage_rc(t2 * 16 + i * 8192, R2[i], C2[i]);
                P.a_off_tab(lds + A_TAB_OFF + ((ui + 1) & 1) * 1024, R2, C2, nvA);
                Unit n2; if (S.next(ui + 2, n2)) P.atab_issue(n2, lds + A_TAB_OFF + (ui & 1) * 1024, wid, lane); }
            else {
#pragma unroll
                for (int h = 0; h < NH; ++h)
#pragma unroll
                    for (int i = 0; i < 2; ++i) nvA[h][i] = vA[h][i];
            }
        }
        if constexpr (Epi::HAS_TAB) E.tab_issue(cur, lds + EPI_TAB_OFF + (ui & 1) * 2048, wid, lane);
        for (int t = 0; t < nt; t += 2) {
            const bool last = (t == nt - 2);
            const char* a1 = cA + (size_t)(t + 1) * kstepA;
            const char* a2 = last ? nA : cA + (size_t)(t + 2) * kstepA; const char* b2 = last ? nB : cB + (size_t)(t + 2) * kstep;
            const char* a3 = a2 + kstepA; const char* b3 = b2 + kstep;
            unsigned wA[NH][2];
#pragma unroll
            for (int h = 0; h < NH; ++h)
#pragma unroll
                for (int i = 0; i < 2; ++i) wA[h][i] = (GA && last) ? nvA[h][i] : vA[h][i];
            PG8_LDB(B0, 0, 0); PG8_LDB(B1, 0, 1); PG8_SCHED; PG8_LDA(At, 0, 0); PG8_STAGEA(PG8_SA(1, 1), a1, 1, vA);
            PG8_WAIT_V(8); PG8_WAIT_L(0); PG8_BAR; PG8_MMA(0, 0, At, B0); PG8_MMA(0, 1, At, B1); PG8_BAR; PG8_SCHED;
            PG8_LDA(At, 0, 1); PG8_STAGE(PG8_SB(0, 0), b2, voffB); PG8_STAGE(PG8_SB(0, 1), b2 + hstepB, voffB); PG8_STAGEA(PG8_SA(0, 0), a2, 0, wA);
            PG8_WAIT_V(8); PG8_WAIT_L(0); PG8_BAR; PG8_MMA(1, 0, At, B0); PG8_MMA(1, 1, At, B1); PG8_BAR; PG8_SCHED;
            PG8_LDB(B0, 1, 0); PG8_LDB(B1, 1, 1); PG8_SCHED; PG8_LDA(At, 1, 0); PG8_STAGEA(PG8_SA(0, 1), a2, 1, wA);
            PG8_WAIT_V(8); PG8_WAIT_L(0); PG8_BAR; PG8_MMA(0, 0, At, B0); PG8_MMA(0, 1, At, B1); PG8_BAR; PG8_SCHED;
            PG8_LDA(At, 1, 1); PG8_STAGE(PG8_SB(1, 0), b3, voffB); PG8_STAGE(PG8_SB(1, 1), b3 + hstepB, voffB); PG8_STAGEA(PG8_SA(1, 0), a3, 0, wA);
            PG8_WAIT_V(8); PG8_WAIT_L(0); PG8_BAR; PG8_MMA(1, 0, At, B0); PG8_MMA(1, 1, At, B1); PG8_BAR; PG8_SCHED;
        }
        if (wr == 0) PG8_BAR;
        if constexpr (Prob::F8) asm volatile("s_nop 15\n\ts_nop 7" ::: "memory");
        if constexpr (Epi::HAS_TAB) E(acc, cur, wr, wc, fr, fq, lds + EPI_TAB_OFF + (ui & 1) * 2048);
        else E(acc, cur, wr, wc, fr, fq);
        if (!has_next) break;
#pragma unroll
        for (int a = 0; a < 2; ++a)
#pragma unroll
            for (int b = 0; b < 2; ++b)
#pragma unroll
                for (int m = 0; m < 4; ++m)
#pragma unroll
                    for (int n = 0; n < 2; ++n) acc[a][b][m][n] = (f32x4){0.f, 0.f, 0.f, 0.f};
        cur = nxt; cA = nA; cB = nB; ++ui;
        if constexpr (GA) {
#pragma unroll
            for (int h = 0; h < NH; ++h)
#pragma unroll
                for (int i = 0; i < 2; ++i) vA[h][i] = nvA[h][i];
        }
        if (wr == 1) PG8_BAR;
    }
    PG8_WAIT_V(0);
    PG8_BAR;
#undef PG8_SA
#undef PG8_SB
#undef PG8_STAGE
#undef PG8_STAGEA
#undef PG8_LDA
#undef PG8_LDB
#undef PG8_MMA
#undef PG8_CAT
#undef PG8_WAIT_V
#undef PG8_WAIT_L
#undef PG8_BAR
#undef PG8_SCHED
}

template <bool F8_ = false, bool TILED_ = false> struct ProbPlainT {
    static constexpr bool GATHER = false, F8 = F8_;
    const bf16* A; const bf16* Bt; int lda, ldb, K;
    __device__ __forceinline__ const char* a_ptr(const Unit& u) const { return TILED_ ? (const char*)A + (size_t)u.pm * (K / BK) * 32768 : (const char*)(A + (size_t)u.pm * BM * lda); }
    __device__ __forceinline__ const char* b_ptr(const Unit& u) const { return (const char*)(Bt + (size_t)u.pn * BM * ldb); }
    __device__ __forceinline__ size_t hstep_a() const { return TILED_ ? (size_t)4096 : (size_t)HALF * lda * 2; }
    __device__ __forceinline__ size_t kstep_a() const { return TILED_ ? (size_t)32768 : (size_t)(BK * 2); }
    __device__ __forceinline__ void a_off(const Unit&, const int (&R)[2], const int (&C)[2], unsigned (&off)[1][2]) const {
#pragma unroll
        for (int i = 0; i < 2; ++i) {
            if (TILED_) { const int wr = R[i] >> 6, m = (R[i] >> 4) & 3, fr = R[i] & 15, cb = 2 * C[i]; off[0][i] = (unsigned)((((wr * 2 + (cb >> 6)) * 2) * 4 + m) * 1024 + fr * 64 + (cb & 63)); }
            else off[0][i] = (unsigned)(R[i] * lda + C[i]) * 2u;
        }
    }
};
typedef ProbPlainT<false> ProbPlain;
}

struct Args { const float* in[27]; float* out; unsigned char* ws; int ph_lo, ph_hi; };
struct Frame {
    LAS unsigned char* lds;
    int tid, lane, wave, G, bid;
    const float* const* in; unsigned char* ws; unsigned char* dout;
};
template <class T> __device__ __forceinline__ T* wsp(const Frame& F, size_t off) { return (T*)(F.ws + off); }
__device__ __forceinline__ Frame launder(const Frame& F0) {
    Frame F = F0; int t = F0.tid; asm volatile("" : "+v"(t)); F.tid = t; F.lane = t & 63; F.wave = __builtin_amdgcn_readfirstlane(t >> 6);
    int z = 0; asm volatile("" : "+s"(z));
    F.ws = F0.ws + z; F.dout = F0.dout + z; F.in = (const float* const*)((const char*)F0.in + z); return F;
}

__device__ __forceinline__ float row_rstd(const float* ssp, int r) {
    const f32x4* p = (const f32x4*)(ssp + (size_t)r * 16);
    const f32x4 a = p[0], b = p[1], c = p[2], d = p[3];
    const float s = ((a[0] + a[1]) + (a[2] + a[3])) + ((b[0] + b[1]) + (b[2] + b[3])) + ((c[0] + c[1]) + (c[2] + c[3])) + ((d[0] + d[1]) + (d[2] + d[3]));
    return rsqrtf(s * (1.0f / D) + EPS);
}

typedef pg8::Unit Unit;
struct EpiInproj {
    static constexpr bool HAS_TAB = false;
    const float* ssp; unsigned char* act;
    __device__ __forceinline__ void operator()(const f32x4 (&acc)[2][2][4][2], const Unit& u, int wr, int wc, int fr, int fq) const {
        static_assert(WS_UGM == WS_ACT && WS_Q == WS_ACT + 32 * MiB && WS_K == WS_ACT + 48 * MiB && WS_V == WS_ACT + 64 * MiB && WS_R == WS_ACT + 96 * MiB, "in-proj destination arithmetic");
        const unsigned pn = (unsigned)u.pn;
        const bool isu = pn < 2u;
        bf16* const base = (bf16*)(act + (size_t)((0x66443200u >> (4u * pn)) & 15u) * (16 * MiB));
        const unsigned stride = 512u >> ((0x0Cu >> pn) & 1u);
        const unsigned cb = ((pn >> 2) & pn & 1u) * 256u;
#pragma unroll
        for (int ai = 0; ai < 2; ++ai) {
            float rs4[4];
#pragma unroll
            for (int m = 0; m < 4; ++m) rs4[m] = row_rstd(ssp, u.pm * 256 + ai * 128 + wr * 64 + m * 16 + fr);
            CFENCE();
#pragma unroll
            for (int m = 0; m < 4; ++m) {
                const unsigned row = (unsigned)(u.pm * 256 + ai * 128 + wr * 64 + m * 16 + fr);
                const float rs = rs4[m];
                const unsigned ro = isu ? ((row >> 12) * 2097152u + (row & 4095u) * 16u) : row * stride;
#pragma unroll
                for (int bj = 0; bj < 2; ++bj) {
                    const unsigned cl = (unsigned)(bj * 128 + wc * 32 + 8 * fq);
                    f32x4 v0 = acc[ai][bj][m][0] * rs, v1 = acc[ai][bj][m][1] * rs;
                    const unsigned co = isu ? ((pn * 256u + cl) >> 4) * 65536u + ((cl >> 3) & 1u) * 8u : cb + cl;
                    u32x4 w; w.x = cvt_pk_bf16(v0[0], v0[1]); w.y = cvt_pk_bf16(v0[2], v0[3]); w.z = cvt_pk_bf16(v1[0], v1[1]); w.w = cvt_pk_bf16(v1[2], v1[3]);
                    *(u32x4*)(base + (size_t)(ro + co)) = w;
                }
            }
            CFENCE();
        }
    }
};
struct EpiGlu {
    static constexpr bool HAS_TAB = false;
    const bf16* ys5; bf16* yglu; const float* bglu;
    __device__ __forceinline__ void operator()(const f32x4 (&acc)[2][2][4][2], const Unit& u, int wr, int wc, int fr, int fq) const {
        const int colb = u.pn * 256 + wc * 32 + 8 * fq;
        const bf16* src = ys5 + (size_t)(u.pm * 256 + wr * 64 + fr) * 512 + colb;
        u32x4 nx[2] = {*(const u32x4*)src, *(const u32x4*)(src + 128)};
#pragma unroll
        for (int g = 0; g < 8; ++g) {
            const int ai = g >> 2, m = g & 3;
            const u32x4 a2[2] = {nx[0], nx[1]};
            if (g < 7) { const int g1 = g + 1; const bf16* s1 = src + (size_t)((g1 >> 2) * 128 + (g1 & 3) * 16) * 512; nx[0] = *(const u32x4*)s1; nx[1] = *(const u32x4*)(s1 + 128); }
            CFENCE();
            const int row = u.pm * 256 + ai * 128 + wr * 64 + m * 16 + fr;
#pragma unroll
            for (int bj = 0; bj < 2; ++bj) {
                const int col = colb + bj * 128;
                const u32x4 a = a2[bj];
                const f32x4 b0 = *(const f32x4*)(bglu + col), b1 = *(const f32x4*)(bglu + col + 4);
                const f32x4 v0 = acc[ai][bj][m][0] + b0, v1 = acc[ai][bj][m][1] + b1;
                u32x4 w;
                w.x = cvt_pk_bf16(bflo(a.x) * sigmoidf_(v0[0]), bfhi(a.x) * sigmoidf_(v0[1]));
                w.y = cvt_pk_bf16(bflo(a.y) * sigmoidf_(v0[2]), bfhi(a.y) * sigmoidf_(v0[3]));
                w.z = cvt_pk_bf16(bflo(a.z) * sigmoidf_(v1[0]), bfhi(a.z) * sigmoidf_(v1[1]));
                w.w = cvt_pk_bf16(bflo(a.w) * sigmoidf_(v1[2]), bfhi(a.w) * sigmoidf_(v1[3]));
                *(u32x4*)(yglu + (size_t)row * 512 + col) = w;
            }
        }
        CFENCE();
    }
};
struct EpiResid {
    static constexpr bool HAS_TAB = false;
    bf16* xb; float* ssp; bf16* dst; bool wr_ssp;
    unsigned char* x8;
    float ascale;
    __device__ __forceinline__ void operator()(const f32x4 (&acc)[2][2][4][2], const Unit& u, int wr, int wc, int fr, int fq) const {
        const int colb = u.pn * 256 + wc * 32 + 8 * fq;
        const bf16* src = xb + (size_t)(u.pm * 256 + wr * 64 + fr) * D + colb;
        u32x4 nx[2] = {*(const u32x4*)src, *(const u32x4*)(src + 128)};
#pragma unroll
        for (int g = 0; g < 8; ++g) {
            const int ai = g >> 2, m = g & 3;
            const u32x4 a2[2] = {nx[0], nx[1]};
            if (g < 7) { const int g1 = g + 1; const bf16* s1 = src + (size_t)((g1 >> 2) * 128 + (g1 & 3) * 16) * D; nx[0] = *(const u32x4*)s1; nx[1] = *(const u32x4*)(s1 + 128); }
            CFENCE();
            const int row = u.pm * 256 + ai * 128 + wr * 64 + m * 16 + fr;
            float ss = 0.f;
#pragma unroll
            for (int bj = 0; bj < 2; ++bj) {
                const int col = colb + bj * 128;
                const u32x4 a = a2[bj];
                const f32x4 v0 = acc[ai][bj][m][0] * ascale + (f32x4){bflo(a.x), bfhi(a.x), bflo(a.y), bfhi(a.y)};
                const f32x4 v1 = acc[ai][bj][m][1] * ascale + (f32x4){bflo(a.z), bfhi(a.z), bflo(a.w), bfhi(a.w)};
                ss += (v0[0] * v0[0] + v0[1] * v0[1]) + (v0[2] * v0[2] + v0[3] * v0[3]) + (v1[0] * v1[0] + v1[1] * v1[1]) + (v1[2] * v1[2] + v1[3] * v1[3]);
                u32x4 w; w.x = cvt_pk_bf16(v0[0], v0[1]); w.y = cvt_pk_bf16(v0[2], v0[3]); w.z = cvt_pk_bf16(v1[0], v1[1]); w.w = cvt_pk_bf16(v1[2], v1[3]);
                *(u32x4*)(dst + (size_t)row * D + col) = w;
                if (x8) { u32x2 q; q.x = pk4_fp8(v0[0], v0[1], v0[2], v0[3]); q.y = pk4_fp8(v1[0], v1[1], v1[2], v1[3]); *(u32x2*)(x8 + (size_t)row * D + col) = q; }
            }
            ss += __shfl_xor(ss, 16); ss += __shfl_xor(ss, 32);
            if (fq == 0 && wr_ssp) ssp[(size_t)row * 16 + u.pn * 4 + wc] = ss;
        }
        CFENCE();
    }
};
template <bool F8> struct EpiSwigluT {
    static constexpr bool HAS_TAB = false;
    const float* ssp; bf16* h; int ldh;
    __device__ __forceinline__ void operator()(const f32x4 (&acc)[2][2][4][2], const Unit& u, int wr, int wc, int fr, int fq) const {
#pragma unroll
        for (int ai = 0; ai < 2; ++ai) {
            float rs4[4];
#pragma unroll
            for (int m = 0; m < 4; ++m) rs4[m] = row_rstd(ssp, u.pm * 256 + ai * 128 + wr * 64 + m * 16 + fr);
            CFENCE();
#pragma unroll
            for (int m = 0; m < 4; ++m) {
                const int row = u.pm * 256 + ai * 128 + wr * 64 + m * 16 + fr;
                const float rs = rs4[m] * (F8 ? 1.0f / F8_SW_UP : 1.0f);
                const float hs = F8 ? F8_SH : 1.0f, nrs = rs * -1.4426950408889634f, cc = rs * rs * hs;
                const f32x4 ga = acc[ai][0][m][0], gb = acc[ai][0][m][1], ua = acc[ai][1][m][0], ub = acc[ai][1][m][1];
                const f32x2 p0 = swiglu2((f32x2){ga[0], ga[1]}, (f32x2){ua[0], ua[1]}, nrs, cc), p1 = swiglu2((f32x2){ga[2], ga[3]}, (f32x2){ua[2], ua[3]}, nrs, cc);
                const f32x2 p2 = swiglu2((f32x2){gb[0], gb[1]}, (f32x2){ub[0], ub[1]}, nrs, cc), p3 = swiglu2((f32x2){gb[2], gb[3]}, (f32x2){ub[2], ub[3]}, nrs, cc);
                const f32x4 h0 = {p0[0], p0[1], p1[0], p1[1]}, h1 = {p2[0], p2[1], p3[0], p3[1]};
                const int col = u.pn * 128 + wc * 32 + 8 * fq;
                static_assert(!F8, "the dense tile-major hidden layout is written for bf16");
                const size_t to = ((size_t)u.pm * (2 * ldh / 128) + 2 * u.pn + (wc >> 1)) * 32768 + (size_t)(((((wr * 2 + (wc & 1)) * 2 + ai) * 4 + m) * 1024) + fr * 64 + 16 * fq);
                if constexpr (F8) { u32x2 q; q.x = pk4_fp8(h0[0], h0[1], h0[2], h0[3]); q.y = pk4_fp8(h1[0], h1[1], h1[2], h1[3]); *(u32x2*)((unsigned char*)h + (size_t)row * ldh + col) = q; }
                else { u32x4 w; w.x = cvt_pk_bf16(h0[0], h0[1]); w.y = cvt_pk_bf16(h0[2], h0[3]); w.z = cvt_pk_bf16(h1[0], h1[1]); w.w = cvt_pk_bf16(h1[2], h1[3]); *(u32x4*)((unsigned char*)h + to) = w; }
            }
            CFENCE();
        }
    }
};

struct MoeTab { LAS int* cnt; LAS int* cb; LAS short* tl_list; LAS short* tl_sub; };
__device__ __forceinline__ MoeTab moe_tab(const Frame& F) {
    MoeTab T; T.cnt = (LAS int*)(F.lds + MOE_TAB_OFF); T.cb = T.cnt + 16; T.tl_list = (LAS short*)(T.cb + 8); T.tl_sub = T.tl_list + 288; return T;
}
__device__ __forceinline__ void moe_build_tables(const Frame& F) {
    MoeTab T = moe_tab(F);
    if (F.tid < 16) { const unsigned* gc = wsp<unsigned>(F, WS_CTL) + CW_CNT; int c = (int)__hip_atomic_load(gc + F.tid, __ATOMIC_RELAXED, __HIP_MEMORY_SCOPE_AGENT); if (c > 32768) c = 32768; T.cnt[F.tid] = c; }
    __syncthreads();
    if (F.tid == 0) {
        int tot = 0, tr0 = 0, tr1 = 0;
#pragma unroll 1
        for (int l = 0; l < 16; ++l) {
            const int nt_ = (T.cnt[l] + 255) >> 8; if (l < 8) tr0 += nt_; else tr1 += nt_;
#pragma unroll 1
            for (int s = 0; s < nt_; ++s) { T.tl_list[tot] = (short)l; T.tl_sub[tot] = (short)s; ++tot; }
        }
        const int c0 = (tr0 > 64 + MOE_CAP_TILES) ? tr0 - MOE_CAP_TILES : (tr0 < 64 ? tr0 : 64);
        const int c3 = (tr1 > 64 + MOE_CAP_TILES) ? tr1 - MOE_CAP_TILES : (tr1 < 64 ? tr1 : 64);
        T.cb[0] = 0; T.cb[1] = c0; T.cb[2] = tr0; T.cb[3] = tr0 + tr1 - c3; T.cb[4] = tr0 + tr1;
    }
    __syncthreads();
}
struct MoeOrder {
    MoeTab T; int t0, ntile, nN, lo, nloc, j, nbx, nheavy, skip;
    __device__ __forceinline__ void init(const MoeTab& T_, int chunk, int nN_, int G, int bid, int nheavy_, int skip_) {
        T = T_; t0 = T.cb[chunk]; ntile = T.cb[chunk + 1] - t0; nN = nN_;
        const int total = ntile * nN, x = bid & 7, q = total >> 3, r = total & 7;
        lo = (x < r) ? x * (q + 1) : r * (q + 1) + (x - r) * q; nloc = q + (x < r ? 1 : 0);
        j = bid >> 3; nbx = (G - x + 7) >> 3; nheavy = nheavy_; skip = skip_;
    }
    __device__ __forceinline__ int nheavy_next() const { return nloc % nbx; }
    __device__ __forceinline__ bool next(int i, Unit& u) const {
        int k;
        if (j < nheavy) k = skip * (nbx - nheavy) + i * nbx + j;
        else k = (i < skip) ? i * (nbx - nheavy) + (j - nheavy) : skip * (nbx - nheavy) + (i - skip) * nbx + j;
        if (k >= nloc) return false;
        const int idx = lo + k, nig = 8 * nN, gid = idx / nig, fm = gid * 8, gsz = (ntile - fm) < 8 ? (ntile - fm) : 8, w = idx - gid * nig;
        const int tl = fm + w % gsz; u.pm = tl; u.pn = w / gsz; u.e = T.tl_list[t0 + tl]; u.sub = T.tl_sub[t0 + tl]; return true;
    }
};
constexpr int MOE_ESZ = USE_F8_MOE ? 1 : 2;
struct ProbMoeUp {
    static constexpr bool GATHER = true, F8 = USE_F8_MOE != 0;
    const void* xa; const void* wgu; const int* tok; MoeTab T; int lda, ldb, K;
    __device__ __forceinline__ const char* a_ptr(const Unit&) const { return (const char*)xa; }
    __device__ __forceinline__ size_t hstep_a() const { return 0; }
    __device__ __forceinline__ size_t kstep_a() const { return 128; }
    __device__ __forceinline__ const char* b_ptr(const Unit& u) const { return (const char*)wgu + ((size_t)(u.e & 7) * (2 * DFE) + (size_t)u.pn * 256) * D * MOE_ESZ; }
    __device__ __forceinline__ void a_off(const Unit& u, const int (&R)[2], const int (&C)[2], unsigned (&off)[2][2]) const {
        const int cnt = T.cnt[u.e];
#pragma unroll
        for (int h = 0; h < 2; ++h)
#pragma unroll
            for (int i = 0; i < 2; ++i) { const int p = u.sub * 256 + h * 128 + R[i]; const int t = (p < cnt) ? tok[u.e * 32768 + p] : 0; off[h][i] = (unsigned)(t * lda + C[i]) * 2u; }
    }
    __device__ __forceinline__ void atab_issue(const Unit& u, LAS unsigned char* tab, int wid, int lane) const {
        if (wid < 4) { const int cnt = T.cnt[u.e]; int p = u.sub * 256 + wid * 64 + lane; p = (p < cnt) ? p : 0;
            __builtin_amdgcn_global_load_lds((const unsigned*)(tok + u.e * 32768 + p), (LAS unsigned*)(tab + wid * 256), 4, 0, 0); }
    }
    __device__ __forceinline__ void a_off_tab(const LAS unsigned char* tab, const int (&R)[2], const int (&C)[2], unsigned (&off)[2][2]) const {
#pragma unroll
        for (int h = 0; h < 2; ++h)
#pragma unroll
            for (int i = 0; i < 2; ++i) { const int t = *(const LAS int*)(tab + (h * 128 + R[i]) * 4); off[h][i] = (unsigned)(t * lda + C[i]) * 2u; }
    }
};
struct ProbMoeDown {
    static constexpr bool GATHER = false, F8 = USE_F8_MOE != 0;
    const void* h; const void* wd; int lda, ldb, K;
    static constexpr bool TILED = USE_F8_MOE != 0;
    __device__ __forceinline__ const char* a_ptr(const Unit& u) const { return TILED ? (const char*)h + (size_t)u.pm * (DFE / 128) * 32768 : (const char*)h + (size_t)u.pm * 256 * DFE * MOE_ESZ; }
    __device__ __forceinline__ const char* b_ptr(const Unit& u) const { return (const char*)wd + ((size_t)(u.e & 7) * D + (size_t)u.pn * 256) * DFE * MOE_ESZ; }
    __device__ __forceinline__ size_t hstep_a() const { return TILED ? (size_t)2048 : (size_t)128 * lda * 2; }
    __device__ __forceinline__ size_t kstep_a() const { return TILED ? (size_t)32768 : (size_t)128; }
    __device__ __forceinline__ void a_off(const Unit&, const int (&R)[2], const int (&C)[2], unsigned (&off)[1][2]) const {
#pragma unroll
        for (int i = 0; i < 2; ++i) {
            if (TILED) { const int wr = R[i] >> 6, m = (R[i] >> 4) & 3, fr = R[i] & 15, cb = 2 * C[i]; off[0][i] = (unsigned)((((wr * 4 + (cb >> 5)) * 2) * 4 + m) * 512 + fr * 32 + (cb & 31)); }
            else off[0][i] = (unsigned)(R[i] * lda + C[i]) * 2u;
        }
    }
};
struct EpiSwigluMoe {
    static constexpr bool HAS_TAB = true;
    const float* rl; void* h; MoeTab T;
    __device__ __forceinline__ void tab_issue(const Unit& u, LAS unsigned char* tab, int wid, int lane) const {
        if (wid < 4) { const int cnt = T.cnt[u.e]; int p = u.sub * 256 + wid * 64 + lane; p = (p < cnt) ? p : 0;
            __builtin_amdgcn_global_load_lds((const unsigned*)(rl + u.e * 32768 + p), (LAS unsigned*)(tab + wid * 256), 4, 0, 0); }
    }
    __device__ __forceinline__ void operator()(const f32x4 (&acc)[2][2][4][2], const Unit& u, int wr, int wc, int fr, int fq, const LAS unsigned char* tab) const {
        constexpr bool F8 = USE_F8_MOE != 0;
        const int cnt = T.cnt[u.e];
        float rs8[8];
#pragma unroll
        for (int g = 0; g < 8; ++g) { const int rl_ = (g >> 2) * 128 + wr * 64 + (g & 3) * 16 + fr, p = u.sub * 256 + rl_; const float v = *(const LAS float*)(tab + rl_ * 4); rs8[g] = (p < cnt) ? v * (F8 ? 1.0f / F8_SW_UP : 1.0f) : 0.f; }
        CFENCE();
#pragma unroll
        for (int ai = 0; ai < 2; ++ai)
#pragma unroll
            for (int m = 0; m < 4; ++m) {
                const int rl_ = ai * 128 + wr * 64 + m * 16 + fr;
                const float rs = rs8[ai * 4 + m];
                const float hs = F8 ? F8_SH : 1.0f, nrs = rs * -1.4426950408889634f, cc = rs * rs * hs;
                const f32x4 ga = acc[ai][0][m][0], gb = acc[ai][0][m][1], ua = acc[ai][1][m][0], ub = acc[ai][1][m][1];
                const f32x2 p0 = swiglu2((f32x2){ga[0], ga[1]}, (f32x2){ua[0], ua[1]}, nrs, cc), p1 = swiglu2((f32x2){ga[2], ga[3]}, (f32x2){ua[2], ua[3]}, nrs, cc);
                const f32x2 p2 = swiglu2((f32x2){gb[0], gb[1]}, (f32x2){ub[0], ub[1]}, nrs, cc), p3 = swiglu2((f32x2){gb[2], gb[3]}, (f32x2){ub[2], ub[3]}, nrs, cc);
                const f32x4 h0 = {p0[0], p0[1], p1[0], p1[1]}, h1 = {p2[0], p2[1], p3[0], p3[1]};
                const size_t eo = F8 ? ((size_t)(u.pm * (DFE / 128) + u.pn) * 32768 + (size_t)((((wr * 4 + wc) * 2 + ai) * 4 + m) * 512 + fr * 32 + 8 * fq))
                                     : ((size_t)(u.pm * 256 + rl_) * DFE + u.pn * 128 + wc * 32 + 8 * fq);
                if constexpr (F8) { u32x2 q; q.x = pk4_fp8(h0[0], h0[1], h0[2], h0[3]); q.y = pk4_fp8(h1[0], h1[1], h1[2], h1[3]); *(u32x2*)((unsigned char*)h + eo) = q; }
                else { u32x4 w; w.x = cvt_pk_bf16(h0[0], h0[1]); w.y = cvt_pk_bf16(h0[2], h0[3]); w.z = cvt_pk_bf16(h1[0], h1[1]); w.w = cvt_pk_bf16(h1[2], h1[3]); *(u32x4*)((bf16*)h + eo) = w; }
            }
        CFENCE();
    }
};
struct EpiMoeDown {
    static constexpr bool HAS_TAB = false;
    const int* tok; const float* wl; const bf16* xb; bf16* xo; MoeTab T; bool dry;
    __device__ __forceinline__ void operator()(const f32x4 (&acc)[2][2][4][2], const Unit& u, int wr, int wc, int fr, int fq) const {
        const int cnt = T.cnt[u.e]; const bf16* src = (u.e < 8) ? xb : (const bf16*)xo;
        const int colb = u.pn * 256 + wc * 32 + 8 * fq;
        int t8[8]; float w8[8];
#pragma unroll
        for (int g = 0; g < 8; ++g) { const int p = u.sub * 256 + (g >> 2) * 128 + wr * 64 + (g & 3) * 16 + fr; const bool ok = p < cnt; const int pc = ok ? p : 0;
            const int t_ = tok[u.e * 32768 + pc]; const float w_ = wl[u.e * 32768 + pc];
            t8[g] = ok ? t_ : -1; w8[g] = ok ? w_ * (USE_F8_MOE ? 1.0f / (F8_SH * F8_SW_DN) : 1.0f) : 0.f; }
        CFENCE();
        u32x4 nx[2];
        { const bf16* s0 = src + (size_t)(t8[0] < 0 ? 0 : t8[0]) * D + colb; nx[0] = *(const u32x4*)s0; nx[1] = *(const u32x4*)(s0 + 128); }
#pragma unroll
        for (int g = 0; g < 8; ++g) {
            const int ai = g >> 2, m = g & 3;
            const u32x4 a2[2] = {nx[0], nx[1]};
            if (g < 7) { const bf16* s1 = src + (size_t)(t8[g + 1] < 0 ? 0 : t8[g + 1]) * D + colb; nx[0] = *(const u32x4*)s1; nx[1] = *(const u32x4*)(s1 + 128); }
            CFENCE();
            if (t8[g] >= 0) {
#pragma unroll
                for (int bj = 0; bj < 2; ++bj) {
                    const u32x4 a = a2[bj];
                    const f32x4 v0 = acc[ai][bj][m][0] * w8[g] + (f32x4){bflo(a.x), bfhi(a.x), bflo(a.y), bfhi(a.y)};
                    const f32x4 v1 = acc[ai][bj][m][1] * w8[g] + (f32x4){bflo(a.z), bfhi(a.z), bflo(a.w), bfhi(a.w)};
                    u32x4 w; w.x = cvt_pk_bf16(v0[0], v0[1]); w.y = cvt_pk_bf16(v0[2], v0[3]); w.z = cvt_pk_bf16(v1[0], v1[1]); w.w = cvt_pk_bf16(v1[2], v1[3]);
                    if (!dry) *(u32x4*)(xo + (size_t)t8[g] * D + colb + bj * 128) = w;
                }
            }
        }
        CFENCE();
    }
};

__device__ __forceinline__ void p0_tr_item(const float* src, int ldsrc, int ncol0, int k0, const float* gain, bf16* dst, int K, int drow0, LAS float* scr, int lane) {
    float gv[8]; f32x4 v8[8];
#pragma unroll
    for (int i = 0; i < 8; ++i) gv[i] = 1.0f;
    if (gain) {
#pragma unroll
        for (int i = 0; i < 8; ++i) gv[i] = gain[k0 + 8 * i + (lane >> 3)];
    }
#pragma unroll
    for (int i = 0; i < 8; ++i) v8[i] = *(const f32x4*)(src + (size_t)(k0 + 8 * i + (lane >> 3)) * ldsrc + ncol0 + 4 * (lane & 7));
    CFENCE();
#pragma unroll
    for (int i = 0; i < 8; ++i) { const int kk = 8 * i + (lane >> 3), c4 = lane & 7; *(LAS f32x4*)(scr + kk * 36 + 4 * c4) = v8[i] * gv[i]; }
    LDS_WAIT(); CFENCE();
    const int c = lane & 7;
#pragma unroll
    for (int j = 0; j < 4; ++j) { const int n = (lane >> 3) + 8 * j; const LAS float* s = scr + (8 * c) * 36 + n;
        u32x4 o; o.x = pk2(s[0 * 36], s[1 * 36]); o.y = pk2(s[2 * 36], s[3 * 36]); o.z = pk2(s[4 * 36], s[5 * 36]); o.w = pk2(s[6 * 36], s[7 * 36]);
        *(u32x4*)(dst + (size_t)(drow0 + n) * K + k0 + 8 * c) = o; }
    LDS_WAIT(); CFENCE();
}
__device__ __forceinline__ void p0_tr_item_f8(const float* src, int ldsrc, int ncol0, int k0, const float* gain, float scale, unsigned char* dst, int K, int drow0, LAS float* scr, int lane) {
    float gv[8]; f32x4 v8[8];
#pragma unroll
    for (int i = 0; i < 8; ++i) gv[i] = 1.0f;
    if (gain) {
#pragma unroll
        for (int i = 0; i < 8; ++i) gv[i] = gain[k0 + 8 * i + (lane >> 3)];
    }
#pragma unroll
    for (int i = 0; i < 8; ++i) v8[i] = *(const f32x4*)(src + (size_t)(k0 + 8 * i + (lane >> 3)) * ldsrc + ncol0 + 4 * (lane & 7));
    CFENCE();
#pragma unroll
    for (int i = 0; i < 8; ++i) { const int kk = 8 * i + (lane >> 3), c4 = lane & 7; *(LAS f32x4*)(scr + kk * 36 + 4 * c4) = v8[i] * (gv[i] * scale); }
    LDS_WAIT(); CFENCE();
    const int c = lane & 7;
#pragma unroll
    for (int j = 0; j < 4; ++j) { const int n = (lane >> 3) + 8 * j; const LAS float* s = scr + (8 * c) * 36 + n;
        u32x2 o; o.x = pk4_fp8(s[0 * 36], s[1 * 36], s[2 * 36], s[3 * 36]); o.y = pk4_fp8(s[4 * 36], s[5 * 36], s[6 * 36], s[7 * 36]);
        *(u32x2*)(dst + (size_t)(drow0 + n) * K + k0 + 8 * c) = o; }
    LDS_WAIT(); CFENCE();
}
__device__ __forceinline__ void p0_s5_unit(const Frame& F, int l, int g) {
    LAS float* AP = (LAS float*)F.lds;
    LAS float* BB = AP + 64 * 17 * 2;
    LAS float* CC = BB + 64 * 16 * 2;
    LAS float* KT = CC + 16 * 64 * 2;
    const float* lre = F.in[3] + (l * 32 + g) * 64; const float* lim = F.in[4] + (l * 32 + g) * 64; const float ldt = F.in[5][l * 32 + g];
    const float* bre = F.in[6] + (size_t)(l * 32 + g) * 1024; const float* bim = F.in[7] + (size_t)(l * 32 + g) * 1024;
    const float* cre = F.in[8] + (size_t)(l * 32 + g) * 1024; const float* cim = F.in[9] + (size_t)(l * 32 + g) * 1024;
    const int tid = F.tid;
    for (int i = tid; i < 64 * 17; i += 512) {
        const int p = i / 17, tau = i % 17;
        const double lr = fmin((double)lre[p], -1e-4), li = (double)lim[p], dt = exp((double)ldt);
        const double mg = exp(lr * dt * tau), ph = li * dt * tau;
        AP[i * 2] = (float)(mg * cos(ph)); AP[i * 2 + 1] = (float)(mg * sin(ph));
    }
    for (int i = tid; i < 1024; i += 512) {
        const int p = i >> 4;
        const double lr = fmin((double)lre[p], -1e-4), li = (double)lim[p], dt = exp((double)ldt);
        const double mg = exp(lr * dt), ar = mg * cos(li * dt), ai = mg * sin(li * dt), nr = ar - 1.0, ni = ai, den = lr * lr + li * li;
        const double fr = (nr * lr + ni * li) / den, fi = (ni * lr - nr * li) / den;
        const double br = bre[i], bi = bim[i];
        BB[i * 2] = (float)(fr * br - fi * bi); BB[i * 2 + 1] = (float)(fr * bi + fi * br);
        CC[i * 2] = cre[i]; CC[i * 2 + 1] = cim[i];
    }
    __syncthreads();
    for (int i = tid; i < 4096; i += 512) {
        const int tau = i >> 8, c = (i >> 4) & 15, c2 = i & 15; float s = 0.f;
        for (int p = 0; p < 64; ++p) {
            const float xr = CC[(c * 64 + p) * 2], xi = CC[(c * 64 + p) * 2 + 1], ar = AP[(p * 17 + tau) * 2], ai = AP[(p * 17 + tau) * 2 + 1];
            const float zr = xr * ar - xi * ai, zi = xr * ai + xi * ar;
            s += zr * BB[(p * 16 + c2) * 2] - zi * BB[(p * 16 + c2) * 2 + 1];
        }
        KT[i] = s;
    }
    __syncthreads();
    bf16* MQ = wsp<bf16>(F, WS_S5MQ) + (size_t)(l * 32 + g) * 256 * 384;
    for (int i = tid; i < 256 * 48; i += 512) {
        const int m = i / 48, k8 = (i % 48) * 8, t = m >> 4, c = m & 15; float v[8];
#pragma unroll
        for (int j = 0; j < 8; ++j) {
            const int kc = k8 + j;
            if (kc < 256) { const int s = kc >> 4, c2 = kc & 15; v[j] = (s <= t) ? KT[((t - s) * 16 + c) * 16 + c2] : 0.f; }
            else { const int pp = kc - 256, p = pp & 63; const float xr = CC[(c * 64 + p) * 2], xi = CC[(c * 64 + p) * 2 + 1], ar = AP[(p * 17 + t + 1) * 2], ai = AP[(p * 17 + t + 1) * 2 + 1];
                   v[j] = (pp < 64) ? (xr * ar - xi * ai) : -(xr * ai + xi * ar); }
        }
        u32x4 o; o.x = pk2(v[0], v[1]); o.y = pk2(v[2], v[3]); o.z = pk2(v[4], v[5]); o.w = pk2(v[6], v[7]);
        *(u32x4*)(MQ + (size_t)m * 384 + k8) = o;
    }
    bf16* PM = wsp<bf16>(F, WS_S5P) + (size_t)(l * 32 + g) * 128 * 256;
    for (int i = tid; i < 128 * 32; i += 512) {
        const int pp = i >> 5, k8 = (i & 31) * 8, p = pp & 63; float v[8];
#pragma unroll
        for (int j = 0; j < 8; ++j) {
            const int kc = k8 + j, s = kc >> 4, c2 = kc & 15;
            const float ar = AP[(p * 17 + 15 - s) * 2], ai = AP[(p * 17 + 15 - s) * 2 + 1], br = BB[(p * 16 + c2) * 2], bi = BB[(p * 16 + c2) * 2 + 1];
            v[j] = (pp < 64) ? (ar * br - ai * bi) : (ar * bi + ai * br);
        }
        u32x4 o; o.x = pk2(v[0], v[1]); o.y = pk2(v[2], v[3]); o.z = pk2(v[4], v[5]); o.w = pk2(v[6], v[7]);
        *(u32x4*)(PM + (size_t)pp * 256 + k8) = o;
    }
    float* A16 = wsp<float>(F, WS_S5A16) + (size_t)(l * 32 + g) * 128;
    if (tid < 64) { A16[tid * 2] = AP[(tid * 17 + 16) * 2]; A16[tid * 2 + 1] = AP[(tid * 17 + 16) * 2 + 1]; }
    __syncthreads();
}
__device__ __forceinline__ void p0_prologue(const Frame& F) {
    if (F.bid == 0 && F.tid < 16) __hip_atomic_store(wsp<unsigned>(F, WS_CTL) + CW_CNT + F.tid, 0u, __ATOMIC_RELAXED, __HIP_MEMORY_SCOPE_AGENT);
#ifndef PROBE_S5U
#define PROBE_S5U 1
#endif
#pragma unroll 1
    for (int pr = 0; pr < PROBE_S5U; ++pr) for (int un = F.bid; un < 64; un += F.G) p0_s5_unit(F, un >> 5, un & 31);
    LAS float* scr = (LAS float*)(F.lds + F.wave * 16384);
    const int gw = F.bid * 8 + F.wave, NGW = F.G * 8, lane = F.lane;
    constexpr int I_IN = 16 * 64, I_GLU = 8 * 16, I_OUT = 16 * 32, I_FGU = 16 * 176, I_FD = 44 * 32, I_MGU = 16 * 224, I_MD = 56 * 32;
    constexpr int NITEMS = 2 * (I_IN + I_GLU + I_OUT) + I_FGU + I_FD + 8 * (I_MGU + I_MD);
    const bool split = F.G > 64;
    const int N1 = split ? ((NITEMS / NGW > 4) ? (NITEMS / NGW - 4) * NGW : 0) : NITEMS;
    int step = NGW;
    for (int it = gw; ; it += step) {
        if (step == NGW && it >= N1) { if (!split || F.bid < 64) break; it = N1 + (F.bid - 64) * 8 + F.wave; step = (F.G - 64) * 8; }
        if (it >= NITEMS) break;
        int r = it; bool done = false;
#pragma unroll
        for (int l = 0; l < 2; ++l) {
            if (done) break;
            if (r < I_IN) { p0_tr_item(F.in[2] + (size_t)l * D * DIN, DIN, 32 * (r % 64), 64 * (r / 64), F.in[1] + l * D, wsp<bf16>(F, WS_WIN) + (size_t)l * NPROJ * D, D, 32 * (r % 64), scr, lane); done = true; break; } r -= I_IN;
            if (r < I_GLU) { p0_tr_item(F.in[11] + (size_t)l * 512 * 512, 512, 32 * (r % 16), 64 * (r / 16), nullptr, wsp<bf16>(F, WS_WGLU) + (size_t)l * 512 * 512, 512, 32 * (r % 16), scr, lane); done = true; break; } r -= I_GLU;
            if (r < I_OUT) { p0_tr_item(F.in[17] + (size_t)l * D * D, D, 32 * (r % 32), 64 * (r / 32), nullptr, wsp<bf16>(F, WS_WOUT) + (size_t)l * D * D, D, 32 * (r % 32), scr, lane); done = true; break; } r -= I_OUT;
        }
        if (done) continue;
        if (r < I_FGU) { const int nb = r % 176, kb = r / 176, n0 = 32 * nb, T = n0 >> 8, hf = (n0 >> 7) & 1, j0 = n0 & 127;
            if (USE_F8_FFN) p0_tr_item_f8(hf ? F.in[20] : F.in[19], DFF, 128 * T + j0, 64 * kb, F.in[18], F8_SW_UP, wsp<unsigned char>(F, WS_WFGU), D, n0, scr, lane);
            else p0_tr_item(hf ? F.in[20] : F.in[19], DFF, 128 * T + j0, 64 * kb, F.in[18], wsp<bf16>(F, WS_WFGU), D, n0, scr, lane);
            continue; } r -= I_FGU;
        if (r < I_FD) {
            if (USE_F8_FFN) p0_tr_item_f8(F.in[21], D, 32 * (r % 32), 64 * (r / 32), nullptr, F8_SW_DN, wsp<unsigned char>(F, WS_WFD), DFF, 32 * (r % 32), scr, lane);
            else p0_tr_item(F.in[21], D, 32 * (r % 32), 64 * (r / 32), nullptr, wsp<bf16>(F, WS_WFD), DFF, 32 * (r % 32), scr, lane);
            continue; } r -= I_FD;
        const int e = r / (I_MGU + I_MD); r -= e * (I_MGU + I_MD);
        if (r < I_MGU) { const int nb = r % 224, kb = r / 224, n0 = 32 * nb, T = n0 >> 8, hf = (n0 >> 7) & 1, j0 = n0 & 127;
            if (USE_F8_MOE) p0_tr_item_f8((hf ? F.in[24] : F.in[23]) + (size_t)e * D * DFE, DFE, 128 * T + j0, 64 * kb, F.in[18] + D, F8_SW_UP, wsp<unsigned char>(F, WS_MGU) + (size_t)e * 2 * DFE * D, D, n0, scr, lane);
            else p0_tr_item((hf ? F.in[24] : F.in[23]) + (size_t)e * D * DFE, DFE, 128 * T + j0, 64 * kb, F.in[18] + D, wsp<bf16>(F, WS_MGU) + (size_t)e * 2 * DFE * D, D, n0, scr, lane);
            continue; } r -= I_MGU;
        if (USE_F8_MOE) p0_tr_item_f8(F.in[25] + (size_t)e * DFE * D, D, 32 * (r % 32), 64 * (r / 32), nullptr, F8_SW_DN, wsp<unsigned char>(F, WS_MD) + (size_t)e * D * DFE, DFE, 32 * (r % 32), scr, lane);
        else p0_tr_item(F.in[25] + (size_t)e * DFE * D, D, 32 * (r % 32), 64 * (r / 32), nullptr, wsp<bf16>(F, WS_MD) + (size_t)e * D * DFE, DFE, 32 * (r % 32), scr, lane);
    }
    for (int it = F.bid * 512 + F.tid; it < 2 * 16 * 1024; it += F.G * 512) {
        const int l = it >> 14, r = (it >> 10) & 15, k = it & 1023;
        wsp<bf16>(F, WS_WGT)[it] = (bf16)f2bf(F.in[1][l * D + k] * F.in[2][(size_t)l * D * DIN + (size_t)k * DIN + 2048 + r]);
    }
    for (int it = F.bid * 512 + F.tid; it < 2 * 256 * 16; it += F.G * 512) {
        const int l = it >> 12, k = (it >> 4) & 255, r = it & 15;
        wsp<bf16>(F, WS_WA2T)[it] = (bf16)f2bf(F.in[14][(size_t)l * 16 * 256 + r * 256 + k]);
    }
    bf16* xb = wsp<bf16>(F, WS_XB); float* ssp = wsp<float>(F, WS_SSP);
    f32x4 xn[4];
    if (gw < M) {
#pragma unroll
        for (int j = 0; j < 4; ++j) xn[j] = ((const f32x4*)(F.in[0] + (size_t)gw * D) + lane)[64 * j];
    }
    for (int m = gw; m < M; m += NGW) {
        f32x4 xc[4]; float s = 0.f;
#pragma unroll
        for (int j = 0; j < 4; ++j) xc[j] = xn[j];
        if (m + NGW < M) {
#pragma unroll
            for (int j = 0; j < 4; ++j) xn[j] = ((const f32x4*)(F.in[0] + (size_t)(m + NGW) * D) + lane)[64 * j];
        }
        CFENCE();
        u32x2* o8 = (u32x2*)(xb + (size_t)m * D) + lane;
#pragma unroll
        for (int j = 0; j < 4; ++j) { const f32x4 v = xc[j]; s += (v[0] * v[0] + v[1] * v[1]) + (v[2] * v[2] + v[3] * v[3]); u32x2 w; w.x = pk2(v[0], v[1]); w.y = pk2(v[2], v[3]); o8[64 * j] = w; }
        s = wave_sum(s);
        if (lane < 16) ssp[(size_t)m * 16 + lane] = (lane == 0) ? s : 0.f;
    }
}

__device__ __forceinline__ bf16x8 frag_row(const LAS unsigned char* base, int stride, int row0, int k0, int lane) {
    return *(const LAS bf16x8*)(base + (row0 + (lane & 15)) * stride + (k0 + 8 * (lane >> 4)) * 2);
}
__device__ __forceinline__ s16x4 lds_tr(const LAS unsigned char* p) { return __builtin_bit_cast(s16x4, __builtin_amdgcn_ds_read_tr16_b64_v4i16((LAS v4i16_t*)p)); }
__device__ __forceinline__ bf16x8 frag_tr(const LAS unsigned char* base, int stride, int r0, int c0, int lane) {
    const int i = lane & 15, q = i >> 2, p = i & 3, g = lane >> 4;
    const LAS unsigned char* a = base + (r0 + 8 * g + q) * stride + (c0 + 4 * p) * 2;
    const s16x4 lo = lds_tr(a), hi = lds_tr(a + 4 * stride);
    return (bf16x8){lo[0], lo[1], lo[2], lo[3], hi[0], hi[1], hi[2], hi[3]};
}
__device__ __forceinline__ bf16x8 frag_tr_perm(const LAS unsigned char* base, int stride, int r0, int c0, int lane) {
    const int i = lane & 15, q = i >> 2, p = i & 3, g = lane >> 4;
    const LAS unsigned char* a = base + (r0 + 4 * g + q) * stride + (c0 + 4 * p) * 2;
    const s16x4 lo = lds_tr(a), hi = lds_tr(a + 16 * stride);
    return (bf16x8){lo[0], lo[1], lo[2], lo[3], hi[0], hi[1], hi[2], hi[3]};
}
#define MFMA16(a, b, c) __builtin_amdgcn_mfma_f32_16x16x32_bf16((a), (b), (c), 0, 0, 0)

__device__ __forceinline__ void glow_pass(const Frame& F, int l) {
    const int lane = F.lane, fr = lane & 15, fq = lane >> 4;
    const bf16* wg = wsp<bf16>(F, WS_WGT) + (size_t)l * 16 * 1024;
    bf16x8 wf[32];
#pragma unroll
    for (int ks = 0; ks < 32; ++ks) wf[ks] = *(const bf16x8*)(wg + fr * 1024 + 32 * ks + 8 * fq);
    const bf16* xb = wsp<bf16>(F, WS_XB); const float* ssp = wsp<float>(F, WS_SSP); bf16* gl = wsp<bf16>(F, WS_GL);
    for (int m0 = 16 * (F.bid * 8 + F.wave); m0 < M; m0 += 16 * F.G * 8) {
        f32x4 acc = {0.f, 0.f, 0.f, 0.f};
        const bf16* xr = xb + (size_t)(m0 + fr) * D + 8 * fq;
        const float rs = row_rstd(ssp, m0 + fr);
        u32x4 an[8];
#pragma unroll
        for (int kk = 0; kk < 8; ++kk) an[kk] = *(const u32x4*)(xr + 32 * kk);
#pragma unroll
        for (int kg = 0; kg < 4; ++kg) {
            u32x4 a8[8];
#pragma unroll
            for (int kk = 0; kk < 8; ++kk) a8[kk] = an[kk];
            if (kg < 3) {
#pragma unroll
                for (int kk = 0; kk < 8; ++kk) an[kk] = *(const u32x4*)(xr + 32 * (8 * (kg + 1) + kk));
            }
            CFENCE();
#pragma unroll
            for (int kk = 0; kk < 8; ++kk) acc = MFMA16(wf[8 * kg + kk], __builtin_bit_cast(bf16x8, a8[kk]), acc);
        }
        u32x2 o; o.x = cvt_pk_bf16(acc[0] * rs, acc[1] * rs); o.y = cvt_pk_bf16(acc[2] * rs, acc[3] * rs);
        *(u32x2*)(gl + (size_t)(m0 + fr) * 16 + 4 * fq) = o;
    }
}
constexpr int S5_USTR = 528, S5_SSTR = 272, S5_HSTR = 272;
__device__ __forceinline__ void s5_unit(const Frame& F, int l, int un) {
    const int b = un >> 5, g = un & 31, tid = F.tid, lane = F.lane, w = F.wave, fq = lane >> 4, fr = lane & 15;
    LAS unsigned char* hb = F.lds; LAS unsigned char* useg = F.lds + 64 * S5_HSTR; LAS unsigned char* slds = useg + 64 * S5_USTR;
    const bf16* PM = wsp<bf16>(F, WS_S5P) + (size_t)(l * 32 + g) * 128 * 256;
    const bf16* MQ = wsp<bf16>(F, WS_S5MQ) + (size_t)(l * 32 + g) * 256 * 384;
    bf16x8 pf[8], mq0[12], mq1[12];
#pragma unroll
    for (int ks = 0; ks < 8; ++ks) pf[ks] = *(const bf16x8*)(PM + (size_t)(16 * w + fr) * 256 + 32 * ks + 8 * fq);
#pragma unroll
    for (int ks = 0; ks < 12; ++ks) { mq0[ks] = *(const bf16x8*)(MQ + (size_t)(16 * w + fr) * 384 + 32 * ks + 8 * fq); mq1[ks] = *(const bf16x8*)(MQ + (size_t)(16 * (w + 8) + fr) * 384 + 32 * ks + 8 * fq); }
    const float* A16 = wsp<float>(F, WS_S5A16) + (size_t)(l * 32 + g) * 128;
    const float a_re = A16[(lane & 63) * 2], a_im = A16[(lane & 63) * 2 + 1];
    const f32x4 dsk = *(const f32x4*)(F.in[10] + l * 512 + g * 16 + 4 * fq);
    float hr = 0.f, hi = 0.f;
    const bf16* ug = wsp<bf16>(F, WS_UGM) + (size_t)((b * 32 + g) * 4096) * 16;
    bf16* ys5 = (bf16*)(F.dout + DO_YS5);
    u32x4 upre[4];
#pragma unroll
    for (int i = 0; i < 4; ++i) upre[i] = *(const u32x4*)(ug + (size_t)(tid + 512 * i) * 8);
    for (int seg = 0; seg < 4; ++seg) {
#pragma unroll
        for (int i = 0; i < 4; ++i) { const int idx = tid + 512 * i; *(LAS u32x4*)(useg + (idx >> 5) * S5_USTR + (idx & 31) * 16) = upre[i]; }
        if (seg < 3) {
#pragma unroll
            for (int i = 0; i < 4; ++i) upre[i] = *(const u32x4*)(ug + (size_t)(seg + 1) * 16384 + (size_t)(tid + 512 * i) * 8);
        }
        __syncthreads();
#ifndef PROBE_S5
#define PROBE_S5 0
#endif
#pragma unroll 1
        for (int pr1 = 0; pr1 < (PROBE_S5 == 1 ? 2 : 1); ++pr1)
        {
            f32x4 acc4[4];
#pragma unroll
            for (int nt = 0; nt < 4; ++nt) acc4[nt] = (f32x4){0.f, 0.f, 0.f, 0.f};
#pragma unroll
            for (int kb = 0; kb < 8; kb += 2) {
                bf16x8 ub[2][4];
#pragma unroll
                for (int ks = 0; ks < 2; ++ks)
#pragma unroll
                    for (int nt = 0; nt < 4; ++nt) ub[ks][nt] = frag_row(useg, S5_USTR, 16 * nt, 32 * (kb + ks), lane);
                __builtin_amdgcn_sched_barrier(0);
#pragma unroll
                for (int ks = 0; ks < 2; ++ks)
#pragma unroll
                    for (int nt = 0; nt < 4; ++nt) acc4[nt] = MFMA16(ub[ks][nt], pf[kb + ks], acc4[nt]);
                __builtin_amdgcn_sched_barrier(0);
            }
#pragma unroll
            for (int nt = 0; nt < 4; ++nt) *(LAS f32x4*)(slds + (16 * w + fr) * S5_SSTR + (16 * nt + 4 * fq) * 4) = acc4[nt];
        }
        __syncthreads();
        if (w == 0) {
            const LAS unsigned char* sre = slds + lane * S5_SSTR; const LAS unsigned char* sim = slds + (64 + lane) * S5_SSTR;
            const float hr0 = hr, hi0 = hi;
            const f32x2 are2 = {a_re, a_re}, aim2 = {-a_im, a_im};
#pragma unroll 1
            for (int pr2 = 0; pr2 < (PROBE_S5 == 2 ? 2 : 1); ++pr2) { hr = hr0; hi = hi0;
#pragma unroll 1
            for (int n0 = 0; n0 < 64; n0 += 16) {
                LAS unsigned char* hw = hb + n0 * S5_HSTR + lane * 2;
                f32x4 cr4[4], ci4[4];
#pragma unroll
                for (int q = 0; q < 4; ++q) { cr4[q] = *(const LAS f32x4*)(sre + n0 * 4 + q * 16); ci4[q] = *(const LAS f32x4*)(sim + n0 * 4 + q * 16); }
                CFENCE();
#pragma unroll
                for (int j = 0; j < 16; ++j) {
                    const f32x2 s2 = {cr4[j >> 2][j & 3], ci4[j >> 2][j & 3]};
                    const unsigned hp = cvt_pk_bf16(hr, hi);
                    *(LAS unsigned short*)(hw + j * S5_HSTR) = (unsigned short)hp; *(LAS unsigned short*)(hw + j * S5_HSTR + 128) = (unsigned short)(hp >> 16);
                    const f32x2 hv = {hr, hi}, hx = {hi, hr};
                    const f32x2 nh = hv * are2 + (hx * aim2 + s2);
                    hr = nh[0]; hi = nh[1];
                }
            }
            }
        }
        __syncthreads();
#pragma unroll 1
        for (int pr3 = 0; pr3 < (PROBE_S5 == 3 ? 2 : 1); ++pr3)
#pragma unroll
        for (int nt = 0; nt < 4; ++nt) {
            f32x4 a0 = {0.f, 0.f, 0.f, 0.f}, a1 = {0.f, 0.f, 0.f, 0.f};
#pragma unroll
            for (int kb = 0; kb < 12; kb += 4) {
                bf16x8 bb[4];
#pragma unroll
                for (int ks = 0; ks < 4; ++ks) bb[ks] = (kb < 8) ? frag_row(useg, S5_USTR, 16 * nt, 32 * (kb + ks), lane) : frag_row(hb, S5_HSTR, 16 * nt, 32 * ks, lane);
                __builtin_amdgcn_sched_barrier(0);
#pragma unroll
                for (int ks = 0; ks < 4; ++ks) { a0 = MFMA16(mq0[kb + ks], bb[ks], a0); a1 = MFMA16(mq1[kb + ks], bb[ks], a1); }
                __builtin_amdgcn_sched_barrier(0);
            }
            const int chunk = 16 * nt + fr;
#pragma unroll
            for (int hh = 0; hh < 2; ++hh) {
                const int t = w + 8 * hh; const f32x4 a = hh ? a1 : a0;
                const u32x2 uu = *(const LAS u32x2*)(useg + chunk * S5_USTR + (t * 16 + 4 * fq) * 2);
                const float y0 = gelu_tanh(a[0] + dsk[0] * bflo(uu.x)), y1 = gelu_tanh(a[1] + dsk[1] * bfhi(uu.x)), y2 = gelu_tanh(a[2] + dsk[2] * bflo(uu.y)), y3 = gelu_tanh(a[3] + dsk[3] * bfhi(uu.y));
                u32x2 o; o.x = cvt_pk_bf16(y0, y1); o.y = cvt_pk_bf16(y2, y3);
                const int token = b * 4096 + seg * 1024 + chunk * 16 + t;
                *(u32x2*)(ys5 + (size_t)token * 512 + g * 16 + 4 * fq) = o;
            }
        }
        __syncthreads();
    }
}

constexpr int GL_TSTR = 144;
__device__ __forceinline__ void gla_ld_tile(const bf16* g, int pitch, u32x4 (&r)[8], int lane) {
#pragma unroll
    for (int i = 0; i < 8; ++i) { const int idx = lane + 64 * i; r[i] = *(const u32x4*)(g + (size_t)(idx >> 3) * pitch + (idx & 7) * 8); }
}
__device__ __forceinline__ void gla_st_tile(LAS unsigned char* img, const u32x4 (&r)[8], int lane) {
#pragma unroll
    for (int i = 0; i < 8; ++i) { const int idx = lane + 64 * i; *(LAS u32x4*)(img + (idx >> 3) * GL_TSTR + (idx & 7) * 16) = r[i]; }
}
__device__ __forceinline__ void gla_loga_tile(const Frame& F, int l, int row0, int h, LAS unsigned char* img, int lane_) {
    int lane = lane_; asm volatile("" : "+v"(lane));
    const int fr = lane & 15, fq = lane >> 4;
    const bf16* wa = wsp<bf16>(F, WS_WA2T) + (size_t)l * 256 * 16 + (size_t)(h * 64) * 16; const bf16* gl = wsp<bf16>(F, WS_GL) + (size_t)row0 * 16;
    const float* ba = F.in[15] + l * 256 + h * 64;
    bf16x8 af[4], bfr[4];
    const u32x4 zero4 = {0u, 0u, 0u, 0u};
#pragma unroll
    for (int i = 0; i < 4; ++i) {
        const u32x4 a = (fq < 2) ? *(const u32x4*)(wa + (size_t)(16 * i + fr) * 16 + 8 * fq) : zero4;
        const u32x4 b = (fq < 2) ? *(const u32x4*)(gl + (size_t)(16 * i + fr) * 16 + 8 * fq) : zero4;
        af[i] = __builtin_bit_cast(bf16x8, a); bfr[i] = __builtin_bit_cast(bf16x8, b);
    }
    float b44[4];
#pragma unroll
    for (int mt = 0; mt < 4; ++mt) b44[mt] = ba[16 * mt + fr];
    CFENCE();
#pragma unroll
    for (int mt = 0; mt < 4; ++mt) {
        const float b1 = b44[mt];
#pragma unroll
        for (int nt = 0; nt < 4; ++nt) {
            f32x4 z = {0.f, 0.f, 0.f, 0.f};
            z = MFMA16(bfr[nt], af[mt], z);
            float la[4];
#pragma unroll
            for (int j = 0; j < 4; ++j) { const float v = z[j] + b1; la[j] = (fminf(v, 0.f) - __logf(1.0f + __expf(-fabsf(v)))) * 0.0625f; }
            u32x2 o; o.x = cvt_pk_bf16(la[0], la[1]); o.y = cvt_pk_bf16(la[2], la[3]);
            *(LAS u32x2*)(img + (16 * mt + fr) * GL_TSTR + (16 * nt + 4 * fq) * 2) = o;
        }
    }
}
__device__ __forceinline__ void gla_row(const LAS unsigned char* img, int lane, u32x4 (&r)[8]) {
#pragma unroll
    for (int i = 0; i < 8; ++i) r[i] = *(const LAS u32x4*)(img + lane * GL_TSTR + i * 16);
}
#define GLA_ROWV(r, t) ((((t) & 1) ? bfhi((r)[(t) >> 3][((t) >> 1) & 3]) : bflo((r)[(t) >> 3][((t) >> 1) & 3])))
__device__ __forceinline__ float gla_col(const LAS unsigned char* img, int t, int lane) { return bf2f(*(const LAS bf16*)(img + t * GL_TSTR + lane * 2)); }
__device__ __forceinline__ void gla_a_unit(const Frame& F, int l, int wu) {
    const int lane = F.lane, fq = lane >> 4, fr = lane & 15;
    const int bh = wu >> 6, n = wu & 63, b = bh >> 2, h = bh & 3, row0 = b * 4096 + n * 64;
    LAS unsigned char* ra = F.lds + F.wave * WAVE_LDS; LAS unsigned char* rb = ra + 64 * GL_TSTR;
    const bf16* vp = wsp<bf16>(F, WS_V) + (size_t)row0 * 512 + h * 128;
    u32x4 t1[8], tv[8];
    gla_ld_tile(wsp<bf16>(F, WS_K) + (size_t)row0 * 256 + h * 64, 256, t1, lane);
    gla_ld_tile(vp, 512, tv, lane);
    gla_loga_tile(F, l, row0, h, ra, lane);
    gla_st_tile(rb, t1, lane);
    CFENCE();
    u32x4 lg[8]; gla_row(ra, lane, lg);
    float tot = 0.f;
#pragma unroll
    for (int t = 0; t < 64; ++t) tot += GLA_ROWV(lg, t);
    wsp<float>(F, WS_DEC)[(size_t)wu * 64 + lane] = __expf(tot);
    float cum = 0.f; u32x4 pk[8];
#pragma unroll
    for (int t8 = 0; t8 < 8; ++t8) {
        float ke[8], kc[8];
#pragma unroll
        for (int tt = 0; tt < 8; ++tt) kc[tt] = gla_col(rb, t8 * 8 + tt, lane);
        CFENCE();
#pragma unroll
        for (int tt = 0; tt < 8; ++tt) { const int t = t8 * 8 + tt; cum += GLA_ROWV(lg, t); ke[tt] = kc[tt] * __expf(tot - cum); }
        pk[t8].x = cvt_pk_bf16(ke[0], ke[1]); pk[t8].y = cvt_pk_bf16(ke[2], ke[3]); pk[t8].z = cvt_pk_bf16(ke[4], ke[5]); pk[t8].w = cvt_pk_bf16(ke[6], ke[7]);
    }
    CFENCE();
#pragma unroll
    for (int t8 = 0; t8 < 8; ++t8) *(LAS u32x4*)(ra + lane * GL_TSTR + t8 * 16) = pk[t8];
    bf16* ut = (bf16*)(F.dout + DO_UT) + (size_t)wu * 8192;
#pragma unroll
    for (int hv = 0; hv < 2; ++hv) {
        CFENCE();
        gla_st_tile(rb, tv, lane);
        if (hv == 0) gla_ld_tile(vp + 64, 512, tv, lane);
        CFENCE();
#pragma unroll
        for (int mt = 0; mt < 4; ++mt)
#pragma unroll
            for (int nt = 0; nt < 4; ++nt) {
                f32x4 acc = {0.f, 0.f, 0.f, 0.f};
#pragma unroll
                for (int ks = 0; ks < 2; ++ks) acc = MFMA16(frag_row(ra, GL_TSTR, 16 * mt, 32 * ks, lane), frag_tr(rb, GL_TSTR, 32 * ks, 16 * nt, lane), acc);
                { u32x2 o; o.x = cvt_pk_bf16(acc[0], acc[1]); o.y = cvt_pk_bf16(acc[2], acc[3]);
                  *(u32x2*)(ut + (size_t)(hv * 64 + nt * 16 + fr) * 64 + mt * 16 + 4 * fq) = o; }
            }
    }
}
__device__ __forceinline__ void gla_b_scan(const Frame& F) {
    const bf16* ut = (const bf16*)(F.dout + DO_UT); bf16* st = (bf16*)(F.dout + DO_ST); const float* dec = wsp<float>(F, WS_DEC);
    LAS float* dl = (LAS float*)F.lds;
    for (int blk = F.bid; blk < 256; blk += F.G) {
        const int bh = blk >> 3, e = (blk & 7) * 1024 + F.tid * 2, k = e & 63;
        __syncthreads();
#pragma unroll
        for (int i = 0; i < 2; ++i) *(LAS f32x4*)(dl + (F.tid + 512 * i) * 4) = *(const f32x4*)(dec + (size_t)bh * 4096 + (size_t)(F.tid + 512 * i) * 4);
        __syncthreads();
        f32x2 s2 = {0.f, 0.f};
        const bf16* up = ut + (size_t)bh * 64 * 8192 + e; bf16* sp = st + (size_t)bh * 64 * 8192 + e;
        unsigned un16[16];
#pragma unroll
        for (int j = 0; j < 16; ++j) un16[j] = *(const unsigned*)(up + (size_t)j * 8192);
#pragma unroll 1
        for (int n0 = 0; n0 < 64; n0 += 16) {
            unsigned u16[16];
#pragma unroll
            for (int j = 0; j < 16; ++j) u16[j] = un16[j];
            if (n0 < 48) {
#pragma unroll
                for (int j = 0; j < 16; ++j) un16[j] = *(const unsigned*)(up + (size_t)(n0 + 16 + j) * 8192);
            }
            CFENCE();
#pragma unroll
            for (int j = 0; j < 16; ++j) {
                const f32x2 d = *(const LAS f32x2*)(dl + (n0 + j) * 64 + k);
                *(unsigned*)(sp + (size_t)(n0 + j) * 8192) = cvt_pk_bf16(s2[0], s2[1]);
                s2 = d * s2 + (f32x2){bflo(u16[j]), bfhi(u16[j])};
            }
        }
    }
}
__device__ __forceinline__ void gla_c_unit(const Frame& F, int l, int wu) {
    const int lane = F.lane, fq = lane >> 4, fr = lane & 15;
    const int bh = wu >> 6, n = wu & 63, b = bh >> 2, h = bh & 3, row0 = b * 4096 + n * 64;
    LAS unsigned char* qtt = F.lds + F.wave * WAVE_LDS; LAS unsigned char* ktt = qtt + 64 * GL_TSTR;
    const bf16* vp = wsp<bf16>(F, WS_V) + (size_t)row0 * 512 + h * 128;
    u32x4 t1[8], t2[8], tv[8];
    gla_loga_tile(F, l, row0, h, qtt, lane);
    CFENCE();
    gla_ld_tile(wsp<bf16>(F, WS_K) + (size_t)row0 * 256 + h * 64, 256, t1, lane);
    gla_ld_tile(wsp<bf16>(F, WS_Q) + (size_t)row0 * 256 + h * 64, 256, t2, lane);
    gla_st_tile(ktt, t1, lane);
    CFENCE();
    unsigned e1p[32]; float cum = 0.f; u32x4 pkk[8], pkq[8];
    u32x4 lg[8]; gla_row(qtt, lane, lg);
#pragma unroll
    for (int t8 = 0; t8 < 8; ++t8) {
        float kt[8], e8[8], kc[8];
#pragma unroll
        for (int tt = 0; tt < 8; ++tt) kc[tt] = gla_col(ktt, t8 * 8 + tt, lane);
        CFENCE();
#pragma unroll
        for (int tt = 0; tt < 8; ++tt) { const int t = t8 * 8 + tt; cum += GLA_ROWV(lg, t); e8[tt] = __expf(cum); kt[tt] = kc[tt] * __builtin_amdgcn_rcpf(e8[tt]); }
#pragma unroll
        for (int j = 0; j < 4; ++j) e1p[t8 * 4 + j] = cvt_pk_bf16(e8[2 * j], e8[2 * j + 1]);
        pkk[t8].x = cvt_pk_bf16(kt[0], kt[1]); pkk[t8].y = cvt_pk_bf16(kt[2], kt[3]); pkk[t8].z = cvt_pk_bf16(kt[4], kt[5]); pkk[t8].w = cvt_pk_bf16(kt[6], kt[7]);
    }
    CFENCE();
    gla_st_tile(qtt, t2, lane);
    gla_ld_tile(vp, 512, tv, lane);
    CFENCE();
#pragma unroll
    for (int t8 = 0; t8 < 8; ++t8) {
        float qt[8], qc[8];
#pragma unroll
        for (int tt = 0; tt < 8; ++tt) qc[tt] = gla_col(qtt, t8 * 8 + tt, lane);
        CFENCE();
#pragma unroll
        for (int tt = 0; tt < 8; ++tt) { const int t = t8 * 8 + tt; const unsigned ep = e1p[t >> 1]; qt[tt] = qc[tt] * ((t & 1) ? bfhi(ep) : bflo(ep)) * 0.125f; }
        pkq[t8].x = cvt_pk_bf16(qt[0], qt[1]); pkq[t8].y = cvt_pk_bf16(qt[2], qt[3]); pkq[t8].z = cvt_pk_bf16(qt[4], qt[5]); pkq[t8].w = cvt_pk_bf16(qt[6], qt[7]);
    }
    CFENCE();
#pragma unroll
    for (int t8 = 0; t8 < 8; ++t8) { *(LAS u32x4*)(qtt + lane * GL_TSTR + t8 * 16) = pkq[t8]; *(LAS u32x4*)(ktt + lane * GL_TSTR + t8 * 16) = pkk[t8]; }
    CFENCE();
    u32x2 sc[4][4];
#pragma unroll
    for (int mt = 0; mt < 4; ++mt)
#pragma unroll
        for (int nt = 0; nt < 4; ++nt) {
            if (mt > nt) { sc[mt][nt] = (u32x2){0u, 0u}; continue; }
            f32x4 acc = {0.f, 0.f, 0.f, 0.f};
#pragma unroll
            for (int ks = 0; ks < 2; ++ks) acc = MFMA16(frag_tr(ktt, GL_TSTR, 32 * ks, 16 * mt, lane), frag_tr(qtt, GL_TSTR, 32 * ks, 16 * nt, lane), acc);
            if (mt == nt) {
#pragma unroll
                for (int rg = 0; rg < 4; ++rg) if (4 * fq + rg > fr) acc[rg] = 0.f;
            }
            sc[mt][nt].x = cvt_pk_bf16(acc[0], acc[1]); sc[mt][nt].y = cvt_pk_bf16(acc[2], acc[3]);
        }
    const bf16* st = (const bf16*)(F.dout + DO_ST) + (size_t)wu * 8192;
    f32x4 o[8][4];
#pragma unroll
    for (int hv = 0; hv < 2; ++hv) {
        CFENCE();
        gla_st_tile(ktt, tv, lane);
        CFENCE();
#pragma unroll
        for (int dt = 0; dt < 4; ++dt) {
            const int dvt = hv * 4 + dt;
            bf16x8 sfr[2], vfr[2];
#pragma unroll
            for (int ks = 0; ks < 2; ++ks) { sfr[ks] = *(const bf16x8*)(st + (size_t)(dvt * 16 + fr) * 64 + 32 * ks + 8 * fq); vfr[ks] = frag_tr_perm(ktt, GL_TSTR, 32 * ks, 16 * dt, lane); }
#pragma unroll
            for (int nt = 0; nt < 4; ++nt) {
                f32x4 acc = {0.f, 0.f, 0.f, 0.f};
#pragma unroll
                for (int ks = 0; ks < 2; ++ks) {
                    if (2 * ks <= nt) {
                        const u32x4 bw = {sc[2 * ks][nt].x, sc[2 * ks][nt].y, sc[2 * ks + 1][nt].x, sc[2 * ks + 1][nt].y};
                        acc = MFMA16(vfr[ks], __builtin_bit_cast(bf16x8, bw), acc);
                    }
                    acc = MFMA16(sfr[ks], frag_tr(qtt, GL_TSTR, 32 * ks, 16 * nt, lane), acc);
                }
                o[dvt][nt] = acc;
            }
        }
        if (hv == 0) gla_ld_tile(vp + 64, 512, tv, lane);
    }
    const float* gn = F.in[16] + l * 512 + h * 128;
    const bf16* rp = wsp<bf16>(F, WS_R) + (size_t)row0 * 512 + h * 128;
    bf16* mx = wsp<bf16>(F, WS_MIXED) + (size_t)row0 * D + 512 + h * 128;
    float rs4[4];
#pragma unroll
    for (int nt = 0; nt < 4; ++nt) {
        float ss = 0.f;
#pragma unroll
        for (int dvt = 0; dvt < 8; ++dvt) { const f32x4 x = o[dvt][nt]; ss += (x[0] * x[0] + x[1] * x[1]) + (x[2] * x[2] + x[3] * x[3]); }
        ss += __shfl_xor(ss, 16); ss += __shfl_xor(ss, 32);
        rs4[nt] = rsqrtf(ss * (1.0f / 128.0f) + EPS);
    }
    f32x4 gN = *(const f32x4*)(gn + 4 * fq); u32x2 rN[4];
#pragma unroll
    for (int nt = 0; nt < 4; ++nt) rN[nt] = *(const u32x2*)(rp + (size_t)(16 * nt + fr) * 512 + 4 * fq);
#pragma unroll
    for (int dvt = 0; dvt < 8; ++dvt) {
        const int dv = 16 * dvt + 4 * fq;
        const f32x4 g = gN; u32x2 rc[4];
#pragma unroll
        for (int nt = 0; nt < 4; ++nt) rc[nt] = rN[nt];
        if (dvt < 7) {
            gN = *(const f32x4*)(gn + dv + 16);
#pragma unroll
            for (int nt = 0; nt < 4; ++nt) rN[nt] = *(const u32x2*)(rp + (size_t)(16 * nt + fr) * 512 + dv + 16);
        }
        CFENCE();
#pragma unroll
        for (int nt = 0; nt < 4; ++nt) {
            const int i = 16 * nt + fr; const float rs = rs4[nt]; const u32x2 rr = rc[nt]; const f32x4 x = o[dvt][nt];
            u32x2 w; w.x = cvt_pk_bf16(x[0] * rs * g[0] * siluf_(bflo(rr.x)), x[1] * rs * g[1] * siluf_(bfhi(rr.x))); w.y = cvt_pk_bf16(x[2] * rs * g[2] * siluf_(bflo(rr.y)), x[3] * rs * g[3] * siluf_(bfhi(rr.y)));
            *(u32x2*)(mx + (size_t)i * D + dv) = w;
        }
    }
}
__device__ __forceinline__ void s5_fin_rows(const Frame& F, int l) {
    const int lane = F.lane, gw = F.bid * 8 + F.wave, NGW = F.G * 8;
    const bf16* y = wsp<bf16>(F, WS_UGM); bf16* mx = wsp<bf16>(F, WS_MIXED);
    const float* gn = F.in[13] + l * 512 + lane * 8; const f32x4 g0 = *(const f32x4*)gn, g1 = *(const f32x4*)(gn + 4);
    u32x4 an = {0u, 0u, 0u, 0u};
    if (gw < M) an = *((const u32x4*)(y + (size_t)gw * 512) + lane);
    for (int row = gw; row < M; row += NGW) {
        const u32x4 a = an;
        if (row + NGW < M) an = *((const u32x4*)(y + (size_t)(row + NGW) * 512) + lane);
        CFENCE();
        float v[8] = {bflo(a.x), bfhi(a.x), bflo(a.y), bfhi(a.y), bflo(a.z), bfhi(a.z), bflo(a.w), bfhi(a.w)}; float s = 0.f;
#pragma unroll
        for (int j = 0; j < 8; ++j) s += v[j] * v[j];
        s = wave_sum(s); const float rs = rsqrtf(s * (1.0f / 512.0f) + EPS);
        u32x4 w; w.x = cvt_pk_bf16(v[0] * rs * g0[0], v[1] * rs * g0[1]); w.y = cvt_pk_bf16(v[2] * rs * g0[2], v[3] * rs * g0[3]); w.z = cvt_pk_bf16(v[4] * rs * g1[0], v[5] * rs * g1[1]); w.w = cvt_pk_bf16(v[6] * rs * g1[2], v[7] * rs * g1[3]);
        *((u32x4*)(mx + (size_t)row * D) + lane) = w;
    }
}
__device__ __forceinline__ void moe_router(const Frame& F) {
    const int lane = F.lane, fr = lane & 15, fq = lane >> 4;
    const float* gain = F.in[18] + D; const float* wr_ = F.in[22];
    constexpr int RT_OFF = 16384, RT_STR = 2064;
    {
        const int k0 = 2 * F.tid;
        const f32x2 g2 = *(const f32x2*)(gain + k0);
        const f32x4 wa = *(const f32x4*)(wr_ + k0 * 8), wb = *(const f32x4*)(wr_ + k0 * 8 + 4), wc_ = *(const f32x4*)(wr_ + k0 * 8 + 8), wd = *(const f32x4*)(wr_ + k0 * 8 + 12);
        const float w0[8] = {wa[0], wa[1], wa[2], wa[3], wb[0], wb[1], wb[2], wb[3]}, w1_[8] = {wc_[0], wc_[1], wc_[2], wc_[3], wd[0], wd[1], wd[2], wd[3]};
#pragma unroll
        for (int e = 0; e < 8; ++e) {
            const float a = g2[0] * w0[e], b2 = g2[1] * w1_[e];
            const unsigned ah = f2bf(a), bh = f2bf(b2), al = f2bf(a - bf2f(ah)), bl = f2bf(b2 - bf2f(bh));
            *(LAS unsigned*)(F.lds + RT_OFF + e * RT_STR + k0 * 2) = ah | (bh << 16);
            *(LAS unsigned*)(F.lds + RT_OFF + (8 + e) * RT_STR + k0 * 2) = al | (bl << 16);
        }
    }
    __syncthreads();
    bf16x8 wf[32];
#pragma unroll
    for (int ks = 0; ks < 32; ++ks) wf[ks] = *(const LAS bf16x8*)(F.lds + RT_OFF + fr * RT_STR + (32 * ks + 8 * fq) * 2);
    const bf16* xb = wsp<bf16>(F, WS_XB); int* tok = wsp<int>(F, WS_TOK); float* wl = wsp<float>(F, WS_WL); float* rl = wsp<float>(F, WS_RL);
    unsigned* cnt = wsp<unsigned>(F, WS_CTL) + CW_CNT;
    LAS int* lcnt = (LAS int*)F.lds; LAS int* lbase = lcnt + 16; LAS int* rinfo = lbase + 16; LAS float* rw = (LAS float*)(rinfo + 1024); LAS float* rr = rw + 1024;
    const int rows_per_wg = ((M + F.G - 1) / F.G + 15) & ~15, r0 = F.bid * rows_per_wg, r1 = (r0 + rows_per_wg < M) ? r0 + rows_per_wg : M;
    if (F.tid < 16) lcnt[F.tid] = 0;
    __syncthreads();
    for (int m0 = r0 + 16 * F.wave; m0 < r1; m0 += 128) {
        f32x4 acc = {0.f, 0.f, 0.f, 0.f}; float ss = 0.f;
        const bf16* xr = xb + (size_t)(m0 + fr) * D + 8 * fq;
#pragma unroll
        for (int kg = 0; kg < 4; ++kg) {
            u32x4 a8[8];
#pragma unroll
            for (int kk = 0; kk < 8; ++kk) a8[kk] = *(const u32x4*)(xr + 32 * (8 * kg + kk));
            CFENCE();
#pragma unroll
            for (int kk = 0; kk < 8; ++kk) {
                const u32x4 a = a8[kk];
                const float x0 = bflo(a.x), x1 = bfhi(a.x), x2 = bflo(a.y), x3 = bfhi(a.y), x4 = bflo(a.z), x5 = bfhi(a.z), x6 = bflo(a.w), x7 = bfhi(a.w);
                ss += (x0 * x0 + x1 * x1) + (x2 * x2 + x3 * x3) + (x4 * x4 + x5 * x5) + (x6 * x6 + x7 * x7);
                acc = MFMA16(wf[8 * kg + kk], __builtin_bit_cast(bf16x8, a), acc);
            }
        }
        ss += __shfl_xor(ss, 16); ss += __shfl_xor(ss, 32);
        float lg4[4];
#pragma unroll
        for (int j = 0; j < 4; ++j) lg4[j] = acc[j] + __shfl_xor(acc[j], 32);
        float lg[8];
#pragma unroll
        for (int j = 0; j < 4; ++j) { const float o = __shfl_xor(lg4[j], 16); lg[j] = (fq & 1) ? o : lg4[j]; lg[4 + j] = (fq & 1) ? lg4[j] : o; }
        const float rs = rsqrtf(ss * (1.0f / D) + EPS);
        int e1 = 0; float l1 = lg[0];
#pragma unroll
        for (int e = 1; e < 8; ++e) if (lg[e] > l1) { l1 = lg[e]; e1 = e; }
        int e2 = -1; float l2 = -3.0e38f;
#pragma unroll
        for (int e = 0; e < 8; ++e) if (e != e1 && lg[e] > l2) { l2 = lg[e]; e2 = e; }
        const float w1 = 1.0f / (1.0f + __expf((l2 - l1) * rs));
        if (fq == 0) {
            const int p1 = __hip_atomic_fetch_add(lcnt + e1, 1, __ATOMIC_RELAXED, __HIP_MEMORY_SCOPE_WORKGROUP);
            const int p2 = __hip_atomic_fetch_add(lcnt + 8 + e2, 1, __ATOMIC_RELAXED, __HIP_MEMORY_SCOPE_WORKGROUP);
            const int i = m0 + fr - r0; rinfo[i] = e1 | (e2 << 4) | (p1 << 8) | (p2 << 20); rw[i] = w1; rr[i] = rs;
        }
    }
    __syncthreads();
    if (F.tid < 16) lbase[F.tid] = (int)__hip_atomic_fetch_add(cnt + F.tid, (unsigned)lcnt[F.tid], __ATOMIC_RELAXED, __HIP_MEMORY_SCOPE_AGENT);
    __syncthreads();
    for (int i = F.tid; i < r1 - r0; i += 512) {
        const int inf = rinfo[i], e1 = inf & 15, e2 = (inf >> 4) & 15, p1 = lbase[e1] + ((inf >> 8) & 4095), p2 = lbase[8 + e2] + ((inf >> 20) & 4095);
        const float w1 = rw[i], rs = rr[i];
        tok[e1 * 32768 + p1] = r0 + i; wl[e1 * 32768 + p1] = w1; rl[e1 * 32768 + p1] = rs;
        tok[(8 + e2) * 32768 + p2] = r0 + i; wl[(8 + e2) * 32768 + p2] = 1.0f - w1; rl[(8 + e2) * 32768 + p2] = rs;
    }
    __syncthreads();
}
__device__ __forceinline__ void final_norm(const Frame& F, bool from_xb) {
    const int lane = F.lane, gw = F.bid * 8 + F.wave, NGW = F.G * 8;
    const bf16* xo = from_xb ? wsp<bf16>(F, WS_XB) : wsp<bf16>(F, WS_XO); const float* g = F.in[26]; float* out = (float*)F.dout;
    f32x4 gv[4];
#pragma unroll
    for (int hh = 0; hh < 2; ++hh) { gv[2 * hh] = *(const f32x4*)(g + hh * 512 + lane * 8); gv[2 * hh + 1] = *(const f32x4*)(g + hh * 512 + lane * 8 + 4); }
    u32x4 n0 = {0u, 0u, 0u, 0u}, n1 = n0;
    if (gw < M) { n0 = *((const u32x4*)(xo + (size_t)gw * D) + lane); n1 = *((const u32x4*)(xo + (size_t)gw * D + 512) + lane); }
    for (int m = gw; m < M; m += NGW) {
        const u32x4 a0 = n0, a1 = n1;
        if (m + NGW < M) { n0 = *((const u32x4*)(xo + (size_t)(m + NGW) * D) + lane); n1 = *((const u32x4*)(xo + (size_t)(m + NGW) * D + 512) + lane); }
        CFENCE();
        const float x[16] = {bflo(a0.x), bfhi(a0.x), bflo(a0.y), bfhi(a0.y), bflo(a0.z), bfhi(a0.z), bflo(a0.w), bfhi(a0.w), bflo(a1.x), bfhi(a1.x), bflo(a1.y), bfhi(a1.y), bflo(a1.z), bfhi(a1.z), bflo(a1.w), bfhi(a1.w)};
        float ss = 0.f;
#pragma unroll
        for (int j = 0; j < 16; ++j) ss += x[j] * x[j];
        ss = wave_sum(ss); const float rs = rsqrtf(ss * (1.0f / D) + EPS);
#pragma unroll
        for (int hh = 0; hh < 2; ++hh) {
            const f32x4 g0 = gv[2 * hh], g1 = gv[2 * hh + 1];
            f32x4 o0 = {x[hh * 8 + 0] * rs * g0[0], x[hh * 8 + 1] * rs * g0[1], x[hh * 8 + 2] * rs * g0[2], x[hh * 8 + 3] * rs * g0[3]};
            f32x4 o1 = {x[hh * 8 + 4] * rs * g1[0], x[hh * 8 + 5] * rs * g1[1], x[hh * 8 + 6] * rs * g1[2], x[hh * 8 + 7] * rs * g1[3]};
            *(f32x4*)(out + (size_t)m * D + hh * 512 + lane * 8) = o0; *(f32x4*)(out + (size_t)m * D + hh * 512 + lane * 8 + 4) = o1;
        }
    }
}

__global__ void __launch_bounds__(512, 2) mk_fwd(Args args) {
    extern __shared__ __attribute__((aligned(16))) unsigned char lds_raw[];
    Frame F0;
    F0.lds = (LAS unsigned char*)lds_raw; F0.tid = threadIdx.x; F0.lane = F0.tid & 63; F0.wave = __builtin_amdgcn_readfirstlane(F0.tid >> 6);
    F0.G = gridDim.x; F0.bid = blockIdx.x; F0.in = args.in; F0.ws = args.ws; F0.dout = (unsigned char*)args.out;
    const Frame& F = F0;
    volatile LAS unsigned* MISC = (volatile LAS unsigned*)(F.lds + MISC_OFF);
    for (int u = F.tid; u < (LDS_BYTES - MISC_OFF) / 4; u += 512) MISC[u] = 0u;
    __syncthreads();
#if MK_N_LAUNCHES == 1
    XcdBarrier bar = xcd_barrier_post(wsp<unsigned>(F, WS_CTL) + CW_BAR, MISC);
#define GRID_BAR() xcd_barrier(bar)
#else
#define GRID_BAR() do {} while (0)
#endif
    const int lo = args.ph_lo, hi = args.ph_hi;
#ifndef PH_MASK
#define PH_MASK 0xFFFFFFu
#endif
#define IN(k) ((((PH_MASK) >> ((k) > 7 && (k) < 13 ? (k) - 7 : (k))) & 1u) && lo <= (k) && (k) < hi)
#define SEAM(k) do { if (IN(k) && IN((k) + 1)) GRID_BAR(); } while (0)
    LAS unsigned char* ring = F.lds;
#define xb wsp<bf16>(F, WS_XB)
#define ssp wsp<float>(F, WS_SSP)
#ifndef REP_PHASE
#define REP_PHASE (-1)
#endif
#ifndef REP_N
#define REP_N 0
#endif
#define REPS(k) (((k) == REP_PHASE) ? 1 + REP_N : 1)
#define REP_BEGIN(k) for (int rep = 0; rep < REPS(k); ++rep) {
#define REP_END(k) if (rep + 1 < REPS(k)) GRID_BAR(); }
    if (IN(0)) { REP_BEGIN(0) p0_prologue(launder(F0)); REP_END(0) } SEAM(0);

#pragma unroll 1
    for (int l = 0; l < 2; ++l) {
        const int pb = 1 + 7 * l;
        if (IN(pb)) {
            REP_BEGIN(1)
            const Frame F = launder(F0);
            pg8::ProbPlain P{xb, wsp<bf16>(F, WS_WIN) + (size_t)l * NPROJ * D, D, D, D};
            pg8::StaticOrder S; S.init(M / 256, 8, F.G, F.bid);
            EpiInproj E{ssp, F.ws + WS_ACT};
            pg8::gemm_phase(ring, P, S, E);
            glow_pass(launder(F0), l);
            REP_END(1)
        } SEAM(pb);
        if (IN(pb + 1)) {
            REP_BEGIN(2)
            const Frame F = launder(F0);
#ifndef PROBE_SUB
#define PROBE_SUB 0
#endif
#pragma unroll 1
            for (int pr = 0; pr < (PROBE_SUB == 1 ? 2 : 1); ++pr) for (int un = F.bid; un < 256; un += F.G) s5_unit(F, l, un);
#pragma unroll 1
            for (int pr = 0; pr < (PROBE_SUB == 2 ? 2 : 1); ++pr) for (int wu = F.bid * 8 + F.wave; wu < 2048; wu += F.G * 8) gla_a_unit(F, l, wu);
            REP_END(2)
        } SEAM(pb + 1);
        if (IN(pb + 2)) {
            REP_BEGIN(3)
            const Frame F = launder(F0);
            pg8::ProbPlain P{(const bf16*)(F.dout + DO_YS5), wsp<bf16>(F, WS_WGLU) + (size_t)l * 512 * 512, 512, 512, 512};
            pg8::StaticOrder S; S.init(M / 256, 2, F.G, F.bid);
            EpiGlu E{(const bf16*)(F.dout + DO_YS5), wsp<bf16>(F, WS_UGM), F.in[12] + l * 512};
            pg8::gemm_phase(ring, P, S, E);
#pragma unroll 1
            for (int pr = 0; pr < (PROBE_SUB == 3 ? 2 : 1); ++pr) gla_b_scan(launder(F0));
            REP_END(3)
        } SEAM(pb + 2);
        if (IN(pb + 3)) {
            REP_BEGIN(4)
            const Frame F = launder(F0);
#pragma unroll 1
            for (int pr = 0; pr < (PROBE_SUB == 4 ? 2 : 1); ++pr) for (int wu = F.bid * 8 + F.wave; wu < 2048; wu += F.G * 8) gla_c_unit(F, l, wu);
#pragma unroll 1
            for (int pr = 0; pr < (PROBE_SUB == 5 ? 2 : 1); ++pr) { s5_fin_rows(launder(F0), l); }
            REP_END(4)
        } SEAM(pb + 3);
        if (IN(pb + 4)) {
            REP_BEGIN(5)
            const Frame F = launder(F0);
            pg8::ProbPlain P{wsp<bf16>(F, WS_MIXED), wsp<bf16>(F, WS_WOUT) + (size_t)l * D * D, D, D, D};
            pg8::StaticOrder S; S.init(M / 256, 4, F.G, F.bid);
            const bool want8 = (l == 0) ? (USE_F8_FFN != 0) : (USE_F8_MOE != 0);
            EpiResid E{xb, ssp, rep ? (bf16*)F.dout : xb, rep == 0, (want8 && rep == 0) ? wsp<unsigned char>(F, WS_X8) : nullptr, 1.0f};
            pg8::gemm_phase(ring, P, S, E);
            REP_END(5)
        } SEAM(pb + 4);
        if (l == 0) {
            if (IN(6)) {
                REP_BEGIN(6)
                const Frame F = launder(F0);
                constexpr int KU = USE_F8_FFN ? D / 2 : D;
                pg8::ProbPlainT<USE_F8_FFN != 0> P{USE_F8_FFN ? wsp<bf16>(F, WS_X8) : xb, wsp<bf16>(F, WS_WFGU), KU, KU, KU};
                pg8::StaticOrder S; S.init(M / 256, 2 * DFF / 256, F.G, F.bid);
                EpiSwigluT<USE_F8_FFN != 0> E{ssp, wsp<bf16>(F, WS_HD), DFF};
                pg8::gemm_phase(ring, P, S, E);
                REP_END(6)
            } SEAM(6);
            if (IN(7)) {
                REP_BEGIN(7)
                const Frame F = launder(F0);
                constexpr int KD = USE_F8_FFN ? DFF / 2 : DFF;
                pg8::ProbPlainT<USE_F8_FFN != 0, true> P{wsp<bf16>(F, WS_HD), wsp<bf16>(F, WS_WFD), KD, KD, KD};
                pg8::StaticOrder S; S.init(M / 256, 4, F.G, F.bid);
                EpiResid E{xb, ssp, rep ? (bf16*)F.dout : xb, rep == 0, nullptr, USE_F8_FFN ? 1.0f / (F8_SH * F8_SW_DN) : 1.0f};
                pg8::gemm_phase(ring, P, S, E);
                REP_END(7)
            } SEAM(7);
        }
    }
    if (IN(13)) { moe_router(launder(F0)); } SEAM(13);
#pragma unroll 1
    for (int s = 0; s < 5; ++s) {
        if (IN(14 + s)) {
            const Frame F = launder(F0);
            moe_build_tables(F);
            const MoeTab T = moe_tab(F);
            int nheavy = 0;
            if (s >= 1) {
                REP_BEGIN(15)
                constexpr int KD = DFE * MOE_ESZ / 2;
                ProbMoeDown P{((s - 1) & 1) ? (void*)wsp<bf16>(F, WS_H1) : (void*)F.dout, wsp<bf16>(F, WS_MD), KD, KD, KD};
                MoeOrder S; S.init(T, s - 1, 4, F.G, F.bid, 0, 0);
                nheavy = S.nheavy_next();
                EpiMoeDown E{wsp<int>(F, WS_TOK), wsp<float>(F, WS_WL), xb, wsp<bf16>(F, WS_XO), T, rep != 0};
                pg8::gemm_phase(ring, P, S, E);
                REP_END(15)
            }
            if (s < 4) {
                REP_BEGIN(14)
                constexpr int KU = D * MOE_ESZ / 2;
                ProbMoeUp P{USE_F8_MOE ? (const void*)wsp<unsigned char>(F, WS_X8) : (const void*)xb, wsp<bf16>(F, WS_MGU), wsp<int>(F, WS_TOK), T, KU, KU, KU};
                MoeOrder S; S.init(T, s, 2 * DFE / 256, F.G, F.bid, nheavy, 3);
                EpiSwigluMoe E{wsp<float>(F, WS_RL), (s & 1) ? (void*)wsp<bf16>(F, WS_H1) : (void*)F.dout, T};
                pg8::gemm_phase(ring, P, S, E);
                REP_END(14)
            }
        } SEAM(14 + s);
    }
    if (IN(19)) { REP_BEGIN(19) final_norm(launder(F0), hi > 50); REP_END(19) }
#undef xb
#undef ssp
#undef IN
#undef SEAM
}

extern "C" void kernel_launch(void* const* d_in, const int* in_sizes, int n_in, void* d_out, int out_size, void* d_ws, size_t ws_size, hipStream_t stream) {
    static int grid = 0;
    if (grid == 0) {
        if (n_in != 27 || in_sizes[0] != M * D || out_size != M * D || ws_size < WS_END) { fprintf(stderr, "kernel_launch: unexpected shapes (n_in %d, ws %zu < %zu?)\n", n_in, ws_size, (size_t)WS_END); grid = -1; return; }
        int dev = 0, cus = 0, per_cu = 0;
        if (hipGetDevice(&dev) != hipSuccess || hipDeviceGetAttribute(&cus, hipDeviceAttributeMultiprocessorCount, dev) != hipSuccess) { grid = -1; return; }
        if (hipFuncSetAttribute((const void*)mk_fwd, hipFuncAttributeMaxDynamicSharedMemorySize, LDS_BYTES) != hipSuccess) { fprintf(stderr, "kernel_launch: hipFuncSetAttribute failed\n"); grid = -1; return; }
        if (hipOccupancyMaxActiveBlocksPerMultiprocessor(&per_cu, (const void*)mk_fwd, 512, LDS_BYTES) != hipSuccess || per_cu < 1) fprintf(stderr, "kernel_launch: occupancy query says %d\n", per_cu);
        (void)hipGetLastError();
        grid = cus;
    }
    if (grid < 0) return;
    if (hipMemsetAsync((char*)d_ws + WS_CTL, 0, CTL_ZERO_BYTES, stream) != hipSuccess) return;
    Args a{};
    for (int i = 0; i < 27; ++i) a.in[i] = (const float*)d_in[i];
    a.out = (float*)d_out; a.ws = (unsigned char*)d_ws;
#if MK_N_LAUNCHES == 1
#ifdef PROBE_PREFIX
    a.ph_lo = 0; a.ph_hi = PROBE_PREFIX + 1;
    hipLaunchKernelGGL(mk_fwd, dim3(grid), dim3(512), LDS_BYTES, stream, a);
    if (hipMemsetAsync((char*)d_ws + WS_CTL, 0, CTL_ZERO_BYTES, stream) != hipSuccess) return;
#endif
    a.ph_lo = 0; a.ph_hi = NPHASE;
    hipLaunchKernelGGL(mk_fwd, dim3(grid), dim3(512), LDS_BYTES, stream, a);
#else
#ifdef EXP_STOP
    for (int p = 0; p <= EXP_STOP; ++p) { a.ph_lo = p; a.ph_hi = p + 1; hipLaunchKernelGGL(mk_fwd, dim3(grid), dim3(512), LDS_BYTES, stream, a); }
    a.ph_lo = 19; a.ph_hi = 100; hipLaunchKernelGGL(mk_fwd, dim3(grid), dim3(512), LDS_BYTES, stream, a);
#else
    for (int p = 0; p < NPHASE; ++p) { a.ph_lo = p; a.ph_hi = p + 1; hipLaunchKernelGGL(mk_fwd, dim3(grid), dim3(512), LDS_BYTES, stream, a); }
#endif
#endif
}
```

```cpp
#include <hip/hip_runtime.h>
#include <cstdio>
#include <cstdint>

#ifndef USE_F8_FFN
#define USE_F8_FFN 0
#endif
#ifndef USE_F8_MOE
#define USE_F8_MOE 1
#endif
#ifndef MK_N_LAUNCHES
#define MK_N_LAUNCHES 1
#endif

#define LAS __attribute__((address_space(3)))
#define GAS __attribute__((address_space(1)))
typedef unsigned short bf16;
typedef short bf16x8 __attribute__((ext_vector_type(8)));
typedef short s16x4 __attribute__((ext_vector_type(4)));
typedef short v4i16_t __attribute__((ext_vector_type(4)));
typedef float f32x4 __attribute__((ext_vector_type(4)));
typedef float f32x2 __attribute__((ext_vector_type(2)));
typedef unsigned u32x4 __attribute__((ext_vector_type(4)));
typedef unsigned u32x2 __attribute__((ext_vector_type(2)));
typedef int i32x4_t __attribute__((ext_vector_type(4)));

constexpr int BATCH = 8, SEQ = 4096, D = 1024, M = BATCH * SEQ;
constexpr int DS5 = 512, NGRP = 32, NST = 64;
constexpr int GH = 4, DK = 64, DV = 128, DGK = 256, DGV = 512, NCH = SEQ / 64;
constexpr int DIN = 2064, NPROJ = 2304;
constexpr int DFF = 2816, NE = 8, DFE = 3584;
constexpr float EPS = 1e-6f;
constexpr int NPHASE = 20;

constexpr size_t MiB = 1u << 20;
constexpr size_t WS_CTL = 0, CTL_ZERO_BYTES = 2 * MiB;
constexpr size_t WS_SSP = 2 * MiB;
constexpr size_t WS_WIN = 4 * MiB;
constexpr size_t WS_WGLU = 13 * MiB;
constexpr size_t WS_WOUT = 14 * MiB;
constexpr size_t WS_WFGU = 18 * MiB;
constexpr size_t WS_WFD = 29 * MiB;
constexpr size_t WS_S5P = 35 * MiB;
constexpr size_t WS_S5MQ = 39 * MiB;
constexpr size_t WS_S5A16 = 51 * MiB;
constexpr size_t WS_WGT = 51 * MiB + 65536;
constexpr size_t WS_WA2T = 51 * MiB + 131072;
constexpr size_t WS_MGU = 52 * MiB;
constexpr size_t WS_MD = (USE_F8_MOE ? 108 : 164) * MiB;
constexpr size_t WS_X8 = (USE_F8_MOE ? 136 : 500) * MiB;
static_assert(USE_F8_MOE || !USE_F8_FFN, "x8 lives in the space the fp8 expert weights leave free");
constexpr size_t WS_XB = 220 * MiB;
constexpr size_t WS_ACT = 284 * MiB;
constexpr size_t WS_UGM = WS_ACT;
constexpr size_t WS_Q = WS_ACT + 32 * MiB;
constexpr size_t WS_K = WS_ACT + 48 * MiB;
constexpr size_t WS_V = WS_ACT + 64 * MiB;
constexpr size_t WS_R = WS_ACT + 96 * MiB;
constexpr size_t WS_GL = WS_ACT + 128 * MiB;
constexpr size_t WS_MIXED = WS_ACT + 144 * MiB;
constexpr size_t WS_HD = WS_ACT;
constexpr size_t WS_H1 = WS_ACT;
constexpr size_t WS_XO = WS_ACT + 120 * MiB;
constexpr size_t WS_TOK = WS_ACT + 184 * MiB;
constexpr size_t WS_WL = WS_ACT + 186 * MiB;
constexpr size_t WS_RL = WS_ACT + 188 * MiB;
constexpr size_t WS_DEC = WS_ACT + 208 * MiB;
constexpr size_t WS_END = WS_ACT + 209 * MiB;
constexpr size_t DO_UT = 0, DO_ST = 64 * MiB, DO_YS5 = 96 * MiB;
constexpr int MOE_CAP_TILES = 68;
constexpr int CW_BAR = 4096;
constexpr int CW_CNT = 16384;

constexpr int RING_BYTES = 131072;
constexpr int MOE_TAB_OFF = 131072;
constexpr int MISC_OFF = 147456;
constexpr int LDS_BYTES = 148480;
constexpr int WAVE_LDS = 18432;

#define LDS_WAIT() asm volatile("s_waitcnt lgkmcnt(0)" ::: "memory")
#define VM_WAIT() asm volatile("s_waitcnt vmcnt(0)" ::: "memory")
#define CFENCE() asm volatile("" ::: "memory")
__device__ __forceinline__ unsigned f2bf(float f) { unsigned u = __builtin_bit_cast(unsigned, f); return (u + 0x7fffu + ((u >> 16) & 1u)) >> 16; }
__device__ __forceinline__ unsigned pk2(float lo, float hi) { return f2bf(lo) | (f2bf(hi) << 16); }
__device__ __forceinline__ float bf2f(unsigned b) { return __builtin_bit_cast(float, b << 16); }
__device__ __forceinline__ float bflo(unsigned w) { return __builtin_bit_cast(float, w << 16); }
__device__ __forceinline__ float bfhi(unsigned w) { return __builtin_bit_cast(float, w & 0xffff0000u); }
typedef __bf16 bf16x2_t __attribute__((ext_vector_type(2)));
__device__ __forceinline__ unsigned cvt_pk_bf16(float lo, float hi) { const f32x2 v = {lo, hi}; return __builtin_bit_cast(unsigned, __builtin_convertvector(v, bf16x2_t)); }
__device__ __forceinline__ unsigned pk4_fp8(float a, float b, float c, float d) {
    a = __builtin_amdgcn_fmed3f(a, -448.f, 448.f); b = __builtin_amdgcn_fmed3f(b, -448.f, 448.f); c = __builtin_amdgcn_fmed3f(c, -448.f, 448.f); d = __builtin_amdgcn_fmed3f(d, -448.f, 448.f);
    int w = 0; w = __builtin_amdgcn_cvt_pk_fp8_f32(a, b, w, false); w = __builtin_amdgcn_cvt_pk_fp8_f32(c, d, w, true); return (unsigned)w;
}
__device__ __forceinline__ f32x2 swiglu2(f32x2 g, f32x2 u, float nrs, float c) {
    const f32x2 t = g * nrs;
    f32x2 d = {__builtin_amdgcn_exp2f(t[0]), __builtin_amdgcn_exp2f(t[1])};
    d = d + 1.0f;
    const f32x2 r = {__builtin_amdgcn_rcpf(d[0]), __builtin_amdgcn_rcpf(d[1])};
    return (g * u) * (r * c);
}
constexpr float F8_SW_UP = 64.f, F8_SH = 4.f, F8_SW_DN = 128.f;
__device__ __forceinline__ float wave_sum(float v) {
#pragma unroll
    for (int o = 1; o < 64; o <<= 1) v += __shfl_xor(v, o);
    return v;
}
__device__ __forceinline__ float sigmoidf_(float z) { return __builtin_amdgcn_rcpf(1.0f + __expf(-z)); }
__device__ __forceinline__ float siluf_(float z) { return z * __builtin_amdgcn_rcpf(1.0f + __expf(-z)); }
__device__ __forceinline__ float gelu_tanh(float y) { const float z = 0.7978845608028654f * (y + 0.044715f * y * y * y); return y * __builtin_amdgcn_rcpf(1.0f + __expf(-2.0f * z)); }

#define XB_TMO      128
#define XB_XCNT(j)  (256  + 64 * (j))
#define XB_XSUB(j)  (1280 + 64 * (j))
#define XB_XGEN(j)  (2304 + 64 * (j))
#define XB_TOP      3328
#define XB_TOPGEN   3392
#define XCD_BAR_WORDS 3456
#define XB_SPIN_CAP (1u << 18)
__device__ __forceinline__ unsigned xb_ld(unsigned* p)              { return __hip_atomic_load(p, __ATOMIC_RELAXED, __HIP_MEMORY_SCOPE_AGENT); }
__device__ __forceinline__ unsigned xb_add(unsigned* p, unsigned v) { return __hip_atomic_fetch_add(p, v, __ATOMIC_RELAXED, __HIP_MEMORY_SCOPE_AGENT); }
__device__ __forceinline__ unsigned xb_xcc_id() { return (unsigned)__builtin_amdgcn_s_getreg((3 << 11) | 20) & 0xFu; }
#define XB_SPIN(cond, bar) do { unsigned _sp = 0; while (cond) { __builtin_amdgcn_s_sleep(1); \
    if ((++_sp & 255u) == 0u) { if (xb_ld(&(bar)[XB_TMO])) break; if (_sp > XB_SPIN_CAP) { atomicAdd(&(bar)[XB_TMO], 1u); break; } } } } while (0)
struct XcdBarrier { unsigned* bar; unsigned x; volatile LAS unsigned* st; };
__device__ __forceinline__ XcdBarrier xcd_barrier_post(unsigned* bar, volatile LAS unsigned* st) {
    XcdBarrier b; b.bar = bar; b.x = xb_xcc_id(); b.st = st;
    if (threadIdx.x == 0) (void)xb_add(&bar[XB_XCNT(b.x)], 1u);
    return b;
}
__device__ __forceinline__ void xcd_barrier_complete(unsigned* bar, unsigned x, unsigned& nloc, unsigned& nx) {
    const unsigned G = gridDim.x * gridDim.y * gridDim.z;
    unsigned sum, cnt, mine, sp = 0u;
    for (;;) {
        sum = 0u; cnt = 0u; mine = 0u;
#pragma unroll
        for (unsigned j = 0; j < 16; ++j) { const unsigned c = xb_ld(&bar[XB_XCNT(j)]); sum += c; cnt += (c > 0u) ? 1u : 0u; mine = (j == x) ? c : mine; }
        if (sum == G) break;
        __builtin_amdgcn_s_sleep(1);
        if ((++sp & 255u) == 0u) { if (xb_ld(&bar[XB_TMO])) break; if (sp > XB_SPIN_CAP) { atomicAdd(&bar[XB_TMO], 1u); break; } }
    }
    nloc = mine > 0u ? mine : 1u; nx = cnt > 0u ? cnt : 1u;
}
__device__ __forceinline__ void xcd_barrier(const XcdBarrier& b) {
    asm volatile("s_waitcnt vmcnt(0)" ::: "memory");
    __syncthreads();
    if (threadIdx.x == 0) {
        unsigned* bar = b.bar;
        __builtin_amdgcn_s_waitcnt(0);
        unsigned nloc = b.st[0], nx = b.st[1];
        if (nloc == 0u) { xcd_barrier_complete(bar, b.x, nloc, nx); b.st[0] = nloc; b.st[1] = nx; }
        const unsigned old = xb_add(&bar[XB_XSUB(b.x)], 1u);
        const unsigned gen = old / nloc;
        if (old + 1u == (gen + 1u) * nloc) {
            __builtin_amdgcn_fence(__ATOMIC_RELEASE, "agent");
            asm volatile("s_waitcnt vmcnt(0)" ::: "memory");
            const unsigned og = xb_add(&bar[XB_TOP], 1u);
            const unsigned tg = og / nx;
            if (og + 1u == (tg + 1u) * nx) xb_add(&bar[XB_TOPGEN], 1u);
            else XB_SPIN(xb_ld(&bar[XB_TOPGEN]) == tg, bar);
            __builtin_amdgcn_fence(__ATOMIC_ACQUIRE, "agent");
            xb_add(&bar[XB_XGEN(b.x)], 1u);
            asm volatile("s_waitcnt vmcnt(0)" ::: "memory");
        } else {
            XB_SPIN(xb_ld(&bar[XB_XGEN(b.x)]) == gen, bar);
            __builtin_amdgcn_fence(__ATOMIC_ACQUIRE, "agent");
            asm volatile("s_waitcnt vmcnt(0)" ::: "memory");
        }
    }
    __syncthreads();
}

namespace pg8 {
constexpr int BM = 256, BK = 64, HALF = 128, HTB = HALF * BK * 2, STAGE_BYTES = 8 * HTB, NXCD = 8, WGM = 8;
constexpr int A_TAB_OFF = 131072 + 8192;
constexpr int EPI_TAB_OFF = 131072 + 4096;
__host__ __device__ __forceinline__ int lds_byte(int r, int c) { const int st = (r >> 4) * 2 + (c >> 5), rr = r & 15, cc = c & 31, ob = rr * 64 + cc * 2; return st * 1024 + (ob ^ (((ob >> 9) & 1) << 5)); }
__host__ __device__ __forceinline__ void stage_rc(int b, int& R, int& C) { const int st = b / 1024, sb = b % 1024, swz = sb ^ (((sb >> 9) & 1) << 5); R = (st >> 1) * 16 + swz / 64; C = (st & 1) * 32 + (swz % 64) / 2; }
__host__ __device__ __forceinline__ int perm32(int rho) { const int n = rho >> 4, i = rho & 15; return 8 * (i >> 2) + 4 * n + (i & 3); }

struct Unit { int pm, pn, e, sub; };

struct StaticOrder {
    int nM, nN, nwg, G, c;
    __device__ __forceinline__ void init(int nM_, int nN_, int G_, int c_) { nM = nM_; nN = nN_; nwg = nM * nN; G = G_; c = c_; }
    __device__ __forceinline__ bool next(int i, Unit& u) const {
        const long L = (long)i * G + c; if (L >= nwg) return false;
        int wgid = (int)L; { const int q = nwg / NXCD, r = nwg % NXCD, xcd = wgid % NXCD, off = wgid / NXCD; wgid = (xcd < r ? xcd * (q + 1) : r * (q + 1) + (xcd - r) * q) + off; }
        const int nig = WGM * nN, gid = wgid / nig, fm = gid * WGM, gsz = (nM - fm) < WGM ? (nM - fm) : WGM;
        u.pm = fm + ((wgid % nig) % gsz); u.pn = (wgid % nig) / gsz; u.e = 0; u.sub = 0; return true;
    }
};

template <class Epi, class Sched, class Prob>
__device__ __forceinline__ void gemm_phase(LAS unsigned char* lds, const Prob& P, const Sched& S, const Epi& E) {
    int tid_ = threadIdx.x; asm volatile("" : "+v"(tid_));
    const int tid = tid_, wid = __builtin_amdgcn_readfirstlane(tid >> 6), lane = tid & 63, wr = wid >> 2, wc = wid & 3, fr = lane & 15, fq = lane >> 4;
    const int K = P.K, nt = K / BK;
    int Rr[2], Cc[2]; unsigned voffB[2];
#pragma unroll
    for (int i = 0; i < 2; ++i) { int R, C; stage_rc(tid * 16 + i * 8192, R, C); Rr[i] = R; Cc[i] = C; const int Rb = (R & ~31) + perm32(R & 31); voffB[i] = (unsigned)(Rb * P.ldb + C) * 2u; }
    const size_t kstep = (size_t)(BK * 2);
    const size_t hstepB = (size_t)HALF * P.ldb * 2;
    const unsigned ldsw = (unsigned)wid * 1024u;
    const int aoff = lds_byte(wr * 64 + fr, fq * 8), boff = lds_byte(wc * 32 + fr, fq * 8);
#define PG8_SA(b, h) (((b) * 2 + (h)) * HTB)
#define PG8_SB(b, h) ((4 + (b) * 2 + (h)) * HTB)
#define PG8_STAGE(bufoff, gbase, voff) do { _Pragma("unroll") for (int _i = 0; _i < 2; ++_i) \
        __builtin_amdgcn_global_load_lds((const unsigned*)((const char*)(gbase) + (voff)[_i]), (LAS unsigned*)(lds + (bufoff) + ldsw + _i * 8192), 16, 0, 0); } while (0)
#define PG8_LDA(dst, b, h) do { _Pragma("unroll") for (int m = 0; m < 4; ++m) _Pragma("unroll") for (int k = 0; k < 2; ++k) dst[m][k] = *(const LAS bf16x8*)(lds + PG8_SA(b, h) + aoff + m * 2048 + k * 1024); } while (0)
#define PG8_LDB(dst, b, h) do { _Pragma("unroll") for (int n = 0; n < 2; ++n) _Pragma("unroll") for (int k = 0; k < 2; ++k) dst[n][k] = *(const LAS bf16x8*)(lds + PG8_SB(b, h) + boff + n * 2048 + k * 1024); } while (0)
#define PG8_CAT(x) __builtin_shufflevector(__builtin_bit_cast(i32x4_t, (x)[0]), __builtin_bit_cast(i32x4_t, (x)[1]), 0, 1, 2, 3, 4, 5, 6, 7)
#define PG8_MMA(ai, bj, At, Bt) do { __builtin_amdgcn_s_setprio(1); _Pragma("unroll") for (int m = 0; m < 4; ++m) _Pragma("unroll") for (int n = 0; n < 2; ++n) { \
        if constexpr (Prob::F8) asm volatile("v_mfma_scale_f32_16x16x128_f8f6f4 %0, %1, %2, %0, %3, %3 op_sel_hi:[0,0,0]" : "+v"(acc[ai][bj][m][n]) : "v"(PG8_CAT(Bt[n])), "v"(PG8_CAT(At[m])), "v"(f8one)); \
        else { _Pragma("unroll") for (int k = 0; k < 2; ++k) acc[ai][bj][m][n] = __builtin_amdgcn_mfma_f32_16x16x32_bf16(Bt[n][k], At[m][k], acc[ai][bj][m][n], 0, 0, 0); } } \
        __builtin_amdgcn_s_setprio(0); } while (0)
#define PG8_WAIT_V(n) asm volatile("s_waitcnt vmcnt(" #n ")" ::: "memory")
#define PG8_WAIT_L(n) asm volatile("s_waitcnt lgkmcnt(" #n ")" ::: "memory")
#define PG8_BAR __builtin_amdgcn_s_barrier()
#define PG8_SCHED __builtin_amdgcn_sched_barrier(0)
    const int f8one = 0x7f7f7f7f;
    Unit cur, nxt; int ui = 0;
    if (!S.next(0, cur)) return;
    f32x4 acc[2][2][4][2];
#pragma unroll
    for (int a = 0; a < 2; ++a)
#pragma unroll
        for (int b = 0; b < 2; ++b)
#pragma unroll
            for (int m = 0; m < 4; ++m)
#pragma unroll
                for (int n = 0; n < 2; ++n) acc[a][b][m][n] = (f32x4){0.f, 0.f, 0.f, 0.f};
    bf16x8 At[4][2], B0[2][2], B1[2][2];
    constexpr bool GA = Prob::GATHER;
    constexpr int NH = GA ? 2 : 1;
    unsigned vA[NH][2], nvA[NH][2];
    const size_t hstepA = GA ? (size_t)0 : P.hstep_a();
    const size_t kstepA = P.kstep_a();
    P.a_off(cur, Rr, Cc, vA);
    const char* cA = P.a_ptr(cur); const char* cB = P.b_ptr(cur);
#define PG8_STAGEA(bufoff, gbase, h, arr) do { _Pragma("unroll") for (int _i = 0; _i < 2; ++_i) \
        __builtin_amdgcn_global_load_lds((const unsigned*)((const char*)(gbase) + (GA ? (size_t)0 : (size_t)(h) * hstepA) + (arr)[GA ? (h) : 0][_i]), (LAS unsigned*)(lds + (bufoff) + ldsw + _i * 8192), 16, 0, 0); } while (0)
    if constexpr (GA) { Unit u1; if (S.next(1, u1)) P.atab_issue(u1, lds + A_TAB_OFF + 1024, wid, lane); }
    PG8_STAGE(PG8_SB(0, 0), cB, voffB); PG8_STAGE(PG8_SB(0, 1), cB + hstepB, voffB); PG8_STAGEA(PG8_SA(0, 0), cA, 0, vA); PG8_STAGEA(PG8_SA(0, 1), cA, 1, vA);
    if (wr == 1) PG8_BAR;
    PG8_WAIT_V(2); PG8_BAR;
    PG8_STAGE(PG8_SB(1, 0), cB + kstep, voffB); PG8_STAGEA(PG8_SA(1, 0), cA + kstepA, 0, vA); PG8_STAGE(PG8_SB(1, 1), cB + hstepB + kstep, voffB);
    PG8_WAIT_V(6); PG8_BAR;
    for (;;) {
        const bool has_next = S.next(ui + 1, nxt);
        const char* nA = has_next ? P.a_ptr(nxt) : cA; const char* nB = has_next ? P.b_ptr(nxt) : cB;
        if constexpr (GA) {
            if (has_next) { int R2[2], C2[2], t2 = tid; asm volatile("" : "+v"(t2));
#pragma unroll
                for (int i = 0; i < 2; ++i) stage_rc(t2 * 16 + i * 8192, R2[i], C2[i]);
                P.a_off_tab(lds + A_TAB_OFF + ((ui + 1) & 1) * 1024, R2, C2, nvA);
                Unit n2; if (S.next(ui + 2, n2)) P.atab_issue(n2, lds + A_TAB_OFF + (ui & 1) * 1024, wid, lane); }
            else {
#pragma unroll
                for (int h = 0; h < NH; ++h)
#pragma unroll
                    for (int i = 0; i < 2; ++i) nvA[h][i] = vA[h][i];
            }
        }
        if constexpr (Epi::HAS_TAB) E.tab_issue(cur, lds + EPI_TAB_OFF + (ui & 1) * 2048, wid, lane);
        for (int t = 0; t < nt; t += 2) {
            const bool last = (t == nt - 2);
            const char* a1 = cA + (size_t)(t + 1) * kstepA;
            const char* a2 = last ? nA : cA + (size_t)(t + 2) * kstepA; const char* b2 = last ? nB : cB + (size_t)(t + 2) * kstep;
            const char* a3 = a2 + kstepA; const char* b3 = b2 + kstep;
            unsigned wA[NH][2];
#pragma unroll
            for (int h = 0; h < NH; ++h)
#pragma unroll
                for (int i = 0; i < 2; ++i) wA[h][i] = (GA && last) ? nvA[h][i] : vA[h][i];
            PG8_LDB(B0, 0, 0); PG8_LDB(B1, 0, 1); PG8_SCHED; PG8_LDA(At, 0, 0); PG8_STAGEA(PG8_SA(1, 1), a1, 1, vA);
            PG8_WAIT_V(8); PG8_WAIT_L(0); PG8_BAR; PG8_MMA(0, 0, At, B0); PG8_MMA(0, 1, At, B1); PG8_BAR; PG8_SCHED;
            PG8_LDA(At, 0, 1); PG8_STAGE(PG8_SB(0, 0), b2, voffB); PG8_STAGE(PG8_SB(0, 1), b2 + hstepB, voffB); PG8_STAGEA(PG8_SA(0, 0), a2, 0, wA);
            PG8_WAIT_V(8); PG8_WAIT_L(0); PG8_BAR; PG8_MMA(1, 0, At, B0); PG8_MMA(1, 1, At, B1); PG8_BAR; PG8_SCHED;
            PG8_LDB(B0, 1, 0); PG8_LDB(B1, 1, 1); PG8_SCHED; PG8_LDA(At, 1, 0); PG8_STAGEA(PG8_SA(0, 1), a2, 1, wA);
            PG8_WAIT_V(8); PG8_WAIT_L(0); PG8_BAR; PG8_MMA(0, 0, At, B0); PG8_MMA(0, 1, At, B1); PG8_BAR; PG8_SCHED;
            PG8_LDA(At, 1, 1); PG8_STAGE(PG8_SB(1, 0), b3, voffB); PG8_STAGE(PG8_SB(1, 1), b3 + hstepB, voffB); PG8_STAGEA(PG8_SA(1, 0), a3, 0, wA);
            PG8_WAIT_V(8); PG8_WAIT_L(0); PG8_BAR; PG8_MMA(1, 0, At, B0); PG8_MMA(1, 1, At, B1); PG8_BAR; PG8_SCHED;
        }
        if (wr == 0) PG8_BAR;
        if constexpr (Prob::F8) asm volatile("s_nop 15\n\ts_nop 7" ::: "memory");
        if constexpr (Epi::HAS_TAB) E(acc, cur, wr, wc, fr, fq, lds + EPI_TAB_OFF + (ui & 1) * 2048);
        else E(acc, cur, wr, wc, fr, fq);
        if (!has_next) break;
#pragma unroll
        for (int a = 0; a < 2; ++a)
#pragma unroll
            for (int b = 0; b < 2; ++b)
#pragma unroll
                for (int m = 0; m < 4; ++m)
#pragma unroll
                    for (int n = 0; n < 2; ++n) acc[a][b][m][n] = (f32x4){0.f, 0.f, 0.f, 0.f};
        cur = nxt; cA = nA; cB = nB; ++ui;
        if constexpr (GA) {
#pragma unroll
            for (int h = 0; h < NH; ++h)
#pragma unroll
                for (int i = 0; i < 2; ++i) vA[h][i] = nvA[h][i];
        }
        if (wr == 1) PG8_BAR;
    }
    PG8_WAIT_V(0);
    PG8_BAR;
#undef PG8_SA
#undef PG8_SB
#undef PG8_STAGE
#undef PG8_STAGEA
#undef PG8_LDA
#undef PG8_LDB
#undef PG8_MMA
#undef PG8_CAT
#undef PG8_WAIT_V
#undef PG8_WAIT_L
#undef PG8_BAR
#undef PG8_SCHED
}

template <bool F8_ = false, bool TILED_ = false> struct ProbPlainT {
    static constexpr bool GATHER = false, F8 = F8_;
    const bf16* A; const bf16* Bt; int lda, ldb, K;
    __device__ __forceinline__ const char* a_ptr(const Unit& u) const { return TILED_ ? (const char*)A + (size_t)u.pm * (K / BK) * 32768 : (const char*)(A + (size_t)u.pm * BM * lda); }
    __device__ __forceinline__ const char* b_ptr(const Unit& u) const { return (const char*)(Bt + (size_t)u.pn * BM * ldb); }
    __device__ __forceinline__ size_t hstep_a() const { return TILED_ ? (size_t)4096 : (size_t)HALF * lda * 2; }
    __device__ __forceinline__ size_t kstep_a() const { return TILED_ ? (size_t)32768 : (size_t)(BK * 2); }
    __device__ __forceinline__ void a_off(const Unit&, const int (&R)[2], const int (&C)[2], unsigned (&off)[1][2]) const {
#pragma unroll
        for (int i = 0; i < 2; ++i) {
            if (TILED_) { const int wr = R[i] >> 6, m = (R[i] >> 4) & 3, fr = R[i] & 15, cb = 2 * C[i]; off[0][i] = (unsigned)((((wr * 2 + (cb >> 6)) * 2) * 4 + m) * 1024 + fr * 64 + (cb & 63)); }
            else off[0][i] = (unsigned)(R[i] * lda + C[i]) * 2u;
        }
    }
};
typedef ProbPlainT<false> ProbPlain;
}

struct Args { const float* in[27]; float* out; unsigned char* ws; int ph_lo, ph_hi; };
struct Frame {
    LAS unsigned char* lds;
    int tid, lane, wave, G, bid;
    const float* const* in; unsigned char* ws; unsigned char* dout;
};
template <class T> __device__ __forceinline__ T* wsp(const Frame& F, size_t off) { return (T*)(F.ws + off); }
__device__ __forceinline__ Frame launder(const Frame& F0) {
    Frame F = F0; int t = F0.tid; asm volatile("" : "+v"(t)); F.tid = t; F.lane = t & 63; F.wave = __builtin_amdgcn_readfirstlane(t >> 6);
    int z = 0; asm volatile("" : "+s"(z));
    F.ws = F0.ws + z; F.dout = F0.dout + z; F.in = (const float* const*)((const char*)F0.in + z); return F;
}

__device__ __forceinline__ float row_rstd(const float* ssp, int r) {
    const f32x4* p = (const f32x4*)(ssp + (size_t)r * 16);
    const f32x4 a = p[0], b = p[1], c = p[2], d = p[3];
    const float s = ((a[0] + a[1]) + (a[2] + a[3])) + ((b[0] + b[1]) + (b[2] + b[3])) + ((c[0] + c[1]) + (c[2] + c[3])) + ((d[0] + d[1]) + (d[2] + d[3]));
    return rsqrtf(s * (1.0f / D) + EPS);
}

typedef pg8::Unit Unit;
struct EpiInproj {
    static constexpr bool HAS_TAB = false;
    const float* ssp; unsigned char* act;
    __device__ __forceinline__ void operator()(const f32x4 (&acc)[2][2][4][2], const Unit& u, int wr, int wc, int fr, int fq) const {
        static_assert(WS_UGM == WS_ACT && WS_Q == WS_ACT + 32 * MiB && WS_K == WS_ACT + 48 * MiB && WS_V == WS_ACT + 64 * MiB && WS_R == WS_ACT + 96 * MiB, "in-proj destination arithmetic");
        const unsigned pn = (unsigned)u.pn;
        const bool isu = pn < 2u;
        bf16* const base = (bf16*)(act + (size_t)((0x66443200u >> (4u * pn)) & 15u) * (16 * MiB));
        const unsigned stride = 512u >> ((0x0Cu >> pn) & 1u);
        const unsigned cb = ((pn >> 2) & pn & 1u) * 256u;
#pragma unroll
        for (int ai = 0; ai < 2; ++ai) {
            float rs4[4];
#pragma unroll
            for (int m = 0; m < 4; ++m) rs4[m] = row_rstd(ssp, u.pm * 256 + ai * 128 + wr * 64 + m * 16 + fr);
            CFENCE();
#pragma unroll
            for (int m = 0; m < 4; ++m) {
                const unsigned row = (unsigned)(u.pm * 256 + ai * 128 + wr * 64 + m * 16 + fr);
                const float rs = rs4[m];
                const unsigned ro = isu ? ((row >> 12) * 2097152u + (row & 4095u) * 16u) : row * stride;
#pragma unroll
                for (int bj = 0; bj < 2; ++bj) {
                    const unsigned cl = (unsigned)(bj * 128 + wc * 32 + 8 * fq);
                    f32x4 v0 = acc[ai][bj][m][0] * rs, v1 = acc[ai][bj][m][1] * rs;
                    const unsigned co = isu ? ((pn * 256u + cl) >> 4) * 65536u + ((cl >> 3) & 1u) * 8u : cb + cl;
                    u32x4 w; w.x = cvt_pk_bf16(v0[0], v0[1]); w.y = cvt_pk_bf16(v0[2], v0[3]); w.z = cvt_pk_bf16(v1[0], v1[1]); w.w = cvt_pk_bf16(v1[2], v1[3]);
                    *(u32x4*)(base + (size_t)(ro + co)) = w;
                }
            }
            CFENCE();
        }
    }
};
struct EpiGlu {
    static constexpr bool HAS_TAB = false;
    const bf16* ys5; bf16* yglu; const float* bglu;
    __device__ __forceinline__ void operator()(const f32x4 (&acc)[2][2][4][2], const Unit& u, int wr, int wc, int fr, int fq) const {
        const int colb = u.pn * 256 + wc * 32 + 8 * fq;
        const bf16* src = ys5 + (size_t)(u.pm * 256 + wr * 64 + fr) * 512 + colb;
        u32x4 nx[2] = {*(const u32x4*)src, *(const u32x4*)(src + 128)};
#pragma unroll
        for (int g = 0; g < 8; ++g) {
            const int ai = g >> 2, m = g & 3;
            const u32x4 a2[2] = {nx[0], nx[1]};
            if (g < 7) { const int g1 = g + 1; const bf16* s1 = src + (size_t)((g1 >> 2) * 128 + (g1 & 3) * 16) * 512; nx[0] = *(const u32x4*)s1; nx[1] = *(const u32x4*)(s1 + 128); }
            CFENCE();
            const int row = u.pm * 256 + ai * 128 + wr * 64 + m * 16 + fr;
#pragma unroll
            for (int bj = 0; bj < 2; ++bj) {
                const int col = colb + bj * 128;
                const u32x4 a = a2[bj];
                const f32x4 b0 = *(const f32x4*)(bglu + col), b1 = *(const f32x4*)(bglu + col + 4);
                const f32x4 v0 = acc[ai][bj][m][0] + b0, v1 = acc[ai][bj][m][1] + b1;
                u32x4 w;
                w.x = cvt_pk_bf16(bflo(a.x) * sigmoidf_(v0[0]), bfhi(a.x) * sigmoidf_(v0[1]));
                w.y = cvt_pk_bf16(bflo(a.y) * sigmoidf_(v0[2]), bfhi(a.y) * sigmoidf_(v0[3]));
                w.z = cvt_pk_bf16(bflo(a.z) * sigmoidf_(v1[0]), bfhi(a.z) * sigmoidf_(v1[1]));
                w.w = cvt_pk_bf16(bflo(a.w) * sigmoidf_(v1[2]), bfhi(a.w) * sigmoidf_(v1[3]));
                *(u32x4*)(yglu + (size_t)row * 512 + col) = w;
            }
        }
        CFENCE();
    }
};
struct EpiResid {
    static constexpr bool HAS_TAB = false;
    bf16* xb; float* ssp; bf16* dst; bool wr_ssp;
    unsigned char* x8;
    float ascale;
    __device__ __forceinline__ void operator()(const f32x4 (&acc)[2][2][4][2], const Unit& u, int wr, int wc, int fr, int fq) const {
        const int colb = u.pn * 256 + wc * 32 + 8 * fq;
        const bf16* src = xb + (size_t)(u.pm * 256 + wr * 64 + fr) * D + colb;
        u32x4 nx[2] = {*(const u32x4*)src, *(const u32x4*)(src + 128)};
#pragma unroll
        for (int g = 0; g < 8; ++g) {
            const int ai = g >> 2, m = g & 3;
            const u32x4 a2[2] = {nx[0], nx[1]};
            if (g < 7) { const int g1 = g + 1; const bf16* s1 = src + (size_t)((g1 >> 2) * 128 + (g1 & 3) * 16) * D; nx[0] = *(const u32x4*)s1; nx[1] = *(const u32x4*)(s1 + 128); }
            CFENCE();
            const int row = u.pm * 256 + ai * 128 + wr * 64 + m * 16 + fr;
            float ss = 0.f;
#pragma unroll
            for (int bj = 0; bj < 2; ++bj) {
                const int col = colb + bj * 128;
                const u32x4 a = a2[bj];
                const f32x4 v0 = acc[ai][bj][m][0] * ascale + (f32x4){bflo(a.x), bfhi(a.x), bflo(a.y), bfhi(a.y)};
                const f32x4 v1 = acc[ai][bj][m][1] * ascale + (f32x4){bflo(a.z), bfhi(a.z), bflo(a.w), bfhi(a.w)};
                ss += (v0[0] * v0[0] + v0[1] * v0[1]) + (v0[2] * v0[2] + v0[3] * v0[3]) + (v1[0] * v1[0] + v1[1] * v1[1]) + (v1[2] * v1[2] + v1[3] * v1[3]);
                u32x4 w; w.x = cvt_pk_bf16(v0[0], v0[1]); w.y = cvt_pk_bf16(v0[2], v0[3]); w.z = cvt_pk_bf16(v1[0], v1[1]); w.w = cvt_pk_bf16(v1[2], v1[3]);
                *(u32x4*)(dst + (size_t)row * D + col) = w;
                if (x8) { u32x2 q; q.x = pk4_fp8(v0[0], v0[1], v0[2], v0[3]); q.y = pk4_fp8(v1[0], v1[1], v1[2], v1[3]); *(u32x2*)(x8 + (size_t)row * D + col) = q; }
            }
            ss += __shfl_xor(ss, 16); ss += __shfl_xor(ss, 32);
            if (fq == 0 && wr_ssp) ssp[(size_t)row * 16 + u.pn * 4 + wc] = ss;
        }
        CFENCE();
    }
};
template <bool F8> struct EpiSwigluT {
    static constexpr bool HAS_TAB = false;
    const float* ssp; bf16* h; int ldh;
    __device__ __forceinline__ void operator()(const f32x4 (&acc)[2][2][4][2], const Unit& u, int wr, int wc, int fr, int fq) const {
#pragma unroll
        for (int ai = 0; ai < 2; ++ai) {
            float rs4[4];
#pragma unroll
            for (int m = 0; m < 4; ++m) rs4[m] = row_rstd(ssp, u.pm * 256 + ai * 128 + wr * 64 + m * 16 + fr);
            CFENCE();
#pragma unroll
            for (int m = 0; m < 4; ++m) {
                const int row = u.pm * 256 + ai * 128 + wr * 64 + m * 16 + fr;
                const float rs = rs4[m] * (F8 ? 1.0f / F8_SW_UP : 1.0f);
                const float hs = F8 ? F8_SH : 1.0f, nrs = rs * -1.4426950408889634f, cc = rs * rs * hs;
                const f32x4 ga = acc[ai][0][m][0], gb = acc[ai][0][m][1], ua = acc[ai][1][m][0], ub = acc[ai][1][m][1];
                const f32x2 p0 = swiglu2((f32x2){ga[0], ga[1]}, (f32x2){ua[0], ua[1]}, nrs, cc), p1 = swiglu2((f32x2){ga[2], ga[3]}, (f32x2){ua[2], ua[3]}, nrs, cc);
                const f32x2 p2 = swiglu2((f32x2){gb[0], gb[1]}, (f32x2){ub[0], ub[1]}, nrs, cc), p3 = swiglu2((f32x2){gb[2], gb[3]}, (f32x2){ub[2], ub[3]}, nrs, cc);
                const f32x4 h0 = {p0[0], p0[1], p1[0], p1[1]}, h1 = {p2[0], p2[1], p3[0], p3[1]};
                const int col = u.pn * 128 + wc * 32 + 8 * fq;
                static_assert(!F8, "the dense tile-major hidden layout is written for bf16");
                const size_t to = ((size_t)u.pm * (2 * ldh / 128) + 2 * u.pn + (wc >> 1)) * 32768 + (size_t)(((((wr * 2 + (wc & 1)) * 2 + ai) * 4 + m) * 1024) + fr * 64 + 16 * fq);
                if constexpr (F8) { u32x2 q; q.x = pk4_fp8(h0[0], h0[1], h0[2], h0[3]); q.y = pk4_fp8(h1[0], h1[1], h1[2], h1[3]); *(u32x2*)((unsigned char*)h + (size_t)row * ldh + col) = q; }
                else { u32x4 w; w.x = cvt_pk_bf16(h0[0], h0[1]); w.y = cvt_pk_bf16(h0[2], h0[3]); w.z = cvt_pk_bf16(h1[0], h1[1]); w.w = cvt_pk_bf16(h1[2], h1[3]); *(u32x4*)((unsigned char*)h + to) = w; }
            }
            CFENCE();
        }
    }
};

struct MoeTab { LAS int* cnt; LAS int* cb; LAS short* tl_list; LAS short* tl_sub; };
__device__ __forceinline__ MoeTab moe_tab(const Frame& F) {
    MoeTab T; T.cnt = (LAS int*)(F.lds + MOE_TAB_OFF); T.cb = T.cnt + 16; T.tl_list = (LAS short*)(T.cb + 8); T.tl_sub = T.tl_list + 288; return T;
}
__device__ __forceinline__ void moe_build_tables(const Frame& F) {
    MoeTab T = moe_tab(F);
    if (F.tid < 16) { const unsigned* gc = wsp<unsigned>(F, WS_CTL) + CW_CNT; int c = (int)__hip_atomic_load(gc + F.tid, __ATOMIC_RELAXED, __HIP_MEMORY_SCOPE_AGENT); if (c > 32768) c = 32768; T.cnt[F.tid] = c; }
    __syncthreads();
    if (F.tid < 16) {
        int tot = 0;
#pragma unroll 1
        for (int l = 0; l < F.tid; ++l) tot += (T.cnt[l] + 255) >> 8;
        const int nt_ = (T.cnt[F.tid] + 255) >> 8;
#pragma unroll 1
        for (int s = 0; s < nt_; ++s) { T.tl_list[tot + s] = (short)F.tid; T.tl_sub[tot + s] = (short)s; }
    }
    if (F.tid == 0) {
        int tr0 = 0, tr1 = 0;
#pragma unroll 1
        for (int l = 0; l < 16; ++l) { const int nt_ = (T.cnt[l] + 255) >> 8; if (l < 8) tr0 += nt_; else tr1 += nt_; }
        const int c0 = (tr0 > 64 + MOE_CAP_TILES) ? tr0 - MOE_CAP_TILES : (tr0 < 64 ? tr0 : 64);
        const int c3 = (tr1 > 64 + MOE_CAP_TILES) ? tr1 - MOE_CAP_TILES : (tr1 < 64 ? tr1 : 64);
        T.cb[0] = 0; T.cb[1] = c0; T.cb[2] = tr0; T.cb[3] = tr0 + tr1 - c3; T.cb[4] = tr0 + tr1;
    }
    __syncthreads();
}
struct MoeOrder {
    MoeTab T; int t0, ntile, nN, lo, nloc, j, nbx, nheavy, skip;
    __device__ __forceinline__ void init(const MoeTab& T_, int chunk, int nN_, int G, int bid, int nheavy_, int skip_) {
        T = T_; t0 = T.cb[chunk]; ntile = T.cb[chunk + 1] - t0; nN = nN_;
        const int total = ntile * nN, x = bid & 7, q = total >> 3, r = total & 7;
        lo = (x < r) ? x * (q + 1) : r * (q + 1) + (x - r) * q; nloc = q + (x < r ? 1 : 0);
        j = bid >> 3; nbx = (G - x + 7) >> 3; nheavy = nheavy_; skip = skip_;
    }
    __device__ __forceinline__ int nheavy_next() const { return nloc % nbx; }
    __device__ __forceinline__ bool next(int i, Unit& u) const {
        int k;
        if (j < nheavy) k = skip * (nbx - nheavy) + i * nbx + j;
        else k = (i < skip) ? i * (nbx - nheavy) + (j - nheavy) : skip * (nbx - nheavy) + (i - skip) * nbx + j;
        if (k >= nloc) return false;
        const int idx = lo + k, nig = 8 * nN, gid = idx / nig, fm = gid * 8, gsz = (ntile - fm) < 8 ? (ntile - fm) : 8, w = idx - gid * nig;
        const int tl = fm + w % gsz; u.pm = tl; u.pn = w / gsz; u.e = T.tl_list[t0 + tl]; u.sub = T.tl_sub[t0 + tl]; return true;
    }
};
constexpr int MOE_ESZ = USE_F8_MOE ? 1 : 2;
struct ProbMoeUp {
    static constexpr bool GATHER = true, F8 = USE_F8_MOE != 0;
    const void* xa; const void* wgu; const int* tok; MoeTab T; int lda, ldb, K;
    __device__ __forceinline__ const char* a_ptr(const Unit&) const { return (const char*)xa; }
    __device__ __forceinline__ size_t hstep_a() const { return 0; }
    __device__ __forceinline__ size_t kstep_a() const { return 128; }
    __device__ __forceinline__ const char* b_ptr(const Unit& u) const { return (const char*)wgu + ((size_t)(u.e & 7) * (2 * DFE) + (size_t)u.pn * 256) * D * MOE_ESZ; }
    __device__ __forceinline__ void a_off(const Unit& u, const int (&R)[2], const int (&C)[2], unsigned (&off)[2][2]) const {
        const int cnt = T.cnt[u.e];
#pragma unroll
        for (int h = 0; h < 2; ++h)
#pragma unroll
            for (int i = 0; i < 2; ++i) { const int p = u.sub * 256 + h * 128 + R[i]; const int t = (p < cnt) ? tok[u.e * 32768 + p] : 0; off[h][i] = (unsigned)(t * lda + C[i]) * 2u; }
    }
    __device__ __forceinline__ void atab_issue(const Unit& u, LAS unsigned char* tab, int wid, int lane) const {
        if (wid < 4) { const int cnt = T.cnt[u.e]; int p = u.sub * 256 + wid * 64 + lane; p = (p < cnt) ? p : 0;
            __builtin_amdgcn_global_load_lds((const unsigned*)(tok + u.e * 32768 + p), (LAS unsigned*)(tab + wid * 256), 4, 0, 0); }
    }
    __device__ __forceinline__ void a_off_tab(const LAS unsigned char* tab, const int (&R)[2], const int (&C)[2], unsigned (&off)[2][2]) const {
#pragma unroll
        for (int h = 0; h < 2; ++h)
#pragma unroll
            for (int i = 0; i < 2; ++i) { const int t = *(const LAS int*)(tab + (h * 128 + R[i]) * 4); off[h][i] = (unsigned)(t * lda + C[i]) * 2u; }
    }
};
struct ProbMoeDown {
    static constexpr bool GATHER = false, F8 = USE_F8_MOE != 0;
    const void* h; const void* wd; int lda, ldb, K;
    static constexpr bool TILED = USE_F8_MOE != 0;
    __device__ __forceinline__ const char* a_ptr(const Unit& u) const { return TILED ? (const char*)h + (size_t)u.pm * (DFE / 128) * 32768 : (const char*)h + (size_t)u.pm * 256 * DFE * MOE_ESZ; }
    __device__ __forceinline__ const char* b_ptr(const Unit& u) const { return (const char*)wd + ((size_t)(u.e & 7) * D + (size_t)u.pn * 256) * DFE * MOE_ESZ; }
    __device__ __forceinline__ size_t hstep_a() const { return TILED ? (size_t)2048 : (size_t)128 * lda * 2; }
    __device__ __forceinline__ size_t kstep_a() const { return TILED ? (size_t)32768 : (size_t)128; }
    __device__ __forceinline__ void a_off(const Unit&, const int (&R)[2], const int (&C)[2], unsigned (&off)[1][2]) const {
#pragma unroll
        for (int i = 0; i < 2; ++i) {
            if (TILED) { const int wr = R[i] >> 6, m = (R[i] >> 4) & 3, fr = R[i] & 15, cb = 2 * C[i]; off[0][i] = (unsigned)((((wr * 4 + (cb >> 5)) * 2) * 4 + m) * 512 + fr * 32 + (cb & 31)); }
            else off[0][i] = (unsigned)(R[i] * lda + C[i]) * 2u;
        }
    }
};
struct EpiSwigluMoe {
    static constexpr bool HAS_TAB = true;
    const float* rl; void* h; MoeTab T;
    __device__ __forceinline__ void tab_issue(const Unit& u, LAS unsigned char* tab, int wid, int lane) const {
        if (wid < 4) { const int cnt = T.cnt[u.e]; int p = u.sub * 256 + wid * 64 + lane; p = (p < cnt) ? p : 0;
            __builtin_amdgcn_global_load_lds((const unsigned*)(rl + u.e * 32768 + p), (LAS unsigned*)(tab + wid * 256), 4, 0, 0); }
    }
    __device__ __forceinline__ void operator()(const f32x4 (&acc)[2][2][4][2], const Unit& u, int wr, int wc, int fr, int fq, const LAS unsigned char* tab) const {
        constexpr bool F8 = USE_F8_MOE != 0;
        const int cnt = T.cnt[u.e];
        float rs8[8];
#pragma unroll
        for (int g = 0; g < 8; ++g) { const int rl_ = (g >> 2) * 128 + wr * 64 + (g & 3) * 16 + fr, p = u.sub * 256 + rl_; const float v = *(const LAS float*)(tab + rl_ * 4); rs8[g] = (p < cnt) ? v * (F8 ? 1.0f / F8_SW_UP : 1.0f) : 0.f; }
        CFENCE();
#pragma unroll
        for (int ai = 0; ai < 2; ++ai)
#pragma unroll
            for (int m = 0; m < 4; ++m) {
                const int rl_ = ai * 128 + wr * 64 + m * 16 + fr;
                const float rs = rs8[ai * 4 + m];
                const float hs = F8 ? F8_SH : 1.0f, nrs = rs * -1.4426950408889634f, cc = rs * rs * hs;
                const f32x4 ga = acc[ai][0][m][0], gb = acc[ai][0][m][1], ua = acc[ai][1][m][0], ub = acc[ai][1][m][1];
                const f32x2 p0 = swiglu2((f32x2){ga[0], ga[1]}, (f32x2){ua[0], ua[1]}, nrs, cc), p1 = swiglu2((f32x2){ga[2], ga[3]}, (f32x2){ua[2], ua[3]}, nrs, cc);
                const f32x2 p2 = swiglu2((f32x2){gb[0], gb[1]}, (f32x2){ub[0], ub[1]}, nrs, cc), p3 = swiglu2((f32x2){gb[2], gb[3]}, (f32x2){ub[2], ub[3]}, nrs, cc);
                const f32x4 h0 = {p0[0], p0[1], p1[0], p1[1]}, h1 = {p2[0], p2[1], p3[0], p3[1]};
                const size_t eo = F8 ? ((size_t)(u.pm * (DFE / 128) + u.pn) * 32768 + (size_t)((((wr * 4 + wc) * 2 + ai) * 4 + m) * 512 + fr * 32 + 8 * fq))
                                     : ((size_t)(u.pm * 256 + rl_) * DFE + u.pn * 128 + wc * 32 + 8 * fq);
                if constexpr (F8) { u32x2 q; q.x = pk4_fp8(h0[0], h0[1], h0[2], h0[3]); q.y = pk4_fp8(h1[0], h1[1], h1[2], h1[3]); *(u32x2*)((unsigned char*)h + eo) = q; }
                else { u32x4 w; w.x = cvt_pk_bf16(h0[0], h0[1]); w.y = cvt_pk_bf16(h0[2], h0[3]); w.z = cvt_pk_bf16(h1[0], h1[1]); w.w = cvt_pk_bf16(h1[2], h1[3]); *(u32x4*)((bf16*)h + eo) = w; }
            }
        CFENCE();
    }
};
struct EpiMoeDown {
    static constexpr bool HAS_TAB = false;
    const int* tok; const float* wl; const bf16* xb; bf16* xo; MoeTab T; bool dry;
    __device__ __forceinline__ void operator()(const f32x4 (&acc)[2][2][4][2], const Unit& u, int wr, int wc, int fr, int fq) const {
        const int cnt = T.cnt[u.e]; const bf16* src = (u.e < 8) ? xb : (const bf16*)xo;
        const int colb = u.pn * 256 + wc * 32 + 8 * fq;
        int t8[8]; float w8[8];
#pragma unroll
        for (int g = 0; g < 8; ++g) { const int p = u.sub * 256 + (g >> 2) * 128 + wr * 64 + (g & 3) * 16 + fr; const bool ok = p < cnt; const int pc = ok ? p : 0;
            const int t_ = tok[u.e * 32768 + pc]; const float w_ = wl[u.e * 32768 + pc];
            t8[g] = ok ? t_ : -1; w8[g] = ok ? w_ * (USE_F8_MOE ? 1.0f / (F8_SH * F8_SW_DN) : 1.0f) : 0.f; }
        CFENCE();
        u32x4 nx[2];
        { const bf16* s0 = src + (size_t)(t8[0] < 0 ? 0 : t8[0]) * D + colb; nx[0] = *(const u32x4*)s0; nx[1] = *(const u32x4*)(s0 + 128); }
#pragma unroll
        for (int g = 0; g < 8; ++g) {
            const int ai = g >> 2, m = g & 3;
            const u32x4 a2[2] = {nx[0], nx[1]};
            if (g < 7) { const bf16* s1 = src + (size_t)(t8[g + 1] < 0 ? 0 : t8[g + 1]) * D + colb; nx[0] = *(const u32x4*)s1; nx[1] = *(const u32x4*)(s1 + 128); }
            CFENCE();
            if (t8[g] >= 0) {
#pragma unroll
                for (int bj = 0; bj < 2; ++bj) {
                    const u32x4 a = a2[bj];
                    const f32x4 v0 = acc[ai][bj][m][0] * w8[g] + (f32x4){bflo(a.x), bfhi(a.x), bflo(a.y), bfhi(a.y)};
                    const f32x4 v1 = acc[ai][bj][m][1] * w8[g] + (f32x4){bflo(a.z), bfhi(a.z), bflo(a.w), bfhi(a.w)};
                    u32x4 w; w.x = cvt_pk_bf16(v0[0], v0[1]); w.y = cvt_pk_bf16(v0[2], v0[3]); w.z = cvt_pk_bf16(v1[0], v1[1]); w.w = cvt_pk_bf16(v1[2], v1[3]);
                    if (!dry) *(u32x4*)(xo + (size_t)t8[g] * D + colb + bj * 128) = w;
                }
            }
        }
        CFENCE();
    }
};

__device__ __forceinline__ void p0_tr_item(const float* src, int ldsrc, int ncol0, int k0, const float* gain, bf16* dst, int K, int drow0, LAS float* scr, int lane) {
    float gv[8]; f32x4 v8[8];
#pragma unroll
    for (int i = 0; i < 8; ++i) gv[i] = 1.0f;
    if (gain) {
#pragma unroll
        for (int i = 0; i < 8; ++i) gv[i] = gain[k0 + 8 * i + (lane >> 3)];
    }
#pragma unroll
    for (int i = 0; i < 8; ++i) v8[i] = *(const f32x4*)(src + (size_t)(k0 + 8 * i + (lane >> 3)) * ldsrc + ncol0 + 4 * (lane & 7));
    CFENCE();
#pragma unroll
    for (int i = 0; i < 8; ++i) { const int kk = 8 * i + (lane >> 3), c4 = lane & 7; *(LAS f32x4*)(scr + kk * 36 + 4 * c4) = v8[i] * gv[i]; }
    LDS_WAIT(); CFENCE();
    const int c = lane & 7;
#pragma unroll
    for (int j = 0; j < 4; ++j) { const int n = (lane >> 3) + 8 * j; const LAS float* s = scr + (8 * c) * 36 + n;
        u32x4 o; o.x = pk2(s[0 * 36], s[1 * 36]); o.y = pk2(s[2 * 36], s[3 * 36]); o.z = pk2(s[4 * 36], s[5 * 36]); o.w = pk2(s[6 * 36], s[7 * 36]);
        *(u32x4*)(dst + (size_t)(drow0 + n) * K + k0 + 8 * c) = o; }
    LDS_WAIT(); CFENCE();
}
__device__ __forceinline__ void p0_tr_item_f8(const float* src, int ldsrc, int ncol0, int k0, const float* gain, float scale, unsigned char* dst, int K, int drow0, LAS float* scr, int lane) {
    float gv[8]; f32x4 v8[8];
#pragma unroll
    for (int i = 0; i < 8; ++i) gv[i] = 1.0f;
    if (gain) {
#pragma unroll
        for (int i = 0; i < 8; ++i) gv[i] = gain[k0 + 8 * i + (lane >> 3)];
    }
#pragma unroll
    for (int i = 0; i < 8; ++i) v8[i] = *(const f32x4*)(src + (size_t)(k0 + 8 * i + (lane >> 3)) * ldsrc + ncol0 + 4 * (lane & 7));
    CFENCE();
#pragma unroll
    for (int i = 0; i < 8; ++i) { const int kk = 8 * i + (lane >> 3), c4 = lane & 7; *(LAS f32x4*)(scr + kk * 36 + 4 * c4) = v8[i] * (gv[i] * scale); }
    LDS_WAIT(); CFENCE();
    const int c = lane & 7;
#pragma unroll
    for (int j = 0; j < 4; ++j) { const int n = (lane >> 3) + 8 * j; const LAS float* s = scr + (8 * c) * 36 + n;
        u32x2 o; o.x = pk4_fp8(s[0 * 36], s[1 * 36], s[2 * 36], s[3 * 36]); o.y = pk4_fp8(s[4 * 36], s[5 * 36], s[6 * 36], s[7 * 36]);
        *(u32x2*)(dst + (size_t)(drow0 + n) * K + k0 + 8 * c) = o; }
    LDS_WAIT(); CFENCE();
}
__device__ __forceinline__ void p0_s5_unit(const Frame& F, int l, int g) {
    LAS float* AP = (LAS float*)F.lds;
    LAS float* BB = AP + 64 * 17 * 2;
    LAS float* CC = BB + 64 * 16 * 2;
    LAS float* KT = CC + 16 * 64 * 2;
    const float* lre = F.in[3] + (l * 32 + g) * 64; const float* lim = F.in[4] + (l * 32 + g) * 64; const float ldt = F.in[5][l * 32 + g];
    const float* bre = F.in[6] + (size_t)(l * 32 + g) * 1024; const float* bim = F.in[7] + (size_t)(l * 32 + g) * 1024;
    const float* cre = F.in[8] + (size_t)(l * 32 + g) * 1024; const float* cim = F.in[9] + (size_t)(l * 32 + g) * 1024;
    const int tid = F.tid;
    for (int i = tid; i < 64 * 17; i += 512) {
        const int p = i / 17, tau = i % 17;
        const double lr = fmin((double)lre[p], -1e-4), li = (double)lim[p], dt = exp((double)ldt);
        const double mg = exp(lr * dt * tau), ph = li * dt * tau;
        AP[i * 2] = (float)(mg * cos(ph)); AP[i * 2 + 1] = (float)(mg * sin(ph));
    }
    for (int i = tid; i < 1024; i += 512) {
        const int p = i >> 4;
        const double lr = fmin((double)lre[p], -1e-4), li = (double)lim[p], dt = exp((double)ldt);
        const double mg = exp(lr * dt), ar = mg * cos(li * dt), ai = mg * sin(li * dt), nr = ar - 1.0, ni = ai, den = lr * lr + li * li;
        const double fr = (nr * lr + ni * li) / den, fi = (ni * lr - nr * li) / den;
        const double br = bre[i], bi = bim[i];
        BB[i * 2] = (float)(fr * br - fi * bi); BB[i * 2 + 1] = (float)(fr * bi + fi * br);
        CC[i * 2] = cre[i]; CC[i * 2 + 1] = cim[i];
    }
    __syncthreads();
    for (int i = tid; i < 4096; i += 512) {
        const int tau = i >> 8, c = (i >> 4) & 15, c2 = i & 15; float s = 0.f;
        for (int p = 0; p < 64; ++p) {
            const float xr = CC[(c * 64 + p) * 2], xi = CC[(c * 64 + p) * 2 + 1], ar = AP[(p * 17 + tau) * 2], ai = AP[(p * 17 + tau) * 2 + 1];
            const float zr = xr * ar - xi * ai, zi = xr * ai + xi * ar;
            s += zr * BB[(p * 16 + c2) * 2] - zi * BB[(p * 16 + c2) * 2 + 1];
        }
        KT[i] = s;
    }
    __syncthreads();
    bf16* MQ = wsp<bf16>(F, WS_S5MQ) + (size_t)(l * 32 + g) * 256 * 384;
    for (int i = tid; i < 256 * 48; i += 512) {
        const int m = i / 48, k8 = (i % 48) * 8, t = m >> 4, c = m & 15; float v[8];
#pragma unroll
        for (int j = 0; j < 8; ++j) {
            const int kc = k8 + j;
            if (kc < 256) { const int s = kc >> 4, c2 = kc & 15; v[j] = (s <= t) ? KT[((t - s) * 16 + c) * 16 + c2] : 0.f; }
            else { const int pp = kc - 256, p = pp & 63; const float xr = CC[(c * 64 + p) * 2], xi = CC[(c * 64 + p) * 2 + 1], ar = AP[(p * 17 + t + 1) * 2], ai = AP[(p * 17 + t + 1) * 2 + 1];
                   v[j] = (pp < 64) ? (xr * ar - xi * ai) : -(xr * ai + xi * ar); }
        }
        u32x4 o; o.x = pk2(v[0], v[1]); o.y = pk2(v[2], v[3]); o.z = pk2(v[4], v[5]); o.w = pk2(v[6], v[7]);
        *(u32x4*)(MQ + (size_t)m * 384 + k8) = o;
    }
    bf16* PM = wsp<bf16>(F, WS_S5P) + (size_t)(l * 32 + g) * 128 * 256;
    for (int i = tid; i < 128 * 32; i += 512) {
        const int pp = i >> 5, k8 = (i & 31) * 8, p = pp & 63; float v[8];
#pragma unroll
        for (int j = 0; j < 8; ++j) {
            const int kc = k8 + j, s = kc >> 4, c2 = kc & 15;
            const float ar = AP[(p * 17 + 15 - s) * 2], ai = AP[(p * 17 + 15 - s) * 2 + 1], br = BB[(p * 16 + c2) * 2], bi = BB[(p * 16 + c2) * 2 + 1];
            v[j] = (pp < 64) ? (ar * br - ai * bi) : (ar * bi + ai * br);
        }
        u32x4 o; o.x = pk2(v[0], v[1]); o.y = pk2(v[2], v[3]); o.z = pk2(v[4], v[5]); o.w = pk2(v[6], v[7]);
        *(u32x4*)(PM + (size_t)pp * 256 + k8) = o;
    }
    float* A16 = wsp<float>(F, WS_S5A16) + (size_t)(l * 32 + g) * 128;
    if (tid < 64) { A16[tid * 2] = AP[(tid * 17 + 16) * 2]; A16[tid * 2 + 1] = AP[(tid * 17 + 16) * 2 + 1]; }
    __syncthreads();
}
__device__ __forceinline__ void p0_prologue(const Frame& F) {
    if (F.bid == 0 && F.tid < 16) __hip_atomic_store(wsp<unsigned>(F, WS_CTL) + CW_CNT + F.tid, 0u, __ATOMIC_RELAXED, __HIP_MEMORY_SCOPE_AGENT);
#ifndef PROBE_S5U
#define PROBE_S5U 1
#endif
#pragma unroll 1
    for (int pr = 0; pr < PROBE_S5U; ++pr) for (int un = F.bid; un < 64; un += F.G) p0_s5_unit(F, un >> 5, un & 31);
    LAS float* scr = (LAS float*)(F.lds + F.wave * 16384);
    const int gw = F.bid * 8 + F.wave, NGW = F.G * 8, lane = F.lane;
    constexpr int I_IN = 16 * 64, I_GLU = 8 * 16, I_OUT = 16 * 32, I_FGU = 16 * 176, I_FD = 44 * 32, I_MGU = 16 * 224, I_MD = 56 * 32;
    constexpr int NITEMS = 2 * (I_IN + I_GLU + I_OUT) + I_FGU + I_FD + 8 * (I_MGU + I_MD);
    const bool split = F.G > 64;
    const int N1 = split ? ((NITEMS / NGW > 4) ? (NITEMS / NGW - 4) * NGW : 0) : NITEMS;
    int step = NGW;
    for (int it = gw; ; it += step) {
        if (step == NGW && it >= N1) { if (!split || F.bid < 64) break; it = N1 + (F.bid - 64) * 8 + F.wave; step = (F.G - 64) * 8; }
        if (it >= NITEMS) break;
        int r = it; bool done = false;
#pragma unroll
        for (int l = 0; l < 2; ++l) {
            if (done) break;
            if (r < I_IN) { p0_tr_item(F.in[2] + (size_t)l * D * DIN, DIN, 32 * (r % 64), 64 * (r / 64), F.in[1] + l * D, wsp<bf16>(F, WS_WIN) + (size_t)l * NPROJ * D, D, 32 * (r % 64), scr, lane); done = true; break; } r -= I_IN;
            if (r < I_GLU) { p0_tr_item(F.in[11] + (size_t)l * 512 * 512, 512, 32 * (r % 16), 64 * (r / 16), nullptr, wsp<bf16>(F, WS_WGLU) + (size_t)l * 512 * 512, 512, 32 * (r % 16), scr, lane); done = true; break; } r -= I_GLU;
            if (r < I_OUT) { p0_tr_item(F.in[17] + (size_t)l * D * D, D, 32 * (r % 32), 64 * (r / 32), nullptr, wsp<bf16>(F, WS_WOUT) + (size_t)l * D * D, D, 32 * (r % 32), scr, lane); done = true; break; } r -= I_OUT;
        }
        if (done) continue;
        if (r < I_FGU) { const int nb = r % 176, kb = r / 176, n0 = 32 * nb, T = n0 >> 8, hf = (n0 >> 7) & 1, j0 = n0 & 127;
            if (USE_F8_FFN) p0_tr_item_f8(hf ? F.in[20] : F.in[19], DFF, 128 * T + j0, 64 * kb, F.in[18], F8_SW_UP, wsp<unsigned char>(F, WS_WFGU), D, n0, scr, lane);
            else p0_tr_item(hf ? F.in[20] : F.in[19], DFF, 128 * T + j0, 64 * kb, F.in[18], wsp<bf16>(F, WS_WFGU), D, n0, scr, lane);
            continue; } r -= I_FGU;
        if (r < I_FD) {
            if (USE_F8_FFN) p0_tr_item_f8(F.in[21], D, 32 * (r % 32), 64 * (r / 32), nullptr, F8_SW_DN, wsp<unsigned char>(F, WS_WFD), DFF, 32 * (r % 32), scr, lane);
            else p0_tr_item(F.in[21], D, 32 * (r % 32), 64 * (r / 32), nullptr, wsp<bf16>(F, WS_WFD), DFF, 32 * (r % 32), scr, lane);
            continue; } r -= I_FD;
        const int e = r / (I_MGU + I_MD); r -= e * (I_MGU + I_MD);
        if (r < I_MGU) { const int nb = r % 224, kb = r / 224, n0 = 32 * nb, T = n0 >> 8, hf = (n0 >> 7) & 1, j0 = n0 & 127;
            if (USE_F8_MOE) p0_tr_item_f8((hf ? F.in[24] : F.in[23]) + (size_t)e * D * DFE, DFE, 128 * T + j0, 64 * kb, F.in[18] + D, F8_SW_UP, wsp<unsigned char>(F, WS_MGU) + (size_t)e * 2 * DFE * D, D, n0, scr, lane);
            else p0_tr_item((hf ? F.in[24] : F.in[23]) + (size_t)e * D * DFE, DFE, 128 * T + j0, 64 * kb, F.in[18] + D, wsp<bf16>(F, WS_MGU) + (size_t)e * 2 * DFE * D, D, n0, scr, lane);
            continue; } r -= I_MGU;
        if (USE_F8_MOE) p0_tr_item_f8(F.in[25] + (size_t)e * DFE * D, D, 32 * (r % 32), 64 * (r / 32), nullptr, F8_SW_DN, wsp<unsigned char>(F, WS_MD) + (size_t)e * D * DFE, DFE, 32 * (r % 32), scr, lane);
        else p0_tr_item(F.in[25] + (size_t)e * DFE * D, D, 32 * (r % 32), 64 * (r / 32), nullptr, wsp<bf16>(F, WS_MD) + (size_t)e * D * DFE, DFE, 32 * (r % 32), scr, lane);
    }
    for (int it = F.bid * 512 + F.tid; it < 2 * 16 * 1024; it += F.G * 512) {
        const int l = it >> 14, r = (it >> 10) & 15, k = it & 1023;
        wsp<bf16>(F, WS_WGT)[it] = (bf16)f2bf(F.in[1][l * D + k] * F.in[2][(size_t)l * D * DIN + (size_t)k * DIN + 2048 + r]);
    }
    for (int it = F.bid * 512 + F.tid; it < 2 * 256 * 16; it += F.G * 512) {
        const int l = it >> 12, k = (it >> 4) & 255, r = it & 15;
        wsp<bf16>(F, WS_WA2T)[it] = (bf16)f2bf(F.in[14][(size_t)l * 16 * 256 + r * 256 + k]);
    }
    bf16* xb = wsp<bf16>(F, WS_XB); float* ssp = wsp<float>(F, WS_SSP);
    f32x4 xn[4];
    if (gw < M) {
#pragma unroll
        for (int j = 0; j < 4; ++j) xn[j] = ((const f32x4*)(F.in[0] + (size_t)gw * D) + lane)[64 * j];
    }
    for (int m = gw; m < M; m += NGW) {
        f32x4 xc[4]; float s = 0.f;
#pragma unroll
        for (int j = 0; j < 4; ++j) xc[j] = xn[j];
        if (m + NGW < M) {
#pragma unroll
            for (int j = 0; j < 4; ++j) xn[j] = ((const f32x4*)(F.in[0] + (size_t)(m + NGW) * D) + lane)[64 * j];
        }
        CFENCE();
        u32x2* o8 = (u32x2*)(xb + (size_t)m * D) + lane;
#pragma unroll
        for (int j = 0; j < 4; ++j) { const f32x4 v = xc[j]; s += (v[0] * v[0] + v[1] * v[1]) + (v[2] * v[2] + v[3] * v[3]); u32x2 w; w.x = pk2(v[0], v[1]); w.y = pk2(v[2], v[3]); o8[64 * j] = w; }
        s = wave_sum(s);
        if (lane < 16) ssp[(size_t)m * 16 + lane] = (lane == 0) ? s : 0.f;
    }
}

__device__ __forceinline__ bf16x8 frag_row(const LAS unsigned char* base, int stride, int row0, int k0, int lane) {
    return *(const LAS bf16x8*)(base + (row0 + (lane & 15)) * stride + (k0 + 8 * (lane >> 4)) * 2);
}
__device__ __forceinline__ s16x4 lds_tr(const LAS unsigned char* p) { return __builtin_bit_cast(s16x4, __builtin_amdgcn_ds_read_tr16_b64_v4i16((LAS v4i16_t*)p)); }
__device__ __forceinline__ bf16x8 frag_tr(const LAS unsigned char* base, int stride, int r0, int c0, int lane) {
    const int i = lane & 15, q = i >> 2, p = i & 3, g = lane >> 4;
    const LAS unsigned char* a = base + (r0 + 8 * g + q) * stride + (c0 + 4 * p) * 2;
    const s16x4 lo = lds_tr(a), hi = lds_tr(a + 4 * stride);
    return (bf16x8){lo[0], lo[1], lo[2], lo[3], hi[0], hi[1], hi[2], hi[3]};
}
__device__ __forceinline__ bf16x8 frag_tr_perm(const LAS unsigned char* base, int stride, int r0, int c0, int lane) {
    const int i = lane & 15, q = i >> 2, p = i & 3, g = lane >> 4;
    const LAS unsigned char* a = base + (r0 + 4 * g + q) * stride + (c0 + 4 * p) * 2;
    const s16x4 lo = lds_tr(a), hi = lds_tr(a + 16 * stride);
    return (bf16x8){lo[0], lo[1], lo[2], lo[3], hi[0], hi[1], hi[2], hi[3]};
}
#define MFMA16(a, b, c) __builtin_amdgcn_mfma_f32_16x16x32_bf16((a), (b), (c), 0, 0, 0)

__device__ __forceinline__ void glow_pass(const Frame& F, int l) {
    const int lane = F.lane, fr = lane & 15, fq = lane >> 4;
    const bf16* wg = wsp<bf16>(F, WS_WGT) + (size_t)l * 16 * 1024;
    bf16x8 wf[32];
#pragma unroll
    for (int ks = 0; ks < 32; ++ks) wf[ks] = *(const bf16x8*)(wg + fr * 1024 + 32 * ks + 8 * fq);
    const bf16* xb = wsp<bf16>(F, WS_XB); const float* ssp = wsp<float>(F, WS_SSP); bf16* gl = wsp<bf16>(F, WS_GL);
    for (int m0 = 16 * (F.bid * 8 + F.wave); m0 < M; m0 += 16 * F.G * 8) {
        f32x4 acc = {0.f, 0.f, 0.f, 0.f};
        const bf16* xr = xb + (size_t)(m0 + fr) * D + 8 * fq;
        const float rs = row_rstd(ssp, m0 + fr);
        u32x4 an[8];
#pragma unroll
        for (int kk = 0; kk < 8; ++kk) an[kk] = *(const u32x4*)(xr + 32 * kk);
#pragma unroll
        for (int kg = 0; kg < 4; ++kg) {
            u32x4 a8[8];
#pragma unroll
            for (int kk = 0; kk < 8; ++kk) a8[kk] = an[kk];
            if (kg < 3) {
#pragma unroll
                for (int kk = 0; kk < 8; ++kk) an[kk] = *(const u32x4*)(xr + 32 * (8 * (kg + 1) + kk));
            }
            CFENCE();
#pragma unroll
            for (int kk = 0; kk < 8; ++kk) acc = MFMA16(wf[8 * kg + kk], __builtin_bit_cast(bf16x8, a8[kk]), acc);
        }
        u32x2 o; o.x = cvt_pk_bf16(acc[0] * rs, acc[1] * rs); o.y = cvt_pk_bf16(acc[2] * rs, acc[3] * rs);
        *(u32x2*)(gl + (size_t)(m0 + fr) * 16 + 4 * fq) = o;
    }
}
constexpr int S5_USTR = 528, S5_SSTR = 272, S5_HSTR = 272;
__device__ __forceinline__ void s5_unit(const Frame& F, int l, int un) {
    const int b = un >> 5, g = un & 31, tid = F.tid, lane = F.lane, w = F.wave, fq = lane >> 4, fr = lane & 15;
    LAS unsigned char* hb = F.lds; LAS unsigned char* useg = F.lds + 64 * S5_HSTR; LAS unsigned char* slds = useg + 64 * S5_USTR;
    const bf16* PM = wsp<bf16>(F, WS_S5P) + (size_t)(l * 32 + g) * 128 * 256;
    const bf16* MQ = wsp<bf16>(F, WS_S5MQ) + (size_t)(l * 32 + g) * 256 * 384;
    bf16x8 pf[8], mq0[12], mq1[12];
#pragma unroll
    for (int ks = 0; ks < 8; ++ks) pf[ks] = *(const bf16x8*)(PM + (size_t)(16 * w + fr) * 256 + 32 * ks + 8 * fq);
#pragma unroll
    for (int ks = 0; ks < 12; ++ks) { mq0[ks] = *(const bf16x8*)(MQ + (size_t)(16 * w + fr) * 384 + 32 * ks + 8 * fq); mq1[ks] = *(const bf16x8*)(MQ + (size_t)(16 * (w + 8) + fr) * 384 + 32 * ks + 8 * fq); }
    const float* A16 = wsp<float>(F, WS_S5A16) + (size_t)(l * 32 + g) * 128;
    const float a_re = A16[(lane & 63) * 2], a_im = A16[(lane & 63) * 2 + 1];
    const f32x4 dsk = *(const f32x4*)(F.in[10] + l * 512 + g * 16 + 4 * fq);
    float hr = 0.f, hi = 0.f;
    const bf16* ug = wsp<bf16>(F, WS_UGM) + (size_t)((b * 32 + g) * 4096) * 16;
    bf16* ys5 = (bf16*)(F.dout + DO_YS5);
    u32x4 upre[4];
#pragma unroll
    for (int i = 0; i < 4; ++i) upre[i] = *(const u32x4*)(ug + (size_t)(tid + 512 * i) * 8);
    for (int seg = 0; seg < 4; ++seg) {
#pragma unroll
        for (int i = 0; i < 4; ++i) { const int idx = tid + 512 * i; *(LAS u32x4*)(useg + (idx >> 5) * S5_USTR + (idx & 31) * 16) = upre[i]; }
        if (seg < 3) {
#pragma unroll
            for (int i = 0; i < 4; ++i) upre[i] = *(const u32x4*)(ug + (size_t)(seg + 1) * 16384 + (size_t)(tid + 512 * i) * 8);
        }
        __syncthreads();
#ifndef PROBE_S5
#define PROBE_S5 0
#endif
#pragma unroll 1
        for (int pr1 = 0; pr1 < (PROBE_S5 == 1 ? 2 : 1); ++pr1)
        {
            f32x4 acc4[4];
#pragma unroll
            for (int nt = 0; nt < 4; ++nt) acc4[nt] = (f32x4){0.f, 0.f, 0.f, 0.f};
#pragma unroll
            for (int kb = 0; kb < 8; kb += 2) {
                bf16x8 ub[2][4];
#pragma unroll
                for (int ks = 0; ks < 2; ++ks)
#pragma unroll
                    for (int nt = 0; nt < 4; ++nt) ub[ks][nt] = frag_row(useg, S5_USTR, 16 * nt, 32 * (kb + ks), lane);
                __builtin_amdgcn_sched_barrier(0);
#pragma unroll
                for (int ks = 0; ks < 2; ++ks)
#pragma unroll
                    for (int nt = 0; nt < 4; ++nt) acc4[nt] = MFMA16(ub[ks][nt], pf[kb + ks], acc4[nt]);
                __builtin_amdgcn_sched_barrier(0);
            }
#pragma unroll
            for (int nt = 0; nt < 4; ++nt) *(LAS f32x4*)(slds + (16 * w + fr) * S5_SSTR + (16 * nt + 4 * fq) * 4) = acc4[nt];
        }
        __syncthreads();
        if (w == 0) {
            const LAS unsigned char* sre = slds + lane * S5_SSTR; const LAS unsigned char* sim = slds + (64 + lane) * S5_SSTR;
            const float hr0 = hr, hi0 = hi;
            const f32x2 are2 = {a_re, a_re}, aim2 = {-a_im, a_im};
#pragma unroll 1
            for (int pr2 = 0; pr2 < (PROBE_S5 == 2 ? 2 : 1); ++pr2) { hr = hr0; hi = hi0;
#pragma unroll 1
            for (int n0 = 0; n0 < 64; n0 += 16) {
                LAS unsigned char* hw = hb + n0 * S5_HSTR + lane * 2;
                f32x4 cr4[4], ci4[4];
#pragma unroll
                for (int q = 0; q < 4; ++q) { cr4[q] = *(const LAS f32x4*)(sre + n0 * 4 + q * 16); ci4[q] = *(const LAS f32x4*)(sim + n0 * 4 + q * 16); }
                CFENCE();
#pragma unroll
                for (int j = 0; j < 16; ++j) {
                    const f32x2 s2 = {cr4[j >> 2][j & 3], ci4[j >> 2][j & 3]};
                    const unsigned hp = cvt_pk_bf16(hr, hi);
                    *(LAS unsigned short*)(hw + j * S5_HSTR) = (unsigned short)hp; *(LAS unsigned short*)(hw + j * S5_HSTR + 128) = (unsigned short)(hp >> 16);
                    const f32x2 hv = {hr, hi}, hx = {hi, hr};
                    const f32x2 nh = hv * are2 + (hx * aim2 + s2);
                    hr = nh[0]; hi = nh[1];
                }
            }
            }
        }
        __syncthreads();
#pragma unroll 1
        for (int pr3 = 0; pr3 < (PROBE_S5 == 3 ? 2 : 1); ++pr3)
#pragma unroll
        for (int nt = 0; nt < 4; ++nt) {
            f32x4 a0 = {0.f, 0.f, 0.f, 0.f}, a1 = {0.f, 0.f, 0.f, 0.f};
#pragma unroll
            for (int kb = 0; kb < 12; kb += 4) {
                bf16x8 bb[4];
#pragma unroll
                for (int ks = 0; ks < 4; ++ks) bb[ks] = (kb < 8) ? frag_row(useg, S5_USTR, 16 * nt, 32 * (kb + ks), lane) : frag_row(hb, S5_HSTR, 16 * nt, 32 * ks, lane);
                __builtin_amdgcn_sched_barrier(0);
#pragma unroll
                for (int ks = 0; ks < 4; ++ks) { a0 = MFMA16(mq0[kb + ks], bb[ks], a0); a1 = MFMA16(mq1[kb + ks], bb[ks], a1); }
                __builtin_amdgcn_sched_barrier(0);
            }
            const int chunk = 16 * nt + fr;
#pragma unroll
            for (int hh = 0; hh < 2; ++hh) {
                const int t = w + 8 * hh; const f32x4 a = hh ? a1 : a0;
                const u32x2 uu = *(const LAS u32x2*)(useg + chunk * S5_USTR + (t * 16 + 4 * fq) * 2);
                const float y0 = gelu_tanh(a[0] + dsk[0] * bflo(uu.x)), y1 = gelu_tanh(a[1] + dsk[1] * bfhi(uu.x)), y2 = gelu_tanh(a[2] + dsk[2] * bflo(uu.y)), y3 = gelu_tanh(a[3] + dsk[3] * bfhi(uu.y));
                u32x2 o; o.x = cvt_pk_bf16(y0, y1); o.y = cvt_pk_bf16(y2, y3);
                const int token = b * 4096 + seg * 1024 + chunk * 16 + t;
                *(u32x2*)(ys5 + (size_t)token * 512 + g * 16 + 4 * fq) = o;
            }
        }
        __syncthreads();
    }
}

constexpr int GL_TSTR = 144;
__device__ __forceinline__ void gla_ld_tile(const bf16* g, int pitch, u32x4 (&r)[8], int lane) {
#pragma unroll
    for (int i = 0; i < 8; ++i) { const int idx = lane + 64 * i; r[i] = *(const u32x4*)(g + (size_t)(idx >> 3) * pitch + (idx & 7) * 8); }
}
__device__ __forceinline__ void gla_st_tile(LAS unsigned char* img, const u32x4 (&r)[8], int lane) {
#pragma unroll
    for (int i = 0; i < 8; ++i) { const int idx = lane + 64 * i; *(LAS u32x4*)(img + (idx >> 3) * GL_TSTR + (idx & 7) * 16) = r[i]; }
}
__device__ __forceinline__ void gla_loga_tile(const Frame& F, int l, int row0, int h, LAS unsigned char* img, int lane_) {
    int lane = lane_; asm volatile("" : "+v"(lane));
    const int fr = lane & 15, fq = lane >> 4;
    const bf16* wa = wsp<bf16>(F, WS_WA2T) + (size_t)l * 256 * 16 + (size_t)(h * 64) * 16; const bf16* gl = wsp<bf16>(F, WS_GL) + (size_t)row0 * 16;
    const float* ba = F.in[15] + l * 256 + h * 64;
    bf16x8 af[4], bfr[4];
    const u32x4 zero4 = {0u, 0u, 0u, 0u};
#pragma unroll
    for (int i = 0; i < 4; ++i) {
        const u32x4 a = (fq < 2) ? *(const u32x4*)(wa + (size_t)(16 * i + fr) * 16 + 8 * fq) : zero4;
        const u32x4 b = (fq < 2) ? *(const u32x4*)(gl + (size_t)(16 * i + fr) * 16 + 8 * fq) : zero4;
        af[i] = __builtin_bit_cast(bf16x8, a); bfr[i] = __builtin_bit_cast(bf16x8, b);
    }
    float b44[4];
#pragma unroll
    for (int mt = 0; mt < 4; ++mt) b44[mt] = ba[16 * mt + fr];
    CFENCE();
#pragma unroll
    for (int mt = 0; mt < 4; ++mt) {
        const float b1 = b44[mt];
#pragma unroll
        for (int nt = 0; nt < 4; ++nt) {
            f32x4 z = {0.f, 0.f, 0.f, 0.f};
            z = MFMA16(bfr[nt], af[mt], z);
            float la[4];
#pragma unroll
            for (int j = 0; j < 4; ++j) { const float v = z[j] + b1; la[j] = (fminf(v, 0.f) - __logf(1.0f + __expf(-fabsf(v)))) * 0.0625f; }
            u32x2 o; o.x = cvt_pk_bf16(la[0], la[1]); o.y = cvt_pk_bf16(la[2], la[3]);
            *(LAS u32x2*)(img + (16 * mt + fr) * GL_TSTR + (16 * nt + 4 * fq) * 2) = o;
        }
    }
}
__device__ __forceinline__ void gla_row(const LAS unsigned char* img, int lane, u32x4 (&r)[8]) {
#pragma unroll
    for (int i = 0; i < 8; ++i) r[i] = *(const LAS u32x4*)(img + lane * GL_TSTR + i * 16);
}
#define GLA_ROWV(r, t) ((((t) & 1) ? bfhi((r)[(t) >> 3][((t) >> 1) & 3]) : bflo((r)[(t) >> 3][((t) >> 1) & 3])))
__device__ __forceinline__ float gla_col(const LAS unsigned char* img, int t, int lane) { return bf2f(*(const LAS bf16*)(img + t * GL_TSTR + lane * 2)); }
__device__ __forceinline__ void gla_a_unit(const Frame& F, int l, int wu) {
    const int lane = F.lane, fq = lane >> 4, fr = lane & 15;
    const int bh = wu >> 6, n = wu & 63, b = bh >> 2, h = bh & 3, row0 = b * 4096 + n * 64;
    LAS unsigned char* ra = F.lds + F.wave * WAVE_LDS; LAS unsigned char* rb = ra + 64 * GL_TSTR;
    const bf16* vp = wsp<bf16>(F, WS_V) + (size_t)row0 * 512 + h * 128;
    u32x4 t1[8], tv[8];
    gla_ld_tile(wsp<bf16>(F, WS_K) + (size_t)row0 * 256 + h * 64, 256, t1, lane);
    gla_ld_tile(vp, 512, tv, lane);
    gla_loga_tile(F, l, row0, h, ra, lane);
    gla_st_tile(rb, t1, lane);
    CFENCE();
    u32x4 lg[8]; gla_row(ra, lane, lg);
    float tot = 0.f;
#pragma unroll
    for (int t = 0; t < 64; ++t) tot += GLA_ROWV(lg, t);
    wsp<float>(F, WS_DEC)[(size_t)wu * 64 + lane] = __expf(tot);
    float cum = 0.f; u32x4 pk[8];
#pragma unroll
    for (int t8 = 0; t8 < 8; ++t8) {
        float ke[8], kc[8];
#pragma unroll
        for (int tt = 0; tt < 8; ++tt) kc[tt] = gla_col(rb, t8 * 8 + tt, lane);
        CFENCE();
#pragma unroll
        for (int tt = 0; tt < 8; ++tt) { const int t = t8 * 8 + tt; cum += GLA_ROWV(lg, t); ke[tt] = kc[tt] * __expf(tot - cum); }
        pk[t8].x = cvt_pk_bf16(ke[0], ke[1]); pk[t8].y = cvt_pk_bf16(ke[2], ke[3]); pk[t8].z = cvt_pk_bf16(ke[4], ke[5]); pk[t8].w = cvt_pk_bf16(ke[6], ke[7]);
    }
    CFENCE();
#pragma unroll
    for (int t8 = 0; t8 < 8; ++t8) *(LAS u32x4*)(ra + lane * GL_TSTR + t8 * 16) = pk[t8];
    bf16* ut = (bf16*)(F.dout + DO_UT) + (size_t)wu * 8192;
#pragma unroll
    for (int hv = 0; hv < 2; ++hv) {
        CFENCE();
        gla_st_tile(rb, tv, lane);
        if (hv == 0) gla_ld_tile(vp + 64, 512, tv, lane);
        CFENCE();
#pragma unroll
        for (int mt = 0; mt < 4; ++mt)
#pragma unroll
            for (int nt = 0; nt < 4; ++nt) {
                f32x4 acc = {0.f, 0.f, 0.f, 0.f};
#pragma unroll
                for (int ks = 0; ks < 2; ++ks) acc = MFMA16(frag_row(ra, GL_TSTR, 16 * mt, 32 * ks, lane), frag_tr(rb, GL_TSTR, 32 * ks, 16 * nt, lane), acc);
                { u32x2 o; o.x = cvt_pk_bf16(acc[0], acc[1]); o.y = cvt_pk_bf16(acc[2], acc[3]);
                  *(u32x2*)(ut + (size_t)(hv * 64 + nt * 16 + fr) * 64 + mt * 16 + 4 * fq) = o; }
            }
    }
}
__device__ __forceinline__ void gla_b_scan(const Frame& F) {
    const bf16* ut = (const bf16*)(F.dout + DO_UT); bf16* st = (bf16*)(F.dout + DO_ST); const float* dec = wsp<float>(F, WS_DEC);
    LAS float* dl = (LAS float*)F.lds;
    for (int blk = F.bid; blk < 256; blk += F.G) {
        const int bh = blk >> 3, e = (blk & 7) * 1024 + F.tid * 2, k = e & 63;
        __syncthreads();
#pragma unroll
        for (int i = 0; i < 2; ++i) *(LAS f32x4*)(dl + (F.tid + 512 * i) * 4) = *(const f32x4*)(dec + (size_t)bh * 4096 + (size_t)(F.tid + 512 * i) * 4);
        __syncthreads();
        f32x2 s2 = {0.f, 0.f};
        const bf16* up = ut + (size_t)bh * 64 * 8192 + e; bf16* sp = st + (size_t)bh * 64 * 8192 + e;
        unsigned un16[16];
#pragma unroll
        for (int j = 0; j < 16; ++j) un16[j] = *(const unsigned*)(up + (size_t)j * 8192);
#pragma unroll 1
        for (int n0 = 0; n0 < 64; n0 += 16) {
            unsigned u16[16];
#pragma unroll
            for (int j = 0; j < 16; ++j) u16[j] = un16[j];
            if (n0 < 48) {
#pragma unroll
                for (int j = 0; j < 16; ++j) un16[j] = *(const unsigned*)(up + (size_t)(n0 + 16 + j) * 8192);
            }
            CFENCE();
#pragma unroll
            for (int j = 0; j < 16; ++j) {
                const f32x2 d = *(const LAS f32x2*)(dl + (n0 + j) * 64 + k);
                *(unsigned*)(sp + (size_t)(n0 + j) * 8192) = cvt_pk_bf16(s2[0], s2[1]);
                s2 = d * s2 + (f32x2){bflo(u16[j]), bfhi(u16[j])};
            }
        }
    }
}
__device__ __forceinline__ void gla_c_unit(const Frame& F, int l, int wu) {
    const int lane = F.lane, fq = lane >> 4, fr = lane & 15;
    const int bh = wu >> 6, n = wu & 63, b = bh >> 2, h = bh & 3, row0 = b * 4096 + n * 64;
    LAS unsigned char* qtt = F.lds + F.wave * WAVE_LDS; LAS unsigned char* ktt = qtt + 64 * GL_TSTR;
    const bf16* vp = wsp<bf16>(F, WS_V) + (size_t)row0 * 512 + h * 128;
    u32x4 t1[8], t2[8], tv[8];
    gla_loga_tile(F, l, row0, h, qtt, lane);
    CFENCE();
    gla_ld_tile(wsp<bf16>(F, WS_K) + (size_t)row0 * 256 + h * 64, 256, t1, lane);
    gla_ld_tile(wsp<bf16>(F, WS_Q) + (size_t)row0 * 256 + h * 64, 256, t2, lane);
    gla_st_tile(ktt, t1, lane);
    CFENCE();
    unsigned e1p[32]; float cum = 0.f; u32x4 pkk[8], pkq[8];
    u32x4 lg[8]; gla_row(qtt, lane, lg);
#pragma unroll
    for (int t8 = 0; t8 < 8; ++t8) {
        float kt[8], e8[8], kc[8];
#pragma unroll
        for (int tt = 0; tt < 8; ++tt) kc[tt] = gla_col(ktt, t8 * 8 + tt, lane);
        CFENCE();
#pragma unroll
        for (int tt = 0; tt < 8; ++tt) { const int t = t8 * 8 + tt; cum += GLA_ROWV(lg, t); e8[tt] = __expf(cum); kt[tt] = kc[tt] * __builtin_amdgcn_rcpf(e8[tt]); }
#pragma unroll
        for (int j = 0; j < 4; ++j) e1p[t8 * 4 + j] = cvt_pk_bf16(e8[2 * j], e8[2 * j + 1]);
        pkk[t8].x = cvt_pk_bf16(kt[0], kt[1]); pkk[t8].y = cvt_pk_bf16(kt[2], kt[3]); pkk[t8].z = cvt_pk_bf16(kt[4], kt[5]); pkk[t8].w = cvt_pk_bf16(kt[6], kt[7]);
    }
    CFENCE();
    gla_st_tile(qtt, t2, lane);
    gla_ld_tile(vp, 512, tv, lane);
    CFENCE();
#pragma unroll
    for (int t8 = 0; t8 < 8; ++t8) {
        float qt[8], qc[8];
#pragma unroll
        for (int tt = 0; tt < 8; ++tt) qc[tt] = gla_col(qtt, t8 * 8 + tt, lane);
        CFENCE();
#pragma unroll
        for (int tt = 0; tt < 8; ++tt) { const int t = t8 * 8 + tt; const unsigned ep = e1p[t >> 1]; qt[tt] = qc[tt] * ((t & 1) ? bfhi(ep) : bflo(ep)) * 0.125f; }
        pkq[t8].x = cvt_pk_bf16(qt[0], qt[1]); pkq[t8].y = cvt_pk_bf16(qt[2], qt[3]); pkq[t8].z = cvt_pk_bf16(qt[4], qt[5]); pkq[t8].w = cvt_pk_bf16(qt[6], qt[7]);
    }
    CFENCE();
#pragma unroll
    for (int t8 = 0; t8 < 8; ++t8) { *(LAS u32x4*)(qtt + lane * GL_TSTR + t8 * 16) = pkq[t8]; *(LAS u32x4*)(ktt + lane * GL_TSTR + t8 * 16) = pkk[t8]; }
    CFENCE();
    u32x2 sc[4][4];
#pragma unroll
    for (int mt = 0; mt < 4; ++mt)
#pragma unroll
        for (int nt = 0; nt < 4; ++nt) {
            if (mt > nt) { sc[mt][nt] = (u32x2){0u, 0u}; continue; }
            f32x4 acc = {0.f, 0.f, 0.f, 0.f};
#pragma unroll
            for (int ks = 0; ks < 2; ++ks) acc = MFMA16(frag_tr(ktt, GL_TSTR, 32 * ks, 16 * mt, lane), frag_tr(qtt, GL_TSTR, 32 * ks, 16 * nt, lane), acc);
            if (mt == nt) {
#pragma unroll
                for (int rg = 0; rg < 4; ++rg) if (4 * fq + rg > fr) acc[rg] = 0.f;
            }
            sc[mt][nt].x = cvt_pk_bf16(acc[0], acc[1]); sc[mt][nt].y = cvt_pk_bf16(acc[2], acc[3]);
        }
    const bf16* st = (const bf16*)(F.dout + DO_ST) + (size_t)wu * 8192;
    f32x4 o[8][4];
#pragma unroll
    for (int hv = 0; hv < 2; ++hv) {
        CFENCE();
        gla_st_tile(ktt, tv, lane);
        CFENCE();
#pragma unroll
        for (int dt = 0; dt < 4; ++dt) {
            const int dvt = hv * 4 + dt;
            bf16x8 sfr[2], vfr[2];
#pragma unroll
            for (int ks = 0; ks < 2; ++ks) { sfr[ks] = *(const bf16x8*)(st + (size_t)(dvt * 16 + fr) * 64 + 32 * ks + 8 * fq); vfr[ks] = frag_tr_perm(ktt, GL_TSTR, 32 * ks, 16 * dt, lane); }
#pragma unroll
            for (int nt = 0; nt < 4; ++nt) {
                f32x4 acc = {0.f, 0.f, 0.f, 0.f};
#pragma unroll
                for (int ks = 0; ks < 2; ++ks) {
                    if (2 * ks <= nt) {
                        const u32x4 bw = {sc[2 * ks][nt].x, sc[2 * ks][nt].y, sc[2 * ks + 1][nt].x, sc[2 * ks + 1][nt].y};
                        acc = MFMA16(vfr[ks], __builtin_bit_cast(bf16x8, bw), acc);
                    }
                    acc = MFMA16(sfr[ks], frag_tr(qtt, GL_TSTR, 32 * ks, 16 * nt, lane), acc);
                }
                o[dvt][nt] = acc;
            }
        }
        if (hv == 0) gla_ld_tile(vp + 64, 512, tv, lane);
    }
    const float* gn = F.in[16] + l * 512 + h * 128;
    const bf16* rp = wsp<bf16>(F, WS_R) + (size_t)row0 * 512 + h * 128;
    bf16* mx = wsp<bf16>(F, WS_MIXED) + (size_t)row0 * D + 512 + h * 128;
    float rs4[4];
#pragma unroll
    for (int nt = 0; nt < 4; ++nt) {
        float ss = 0.f;
#pragma unroll
        for (int dvt = 0; dvt < 8; ++dvt) { const f32x4 x = o[dvt][nt]; ss += (x[0] * x[0] + x[1] * x[1]) + (x[2] * x[2] + x[3] * x[3]); }
        ss += __shfl_xor(ss, 16); ss += __shfl_xor(ss, 32);
        rs4[nt] = rsqrtf(ss * (1.0f / 128.0f) + EPS);
    }
    f32x4 gN = *(const f32x4*)(gn + 4 * fq); u32x2 rN[4];
#pragma unroll
    for (int nt = 0; nt < 4; ++nt) rN[nt] = *(const u32x2*)(rp + (size_t)(16 * nt + fr) * 512 + 4 * fq);
#pragma unroll
    for (int dvt = 0; dvt < 8; ++dvt) {
        const int dv = 16 * dvt + 4 * fq;
        const f32x4 g = gN; u32x2 rc[4];
#pragma unroll
        for (int nt = 0; nt < 4; ++nt) rc[nt] = rN[nt];
        if (dvt < 7) {
            gN = *(const f32x4*)(gn + dv + 16);
#pragma unroll
            for (int nt = 0; nt < 4; ++nt) rN[nt] = *(const u32x2*)(rp + (size_t)(16 * nt + fr) * 512 + dv + 16);
        }
        CFENCE();
#pragma unroll
        for (int nt = 0; nt < 4; ++nt) {
            const int i = 16 * nt + fr; const float rs = rs4[nt]; const u32x2 rr = rc[nt]; const f32x4 x = o[dvt][nt];
            u32x2 w; w.x = cvt_pk_bf16(x[0] * rs * g[0] * siluf_(bflo(rr.x)), x[1] * rs * g[1] * siluf_(bfhi(rr.x))); w.y = cvt_pk_bf16(x[2] * rs * g[2] * siluf_(bflo(rr.y)), x[3] * rs * g[3] * siluf_(bfhi(rr.y)));
            *(u32x2*)(mx + (size_t)i * D + dv) = w;
        }
    }
}
__device__ __forceinline__ void s5_fin_rows(const Frame& F, int l) {
    const int lane = F.lane, gw = F.bid * 8 + F.wave, NGW = F.G * 8;
    const bf16* y = wsp<bf16>(F, WS_UGM); bf16* mx = wsp<bf16>(F, WS_MIXED);
    const float* gn = F.in[13] + l * 512 + lane * 8; const f32x4 g0 = *(const f32x4*)gn, g1 = *(const f32x4*)(gn + 4);
    u32x4 an = {0u, 0u, 0u, 0u};
    if (gw < M) an = *((const u32x4*)(y + (size_t)gw * 512) + lane);
    for (int row = gw; row < M; row += NGW) {
        const u32x4 a = an;
        if (row + NGW < M) an = *((const u32x4*)(y + (size_t)(row + NGW) * 512) + lane);
        CFENCE();
        float v[8] = {bflo(a.x), bfhi(a.x), bflo(a.y), bfhi(a.y), bflo(a.z), bfhi(a.z), bflo(a.w), bfhi(a.w)}; float s = 0.f;
#pragma unroll
        for (int j = 0; j < 8; ++j) s += v[j] * v[j];
        s = wave_sum(s); const float rs = rsqrtf(s * (1.0f / 512.0f) + EPS);
        u32x4 w; w.x = cvt_pk_bf16(v[0] * rs * g0[0], v[1] * rs * g0[1]); w.y = cvt_pk_bf16(v[2] * rs * g0[2], v[3] * rs * g0[3]); w.z = cvt_pk_bf16(v[4] * rs * g1[0], v[5] * rs * g1[1]); w.w = cvt_pk_bf16(v[6] * rs * g1[2], v[7] * rs * g1[3]);
        *((u32x4*)(mx + (size_t)row * D) + lane) = w;
    }
}
__device__ __forceinline__ void moe_router(const Frame& F) {
    const int lane = F.lane, fr = lane & 15, fq = lane >> 4;
    const float* gain = F.in[18] + D; const float* wr_ = F.in[22];
    constexpr int RT_OFF = 16384, RT_STR = 2064;
    {
        const int k0 = 2 * F.tid;
        const f32x2 g2 = *(const f32x2*)(gain + k0);
        const f32x4 wa = *(const f32x4*)(wr_ + k0 * 8), wb = *(const f32x4*)(wr_ + k0 * 8 + 4), wc_ = *(const f32x4*)(wr_ + k0 * 8 + 8), wd = *(const f32x4*)(wr_ + k0 * 8 + 12);
        const float w0[8] = {wa[0], wa[1], wa[2], wa[3], wb[0], wb[1], wb[2], wb[3]}, w1_[8] = {wc_[0], wc_[1], wc_[2], wc_[3], wd[0], wd[1], wd[2], wd[3]};
#pragma unroll
        for (int e = 0; e < 8; ++e) {
            const float a = g2[0] * w0[e], b2 = g2[1] * w1_[e];
            const unsigned ah = f2bf(a), bh = f2bf(b2), al = f2bf(a - bf2f(ah)), bl = f2bf(b2 - bf2f(bh));
            *(LAS unsigned*)(F.lds + RT_OFF + e * RT_STR + k0 * 2) = ah | (bh << 16);
            *(LAS unsigned*)(F.lds + RT_OFF + (8 + e) * RT_STR + k0 * 2) = al | (bl << 16);
        }
    }
    __syncthreads();
    bf16x8 wf[32];
#pragma unroll
    for (int ks = 0; ks < 32; ++ks) wf[ks] = *(const LAS bf16x8*)(F.lds + RT_OFF + fr * RT_STR + (32 * ks + 8 * fq) * 2);
    const bf16* xb = wsp<bf16>(F, WS_XB); int* tok = wsp<int>(F, WS_TOK); float* wl = wsp<float>(F, WS_WL); float* rl = wsp<float>(F, WS_RL);
    unsigned* cnt = wsp<unsigned>(F, WS_CTL) + CW_CNT;
    LAS int* lcnt = (LAS int*)F.lds; LAS int* lbase = lcnt + 16; LAS int* rinfo = lbase + 16; LAS float* rw = (LAS float*)(rinfo + 1024); LAS float* rr = rw + 1024;
    const int rows_per_wg = ((M + F.G - 1) / F.G + 15) & ~15, r0 = F.bid * rows_per_wg, r1 = (r0 + rows_per_wg < M) ? r0 + rows_per_wg : M;
    if (F.tid < 16) lcnt[F.tid] = 0;
    __syncthreads();
    for (int m0 = r0 + 16 * F.wave; m0 < r1; m0 += 128) {
        f32x4 acc = {0.f, 0.f, 0.f, 0.f}; float ss = 0.f;
        const bf16* xr = xb + (size_t)(m0 + fr) * D + 8 * fq;
#pragma unroll
        for (int kg = 0; kg < 4; ++kg) {
            u32x4 a8[8];
#pragma unroll
            for (int kk = 0; kk < 8; ++kk) a8[kk] = *(const u32x4*)(xr + 32 * (8 * kg + kk));
            CFENCE();
#pragma unroll
            for (int kk = 0; kk < 8; ++kk) {
                const u32x4 a = a8[kk];
                const float x0 = bflo(a.x), x1 = bfhi(a.x), x2 = bflo(a.y), x3 = bfhi(a.y), x4 = bflo(a.z), x5 = bfhi(a.z), x6 = bflo(a.w), x7 = bfhi(a.w);
                ss += (x0 * x0 + x1 * x1) + (x2 * x2 + x3 * x3) + (x4 * x4 + x5 * x5) + (x6 * x6 + x7 * x7);
                acc = MFMA16(wf[8 * kg + kk], __builtin_bit_cast(bf16x8, a), acc);
            }
        }
        ss += __shfl_xor(ss, 16); ss += __shfl_xor(ss, 32);
        float lg4[4];
#pragma unroll
        for (int j = 0; j < 4; ++j) lg4[j] = acc[j] + __shfl_xor(acc[j], 32);
        float lg[8];
#pragma unroll
        for (int j = 0; j < 4; ++j) { const float o = __shfl_xor(lg4[j], 16); lg[j] = (fq & 1) ? o : lg4[j]; lg[4 + j] = (fq & 1) ? lg4[j] : o; }
        const float rs = rsqrtf(ss * (1.0f / D) + EPS);
        int e1 = 0; float l1 = lg[0];
#pragma unroll
        for (int e = 1; e < 8; ++e) if (lg[e] > l1) { l1 = lg[e]; e1 = e; }
        int e2 = -1; float l2 = -3.0e38f;
#pragma unroll
        for (int e = 0; e < 8; ++e) if (e != e1 && lg[e] > l2) { l2 = lg[e]; e2 = e; }
        const float w1 = 1.0f / (1.0f + __expf((l2 - l1) * rs));
        if (fq == 0) {
            const int p1 = __hip_atomic_fetch_add(lcnt + e1, 1, __ATOMIC_RELAXED, __HIP_MEMORY_SCOPE_WORKGROUP);
            const int p2 = __hip_atomic_fetch_add(lcnt + 8 + e2, 1, __ATOMIC_RELAXED, __HIP_MEMORY_SCOPE_WORKGROUP);
            const int i = m0 + fr - r0; rinfo[i] = e1 | (e2 << 4) | (p1 << 8) | (p2 << 20); rw[i] = w1; rr[i] = rs;
        }
    }
    __syncthreads();
    if (F.tid < 16) lbase[F.tid] = (int)__hip_atomic_fetch_add(cnt + F.tid, (unsigned)lcnt[F.tid], __ATOMIC_RELAXED, __HIP_MEMORY_SCOPE_AGENT);
    __syncthreads();
    for (int i = F.tid; i < r1 - r0; i += 512) {
        const int inf = rinfo[i], e1 = inf & 15, e2 = (inf >> 4) & 15, p1 = lbase[e1] + ((inf >> 8) & 4095), p2 = lbase[8 + e2] + ((inf >> 20) & 4095);
        const float w1 = rw[i], rs = rr[i];
        tok[e1 * 32768 + p1] = r0 + i; wl[e1 * 32768 + p1] = w1; rl[e1 * 32768 + p1] = rs;
        tok[(8 + e2) * 32768 + p2] = r0 + i; wl[(8 + e2) * 32768 + p2] = 1.0f - w1; rl[(8 + e2) * 32768 + p2] = rs;
    }
    __syncthreads();
}
__device__ __forceinline__ void final_norm(const Frame& F, bool from_xb) {
    const int lane = F.lane, gw = F.bid * 8 + F.wave, NGW = F.G * 8;
    const bf16* xo = from_xb ? wsp<bf16>(F, WS_XB) : wsp<bf16>(F, WS_XO); const float* g = F.in[26]; float* out = (float*)F.dout;
    f32x4 gv[4];
#pragma unroll
    for (int hh = 0; hh < 2; ++hh) { gv[2 * hh] = *(const f32x4*)(g + hh * 512 + lane * 8); gv[2 * hh + 1] = *(const f32x4*)(g + hh * 512 + lane * 8 + 4); }
    u32x4 n0 = {0u, 0u, 0u, 0u}, n1 = n0;
    if (gw < M) { n0 = *((const u32x4*)(xo + (size_t)gw * D) + lane); n1 = *((const u32x4*)(xo + (size_t)gw * D + 512) + lane); }
    for (int m = gw; m < M; m += NGW) {
        const u32x4 a0 = n0, a1 = n1;
        if (m + NGW < M) { n0 = *((const u32x4*)(xo + (size_t)(m + NGW) * D) + lane); n1 = *((const u32x4*)(xo + (size_t)(m + NGW) * D + 512) + lane); }
        CFENCE();
        const float x[16] = {bflo(a0.x), bfhi(a0.x), bflo(a0.y), bfhi(a0.y), bflo(a0.z), bfhi(a0.z), bflo(a0.w), bfhi(a0.w), bflo(a1.x), bfhi(a1.x), bflo(a1.y), bfhi(a1.y), bflo(a1.z), bfhi(a1.z), bflo(a1.w), bfhi(a1.w)};
        float ss = 0.f;
#pragma unroll
        for (int j = 0; j < 16; ++j) ss += x[j] * x[j];
        ss = wave_sum(ss); const float rs = rsqrtf(ss * (1.0f / D) + EPS);
#pragma unroll
        for (int hh = 0; hh < 2; ++hh) {
            const f32x4 g0 = gv[2 * hh], g1 = gv[2 * hh + 1];
            f32x4 o0 = {x[hh * 8 + 0] * rs * g0[0], x[hh * 8 + 1] * rs * g0[1], x[hh * 8 + 2] * rs * g0[2], x[hh * 8 + 3] * rs * g0[3]};
            f32x4 o1 = {x[hh * 8 + 4] * rs * g1[0], x[hh * 8 + 5] * rs * g1[1], x[hh * 8 + 6] * rs * g1[2], x[hh * 8 + 7] * rs * g1[3]};
            *(f32x4*)(out + (size_t)m * D + hh * 512 + lane * 8) = o0; *(f32x4*)(out + (size_t)m * D + hh * 512 + lane * 8 + 4) = o1;
        }
    }
}

__global__ void __launch_bounds__(512, 2) mk_fwd(Args args) {
    extern __shared__ __attribute__((aligned(16))) unsigned char lds_raw[];
    Frame F0;
    F0.lds = (LAS unsigned char*)lds_raw; F0.tid = threadIdx.x; F0.lane = F0.tid & 63; F0.wave = __builtin_amdgcn_readfirstlane(F0.tid >> 6);
    F0.G = gridDim.x; F0.bid = blockIdx.x; F0.in = args.in; F0.ws = args.ws; F0.dout = (unsigned char*)args.out;
    const Frame& F = F0;
    volatile LAS unsigned* MISC = (volatile LAS unsigned*)(F.lds + MISC_OFF);
    for (int u = F.tid; u < (LDS_BYTES - MISC_OFF) / 4; u += 512) MISC[u] = 0u;
    __syncthreads();
#if MK_N_LAUNCHES == 1
    XcdBarrier bar = xcd_barrier_post(wsp<unsigned>(F, WS_CTL) + CW_BAR, MISC);
#define GRID_BAR() xcd_barrier(bar)
#else
#define GRID_BAR() do {} while (0)
#endif
    const int lo = args.ph_lo, hi = args.ph_hi;
#ifndef PH_MASK
#define PH_MASK 0xFFFFFFu
#endif
#define IN(k) ((((PH_MASK) >> ((k) > 7 && (k) < 13 ? (k) - 7 : (k))) & 1u) && lo <= (k) && (k) < hi)
#define SEAM(k) do { if (IN(k) && IN((k) + 1)) GRID_BAR(); } while (0)
    LAS unsigned char* ring = F.lds;
#define xb wsp<bf16>(F, WS_XB)
#define ssp wsp<float>(F, WS_SSP)
#ifndef REP_PHASE
#define REP_PHASE (-1)
#endif
#ifndef REP_N
#define REP_N 0
#endif
#define REPS(k) (((k) == REP_PHASE) ? 1 + REP_N : 1)
#define REP_BEGIN(k) for (int rep = 0; rep < REPS(k); ++rep) {
#define REP_END(k) if (rep + 1 < REPS(k)) GRID_BAR(); }
    if (IN(0)) { REP_BEGIN(0) p0_prologue(launder(F0)); REP_END(0) } SEAM(0);

#pragma unroll 1
    for (int l = 0; l < 2; ++l) {
        const int pb = 1 + 7 * l;
        if (IN(pb)) {
            REP_BEGIN(1)
            const Frame F = launder(F0);
            pg8::ProbPlain P{xb, wsp<bf16>(F, WS_WIN) + (size_t)l * NPROJ * D, D, D, D};
            pg8::StaticOrder S; S.init(M / 256, 8, F.G, F.bid);
            EpiInproj E{ssp, F.ws + WS_ACT};
            pg8::gemm_phase(ring, P, S, E);
            glow_pass(launder(F0), l);
            REP_END(1)
        } SEAM(pb);
        if (IN(pb + 1)) {
            REP_BEGIN(2)
            const Frame F = launder(F0);
#ifndef PROBE_SUB
#define PROBE_SUB 0
#endif
#pragma unroll 1
            for (int pr = 0; pr < (PROBE_SUB == 1 ? 2 : 1); ++pr) for (int un = F.bid; un < 256; un += F.G) s5_unit(F, l, un);
#pragma unroll 1
            for (int pr = 0; pr < (PROBE_SUB == 2 ? 2 : 1); ++pr) for (int wu = F.bid * 8 + F.wave; wu < 2048; wu += F.G * 8) gla_a_unit(F, l, wu);
            REP_END(2)
        } SEAM(pb + 1);
        if (IN(pb + 2)) {
            REP_BEGIN(3)
            const Frame F = launder(F0);
            pg8::ProbPlain P{(const bf16*)(F.dout + DO_YS5), wsp<bf16>(F, WS_WGLU) + (size_t)l * 512 * 512, 512, 512, 512};
            pg8::StaticOrder S; S.init(M / 256, 2, F.G, F.bid);
            EpiGlu E{(const bf16*)(F.dout + DO_YS5), wsp<bf16>(F, WS_UGM), F.in[12] + l * 512};
            pg8::gemm_phase(ring, P, S, E);
#pragma unroll 1
            for (int pr = 0; pr < (PROBE_SUB == 3 ? 2 : 1); ++pr) gla_b_scan(launder(F0));
            REP_END(3)
        } SEAM(pb + 2);
        if (IN(pb + 3)) {
            REP_BEGIN(4)
            const Frame F = launder(F0);
#pragma unroll 1
            for (int pr = 0; pr < (PROBE_SUB == 4 ? 2 : 1); ++pr) for (int wu = F.bid * 8 + F.wave; wu < 2048; wu += F.G * 8) gla_c_unit(F, l, wu);
#pragma unroll 1
            for (int pr = 0; pr < (PROBE_SUB == 5 ? 2 : 1); ++pr) { s5_fin_rows(launder(F0), l); }
            REP_END(4)
        } SEAM(pb + 3);
        if (IN(pb + 4)) {
            REP_BEGIN(5)
            const Frame F = launder(F0);
            pg8::ProbPlain P{wsp<bf16>(F, WS_MIXED), wsp<bf16>(F, WS_WOUT) + (size_t)l * D * D, D, D, D};
            pg8::StaticOrder S; S.init(M / 256, 4, F.G, F.bid);
            const bool want8 = (l == 0) ? (USE_F8_FFN != 0) : (USE_F8_MOE != 0);
            EpiResid E{xb, ssp, rep ? (bf16*)F.dout : xb, rep == 0, (want8 && rep == 0) ? wsp<unsigned char>(F, WS_X8) : nullptr, 1.0f};
            pg8::gemm_phase(ring, P, S, E);
            REP_END(5)
        } SEAM(pb + 4);
        if (l == 0) {
            if (IN(6)) {
                REP_BEGIN(6)
                const Frame F = launder(F0);
                constexpr int KU = USE_F8_FFN ? D / 2 : D;
                pg8::ProbPlainT<USE_F8_FFN != 0> P{USE_F8_FFN ? wsp<bf16>(F, WS_X8) : xb, wsp<bf16>(F, WS_WFGU), KU, KU, KU};
                pg8::StaticOrder S; S.init(M / 256, 2 * DFF / 256, F.G, F.bid);
                EpiSwigluT<USE_F8_FFN != 0> E{ssp, wsp<bf16>(F, WS_HD), DFF};
                pg8::gemm_phase(ring, P, S, E);
                REP_END(6)
            } SEAM(6);
            if (IN(7)) {
                REP_BEGIN(7)
                const Frame F = launder(F0);
                constexpr int KD = USE_F8_FFN ? DFF / 2 : DFF;
                pg8::ProbPlainT<USE_F8_FFN != 0, true> P{wsp<bf16>(F, WS_HD), wsp<bf16>(F, WS_WFD), KD, KD, KD};
                pg8::StaticOrder S; S.init(M / 256, 4, F.G, F.bid);
                EpiResid E{xb, ssp, rep ? (bf16*)F.dout : xb, rep == 0, nullptr, USE_F8_FFN ? 1.0f / (F8_SH * F8_SW_DN) : 1.0f};
                pg8::gemm_phase(ring, P, S, E);
                REP_END(7)
            } SEAM(7);
        }
    }
    if (IN(13)) { moe_router(launder(F0)); } SEAM(13);
#pragma unroll 1
    for (int s = 0; s < 5; ++s) {
        if (IN(14 + s)) {
            const Frame F = launder(F0);
            if (s == 0 || lo == 14 + s) moe_build_tables(F);
            const MoeTab T = moe_tab(F);
            int nheavy = 0;
            if (s >= 1) {
                REP_BEGIN(15)
                constexpr int KD = DFE * MOE_ESZ / 2;
                ProbMoeDown P{((s - 1) & 1) ? (void*)wsp<bf16>(F, WS_H1) : (void*)F.dout, wsp<bf16>(F, WS_MD), KD, KD, KD};
                MoeOrder S; S.init(T, s - 1, 4, F.G, F.bid, 0, 0);
                nheavy = S.nheavy_next();
                EpiMoeDown E{wsp<int>(F, WS_TOK), wsp<float>(F, WS_WL), xb, wsp<bf16>(F, WS_XO), T, rep != 0};
                pg8::gemm_phase(ring, P, S, E);
                REP_END(15)
            }
            if (s < 4) {
                REP_BEGIN(14)
                constexpr int KU = D * MOE_ESZ / 2;
                ProbMoeUp P{USE_F8_MOE ? (const void*)wsp<unsigned char>(F, WS_X8) : (const void*)xb, wsp<bf16>(F, WS_MGU), wsp<int>(F, WS_TOK), T, KU, KU, KU};
                MoeOrder S; S.init(T, s, 2 * DFE / 256, F.G, F.bid, nheavy, 3);
                EpiSwigluMoe E{wsp<float>(F, WS_RL), (s & 1) ? (void*)wsp<bf16>(F, WS_H1) : (void*)F.dout, T};
                pg8::gemm_phase(ring, P, S, E);
                REP_END(14)
            }
        } SEAM(14 + s);
    }
    if (IN(19)) { REP_BEGIN(19) final_norm(launder(F0), hi > 50); REP_END(19) }
#undef xb
#undef ssp
#undef IN
#undef SEAM
}

extern "C" void kernel_launch(void* const* d_in, const int* in_sizes, int n_in, void* d_out, int out_size, void* d_ws, size_t ws_size, hipStream_t stream) {
    static int grid = 0;
    if (grid == 0) {
        if (n_in != 27 || in_sizes[0] != M * D || out_size != M * D || ws_size < WS_END) { fprintf(stderr, "kernel_launch: unexpected shapes (n_in %d, ws %zu < %zu?)\n", n_in, ws_size, (size_t)WS_END); grid = -1; return; }
        int dev = 0, cus = 0, per_cu = 0;
        if (hipGetDevice(&dev) != hipSuccess || hipDeviceGetAttribute(&cus, hipDeviceAttributeMultiprocessorCount, dev) != hipSuccess) { grid = -1; return; }
        if (hipFuncSetAttribute((const void*)mk_fwd, hipFuncAttributeMaxDynamicSharedMemorySize, LDS_BYTES) != hipSuccess) { fprintf(stderr, "kernel_launch: hipFuncSetAttribute failed\n"); grid = -1; return; }
        if (hipOccupancyMaxActiveBlocksPerMultiprocessor(&per_cu, (const void*)mk_fwd, 512, LDS_BYTES) != hipSuccess || per_cu < 1) fprintf(stderr, "kernel_launch: occupancy query says %d\n", per_cu);
        (void)hipGetLastError();
        grid = cus;
    }
    if (grid < 0) return;
    if (hipMemsetAsync((char*)d_ws + WS_CTL, 0, CTL_ZERO_BYTES, stream) != hipSuccess) return;
    Args a{};
    for (int i = 0; i < 27; ++i) a.in[i] = (const float*)d_in[i];
    a.out = (float*)d_out; a.ws = (unsigned char*)d_ws;
#if MK_N_LAUNCHES == 1
#ifdef PROBE_PREFIX
    a.ph_lo = 0; a.ph_hi = PROBE_PREFIX + 1;
    hipLaunchKernelGGL(mk_fwd, dim3(grid), dim3(512), LDS_BYTES, stream, a);
    if (hipMemsetAsync((char*)d_ws + WS_CTL, 0, CTL_ZERO_BYTES, stream) != hipSuccess) return;
#endif
    a.ph_lo = 0; a.ph_hi = NPHASE;
    hipLaunchKernelGGL(mk_fwd, dim3(grid), dim3(512), LDS_BYTES, stream, a);
#else
#ifdef EXP_STOP
    for (int p = 0; p <= EXP_STOP; ++p) { a.ph_lo = p; a.ph_hi = p + 1; hipLaunchKernelGGL(mk_fwd, dim3(grid), dim3(512), LDS_BYTES, stream, a); }
    a.ph_lo = 19; a.ph_hi = 100; hipLaunchKernelGGL(mk_fwd, dim3(grid), dim3(512), LDS_BYTES, stream, a);
#else
    for (int p = 0; p < NPHASE; ++p) { a.ph_lo = p; a.ph_hi = p + 1; hipLaunchKernelGGL(mk_fwd, dim3(grid), dim3(512), LDS_BYTES, stream, a); }
#endif
#endif
}
```

```cpp
#include <hip/hip_runtime.h>
#include <cstdio>
#include <cstdint>

#ifndef USE_F8_FFN
#define USE_F8_FFN 0
#endif
#ifndef USE_F8_MOE
#define USE_F8_MOE 1
#endif
#ifndef MK_N_LAUNCHES
#define MK_N_LAUNCHES 1
#endif

#define LAS __attribute__((address_space(3)))
#define GAS __attribute__((address_space(1)))
typedef unsigned short bf16;
typedef short bf16x8 __attribute__((ext_vector_type(8)));
typedef short s16x4 __attribute__((ext_vector_type(4)));
typedef short v4i16_t __attribute__((ext_vector_type(4)));
typedef float f32x4 __attribute__((ext_vector_type(4)));
typedef float f32x2 __attribute__((ext_vector_type(2)));
typedef unsigned u32x4 __attribute__((ext_vector_type(4)));
typedef unsigned u32x2 __attribute__((ext_vector_type(2)));
typedef int i32x4_t __attribute__((ext_vector_type(4)));

constexpr int BATCH = 8, SEQ = 4096, D = 1024, M = BATCH * SEQ;
constexpr int DS5 = 512, NGRP = 32, NST = 64;
constexpr int GH = 4, DK = 64, DV = 128, DGK = 256, DGV = 512, NCH = SEQ / 64;
constexpr int DIN = 2064, NPROJ = 2304;
constexpr int DFF = 2816, NE = 8, DFE = 3584;
constexpr float EPS = 1e-6f;
constexpr int NPHASE = 20;

constexpr size_t MiB = 1u << 20;
constexpr size_t WS_CTL = 0, CTL_ZERO_BYTES = 2 * MiB;
constexpr size_t WS_SSP = 2 * MiB;
constexpr size_t WS_WIN = 4 * MiB;
constexpr size_t WS_WGLU = 13 * MiB;
constexpr size_t WS_WOUT = 14 * MiB;
constexpr size_t WS_WFGU = 18 * MiB;
constexpr size_t WS_WFD = 29 * MiB;
constexpr size_t WS_S5P = 35 * MiB;
constexpr size_t WS_S5MQ = 39 * MiB;
constexpr size_t WS_S5A16 = 51 * MiB;
constexpr size_t WS_WGT = 51 * MiB + 65536;
constexpr size_t WS_WA2T = 51 * MiB + 131072;
constexpr size_t WS_MGU = 52 * MiB;
constexpr size_t WS_MD = (USE_F8_MOE ? 108 : 164) * MiB;
constexpr size_t WS_X8 = (USE_F8_MOE ? 136 : 500) * MiB;
static_assert(USE_F8_MOE || !USE_F8_FFN, "x8 lives in the space the fp8 expert weights leave free");
constexpr size_t WS_XB = 220 * MiB;
constexpr size_t WS_ACT = 284 * MiB;
constexpr size_t WS_UGM = WS_ACT;
constexpr size_t WS_Q = WS_ACT + 32 * MiB;
constexpr size_t WS_K = WS_ACT + 48 * MiB;
constexpr size_t WS_V = WS_ACT + 64 * MiB;
constexpr size_t WS_R = WS_ACT + 96 * MiB;
constexpr size_t WS_GL = WS_ACT + 128 * MiB;
constexpr size_t WS_MIXED = WS_ACT + 144 * MiB;
constexpr size_t WS_HD = WS_ACT;
constexpr size_t WS_H1 = WS_ACT;
constexpr size_t WS_XO = WS_ACT + 120 * MiB;
constexpr size_t WS_TOK = WS_ACT + 184 * MiB;
constexpr size_t WS_WL = WS_ACT + 186 * MiB;
constexpr size_t WS_RL = WS_ACT + 188 * MiB;
constexpr size_t WS_DEC = WS_ACT + 208 * MiB;
constexpr size_t WS_END = WS_ACT + 209 * MiB;
constexpr size_t DO_UT = 0, DO_ST = 64 * MiB, DO_YS5 = 96 * MiB;
constexpr int MOE_CAP_TILES = 68;
constexpr int CW_BAR = 4096;
constexpr int CW_CNT = 16384;

constexpr int RING_BYTES = 131072;
constexpr int MOE_TAB_OFF = 131072;
constexpr int MISC_OFF = 147456;
constexpr int LDS_BYTES = 148480;
constexpr int WAVE_LDS = 18432;

#define LDS_WAIT() asm volatile("s_waitcnt lgkmcnt(0)" ::: "memory")
#define VM_WAIT() asm volatile("s_waitcnt vmcnt(0)" ::: "memory")
#define CFENCE() asm volatile("" ::: "memory")
__device__ __forceinline__ unsigned f2bf(float f) { unsigned u = __builtin_bit_cast(unsigned, f); return (u + 0x7fffu + ((u >> 16) & 1u)) >> 16; }
__device__ __forceinline__ unsigned pk2(float lo, float hi) { return f2bf(lo) | (f2bf(hi) << 16); }
__device__ __forceinline__ float bf2f(unsigned b) { return __builtin_bit_cast(float, b << 16); }
__device__ __forceinline__ float bflo(unsigned w) { return __builtin_bit_cast(float, w << 16); }
__device__ __forceinline__ float bfhi(unsigned w) { return __builtin_bit_cast(float, w & 0xffff0000u); }
typedef __bf16 bf16x2_t __attribute__((ext_vector_type(2)));
__device__ __forceinline__ unsigned cvt_pk_bf16(float lo, float hi) { const f32x2 v = {lo, hi}; return __builtin_bit_cast(unsigned, __builtin_convertvector(v, bf16x2_t)); }
__device__ __forceinline__ unsigned pk4_fp8(float a, float b, float c, float d) {
    a = __builtin_amdgcn_fmed3f(a, -448.f, 448.f); b = __builtin_amdgcn_fmed3f(b, -448.f, 448.f); c = __builtin_amdgcn_fmed3f(c, -448.f, 448.f); d = __builtin_amdgcn_fmed3f(d, -448.f, 448.f);
    int w = 0; w = __builtin_amdgcn_cvt_pk_fp8_f32(a, b, w, false); w = __builtin_amdgcn_cvt_pk_fp8_f32(c, d, w, true); return (unsigned)w;
}
__device__ __forceinline__ f32x2 swiglu2(f32x2 g, f32x2 u, float nrs, float c) {
    const f32x2 t = g * nrs;
    f32x2 d = {__builtin_amdgcn_exp2f(t[0]), __builtin_amdgcn_exp2f(t[1])};
    d = d + 1.0f;
    const f32x2 r = {__builtin_amdgcn_rcpf(d[0]), __builtin_amdgcn_rcpf(d[1])};
    return (g * u) * (r * c);
}
constexpr float F8_SW_UP = 64.f, F8_SH = 4.f, F8_SW_DN = 128.f;
__device__ __forceinline__ float wave_sum(float v) {
#pragma unroll
    for (int o = 1; o < 64; o <<= 1) v += __shfl_xor(v, o);
    return v;
}
__device__ __forceinline__ float sigmoidf_(float z) { return __builtin_amdgcn_rcpf(1.0f + __expf(-z)); }
__device__ __forceinline__ float siluf_(float z) { return z * __builtin_amdgcn_rcpf(1.0f + __expf(-z)); }
__device__ __forceinline__ float gelu_tanh(float y) { const float z = 0.7978845608028654f * (y + 0.044715f * y * y * y); return y * __builtin_amdgcn_rcpf(1.0f + __expf(-2.0f * z)); }

#define XB_TMO      128
#define XB_XCNT(j)  (256  + 64 * (j))
#define XB_XSUB(j)  (1280 + 64 * (j))
#define XB_XGEN(j)  (2304 + 64 * (j))
#define XB_TOP      3328
#define XB_TOPGEN   3392
#define XCD_BAR_WORDS 3456
#define XB_SPIN_CAP (1u << 18)
__device__ __forceinline__ unsigned xb_ld(unsigned* p)              { return __hip_atomic_load(p, __ATOMIC_RELAXED, __HIP_MEMORY_SCOPE_AGENT); }
__device__ __forceinline__ unsigned xb_add(unsigned* p, unsigned v) { return __hip_atomic_fetch_add(p, v, __ATOMIC_RELAXED, __HIP_MEMORY_SCOPE_AGENT); }
__device__ __forceinline__ unsigned xb_xcc_id() { return (unsigned)__builtin_amdgcn_s_getreg((3 << 11) | 20) & 0xFu; }
#define XB_SPIN(cond, bar) do { unsigned _sp = 0; while (cond) { __builtin_amdgcn_s_sleep(1); \
    if ((++_sp & 255u) == 0u) { if (xb_ld(&(bar)[XB_TMO])) break; if (_sp > XB_SPIN_CAP) { atomicAdd(&(bar)[XB_TMO], 1u); break; } } } } while (0)
struct XcdBarrier { unsigned* bar; unsigned x; volatile LAS unsigned* st; };
__device__ __forceinline__ XcdBarrier xcd_barrier_post(unsigned* bar, volatile LAS unsigned* st) {
    XcdBarrier b; b.bar = bar; b.x = xb_xcc_id(); b.st = st;
    if (threadIdx.x == 0) (void)xb_add(&bar[XB_XCNT(b.x)], 1u);
    return b;
}
__device__ __forceinline__ void xcd_barrier_complete(unsigned* bar, unsigned x, unsigned& nloc, unsigned& nx) {
    const unsigned G = gridDim.x * gridDim.y * gridDim.z;
    unsigned sum, cnt, mine, sp = 0u;
    for (;;) {
        sum = 0u; cnt = 0u; mine = 0u;
#pragma unroll
        for (unsigned j = 0; j < 16; ++j) { const unsigned c = xb_ld(&bar[XB_XCNT(j)]); sum += c; cnt += (c > 0u) ? 1u : 0u; mine = (j == x) ? c : mine; }
        if (sum == G) break;
        __builtin_amdgcn_s_sleep(1);
        if ((++sp & 255u) == 0u) { if (xb_ld(&bar[XB_TMO])) break; if (sp > XB_SPIN_CAP) { atomicAdd(&bar[XB_TMO], 1u); break; } }
    }
    nloc = mine > 0u ? mine : 1u; nx = cnt > 0u ? cnt : 1u;
}
__device__ __forceinline__ void xcd_barrier(const XcdBarrier& b) {
    asm volatile("s_waitcnt vmcnt(0)" ::: "memory");
    __syncthreads();
    if (threadIdx.x == 0) {
        unsigned* bar = b.bar;
        __builtin_amdgcn_s_waitcnt(0);
        unsigned nloc = b.st[0], nx = b.st[1];
        if (nloc == 0u) { xcd_barrier_complete(bar, b.x, nloc, nx); b.st[0] = nloc; b.st[1] = nx; }
        const unsigned old = xb_add(&bar[XB_XSUB(b.x)], 1u);
        const unsigned gen = old / nloc;
        if (old + 1u == (gen + 1u) * nloc) {
            __builtin_amdgcn_fence(__ATOMIC_RELEASE, "agent");
            asm volatile("s_waitcnt vmcnt(0)" ::: "memory");
            const unsigned og = xb_add(&bar[XB_TOP], 1u);
            const unsigned tg = og / nx;
            if (og + 1u == (tg + 1u) * nx) xb_add(&bar[XB_TOPGEN], 1u);
            else XB_SPIN(xb_ld(&bar[XB_TOPGEN]) == tg, bar);
            __builtin_amdgcn_fence(__ATOMIC_ACQUIRE, "agent");
            xb_add(&bar[XB_XGEN(b.x)], 1u);
            asm volatile("s_waitcnt vmcnt(0)" ::: "memory");
        } else {
            XB_SPIN(xb_ld(&bar[XB_XGEN(b.x)]) == gen, bar);
            __builtin_amdgcn_fence(__ATOMIC_ACQUIRE, "agent");
            asm volatile("s_waitcnt vmcnt(0)" ::: "memory");
        }
    }
    __syncthreads();
}

namespace pg8 {
constexpr int BM = 256, BK = 64, HALF = 128, HTB = HALF * BK * 2, STAGE_BYTES = 8 * HTB, NXCD = 8, WGM = 8;
constexpr int A_TAB_OFF = 131072 + 8192;
constexpr int EPI_TAB_OFF = 131072 + 4096;
__host__ __device__ __forceinline__ int lds_byte(int r, int c) { const int st = (r >> 4) * 2 + (c >> 5), rr = r & 15, cc = c & 31, ob = rr * 64 + cc * 2; return st * 1024 + (ob ^ (((ob >> 9) & 1) << 5)); }
__host__ __device__ __forceinline__ void stage_rc(int b, int& R, int& C) { const int st = b / 1024, sb = b % 1024, swz = sb ^ (((sb >> 9) & 1) << 5); R = (st >> 1) * 16 + swz / 64; C = (st & 1) * 32 + (swz % 64) / 2; }
__host__ __device__ __forceinline__ int perm32(int rho) { const int n = rho >> 4, i = rho & 15; return 8 * (i >> 2) + 4 * n + (i & 3); }

struct Unit { int pm, pn, e, sub; };

struct StaticOrder {
    int nM, nN, nwg, G, c;
    __device__ __forceinline__ void init(int nM_, int nN_, int G_, int c_) { nM = nM_; nN = nN_; nwg = nM * nN; G = G_; c = c_; }
    __device__ __forceinline__ bool next(int i, Unit& u) const {
        const long L = (long)i * G + c; if (L >= nwg) return false;
        int wgid = (int)L; { const int q = nwg / NXCD, r = nwg % NXCD, xcd = wgid % NXCD, off = wgid / NXCD; wgid = (xcd < r ? xcd * (q + 1) : r * (q + 1) + (xcd - r) * q) + off; }
        const int nig = WGM * nN, gid = wgid / nig, fm = gid * WGM, gsz = (nM - fm) < WGM ? (nM - fm) : WGM;
        u.pm = fm + ((wgid % nig) % gsz); u.pn = (wgid % nig) / gsz; u.e = 0; u.sub = 0; return true;
    }
};

template <class Epi, class Sched, class Prob>
__device__ __forceinline__ void gemm_phase(LAS unsigned char* lds, const Prob& P, const Sched& S, const Epi& E) {
    int tid_ = threadIdx.x; asm volatile("" : "+v"(tid_));
    const int tid = tid_, wid = __builtin_amdgcn_readfirstlane(tid >> 6), lane = tid & 63, wr = wid >> 2, wc = wid & 3, fr = lane & 15, fq = lane >> 4;
    const int K = P.K, nt = K / BK;
    int Rr[2], Cc[2]; unsigned voffB[2];
#pragma unroll
    for (int i = 0; i < 2; ++i) { int R, C; stage_rc(tid * 16 + i * 8192, R, C); Rr[i] = R; Cc[i] = C; const int Rb = (R & ~31) + perm32(R & 31); voffB[i] = (unsigned)(Rb * P.ldb + C) * 2u; }
    const size_t kstep = (size_t)(BK * 2);
    const size_t hstepB = (size_t)HALF * P.ldb * 2;
    const unsigned ldsw = (unsigned)wid * 1024u;
    const int aoff = lds_byte(wr * 64 + fr, fq * 8), boff = lds_byte(wc * 32 + fr, fq * 8);
#define PG8_SA(b, h) (((b) * 2 + (h)) * HTB)
#define PG8_SB(b, h) ((4 + (b) * 2 + (h)) * HTB)
#define PG8_STAGE(bufoff, gbase, voff) do { _Pragma("unroll") for (int _i = 0; _i < 2; ++_i) \
        __builtin_amdgcn_global_load_lds((const unsigned*)((const char*)(gbase) + (voff)[_i]), (LAS unsigned*)(lds + (bufoff) + ldsw + _i * 8192), 16, 0, 0); } while (0)
#define PG8_LDA(dst, b, h) do { _Pragma("unroll") for (int m = 0; m < 4; ++m) _Pragma("unroll") for (int k = 0; k < 2; ++k) dst[m][k] = *(const LAS bf16x8*)(lds + PG8_SA(b, h) + aoff + m * 2048 + k * 1024); } while (0)
#define PG8_LDB(dst, b, h) do { _Pragma("unroll") for (int n = 0; n < 2; ++n) _Pragma("unroll") for (int k = 0; k < 2; ++k) dst[n][k] = *(const LAS bf16x8*)(lds + PG8_SB(b, h) + boff + n * 2048 + k * 1024); } while (0)
#define PG8_CAT(x) __builtin_shufflevector(__builtin_bit_cast(i32x4_t, (x)[0]), __builtin_bit_cast(i32x4_t, (x)[1]), 0, 1, 2, 3, 4, 5, 6, 7)
#define PG8_MMA(ai, bj, At, Bt) do { __builtin_amdgcn_s_setprio(1); _Pragma("unroll") for (int m = 0; m < 4; ++m) _Pragma("unroll") for (int n = 0; n < 2; ++n) { \
        if constexpr (Prob::F8) asm volatile("v_mfma_scale_f32_16x16x128_f8f6f4 %0, %1, %2, %0, %3, %3 op_sel_hi:[0,0,0]" : "+v"(acc[ai][bj][m][n]) : "v"(PG8_CAT(Bt[n])), "v"(PG8_CAT(At[m])), "v"(f8one)); \
        else { _Pragma("unroll") for (int k = 0; k < 2; ++k) acc[ai][bj][m][n] = __builtin_amdgcn_mfma_f32_16x16x32_bf16(Bt[n][k], At[m][k], acc[ai][bj][m][n], 0, 0, 0); } } \
        __builtin_amdgcn_s_setprio(0); } while (0)
#define PG8_WAIT_V(n) asm volatile("s_waitcnt vmcnt(" #n ")" ::: "memory")
#define PG8_WAIT_L(n) asm volatile("s_waitcnt lgkmcnt(" #n ")" ::: "memory")
#define PG8_BAR __builtin_amdgcn_s_barrier()
#define PG8_SCHED __builtin_amdgcn_sched_barrier(0)
    const int f8one = 0x7f7f7f7f;
    Unit cur, nxt; int ui = 0;
    if (!S.next(0, cur)) return;
    f32x4 acc[2][2][4][2];
#pragma unroll
    for (int a = 0; a < 2; ++a)
#pragma unroll
        for (int b = 0; b < 2; ++b)
#pragma unroll
            for (int m = 0; m < 4; ++m)
#pragma unroll
                for (int n = 0; n < 2; ++n) acc[a][b][m][n] = (f32x4){0.f, 0.f, 0.f, 0.f};
    bf16x8 At[4][2], B0[2][2], B1[2][2];
    constexpr bool GA = Prob::GATHER;
    constexpr int NH = GA ? 2 : 1;
    unsigned vA[NH][2], nvA[NH][2];
    const size_t hstepA = GA ? (size_t)0 : P.hstep_a();
    const size_t kstepA = P.kstep_a();
    P.a_off(cur, Rr, Cc, vA);
    const char* cA = P.a_ptr(cur); const char* cB = P.b_ptr(cur);
#define PG8_STAGEA(bufoff, gbase, h, arr) do { _Pragma("unroll") for (int _i = 0; _i < 2; ++_i) \
        __builtin_amdgcn_global_load_lds((const unsigned*)((const char*)(gbase) + (GA ? (size_t)0 : (size_t)(h) * hstepA) + (arr)[GA ? (h) : 0][_i]), (LAS unsigned*)(lds + (bufoff) + ldsw + _i * 8192), 16, 0, 0); } while (0)
    if constexpr (GA) { Unit u1; if (S.next(1, u1)) P.atab_issue(u1, lds + A_TAB_OFF + 1024, wid, lane); }
    PG8_STAGE(PG8_SB(0, 0), cB, voffB); PG8_STAGE(PG8_SB(0, 1), cB + hstepB, voffB); PG8_STAGEA(PG8_SA(0, 0), cA, 0, vA); PG8_STAGEA(PG8_SA(0, 1), cA, 1, vA);
    if (wr == 1) PG8_BAR;
    PG8_WAIT_V(2); PG8_BAR;
    PG8_STAGE(PG8_SB(1, 0), cB + kstep, voffB); PG8_STAGEA(PG8_SA(1, 0), cA + kstepA, 0, vA); PG8_STAGE(PG8_SB(1, 1), cB + hstepB + kstep, voffB);
    PG8_WAIT_V(6); PG8_BAR;
    for (;;) {
        const bool has_next = S.next(ui + 1, nxt);
        const char* nA = has_next ? P.a_ptr(nxt) : cA; const char* nB = has_next ? P.b_ptr(nxt) : cB;
        if constexpr (GA) {
            if (has_next) { int R2[2], C2[2], t2 = tid; asm volatile("" : "+v"(t2));
#pragma unroll
                for (int i = 0; i < 2; ++i) stage_rc(t2 * 16 + i * 8192, R2[i], C2[i]);
                P.a_off_tab(lds + A_TAB_OFF + ((ui + 1) & 1) * 1024, R2, C2, nvA);
                Unit n2; if (S.next(ui + 2, n2)) P.atab_issue(n2, lds + A_TAB_OFF + (ui & 1) * 1024, wid, lane); }
            else {
#pragma unroll
                for (int h = 0; h < NH; ++h)
#pragma unroll
                    for (int i = 0; i < 2; ++i) nvA[h][i] = vA[h][i];
            }
        }
        if constexpr (Epi::HAS_TAB) E.tab_issue(cur, lds + EPI_TAB_OFF + (ui & 1) * 2048, wid, lane);
        for (int t = 0; t < nt; t += 2) {
            const bool last = (t == nt - 2);
            const char* a1 = cA + (size_t)(t + 1) * kstepA;
            const char* a2 = last ? nA : cA + (size_t)(t + 2) * kstepA; const char* b2 = last ? nB : cB + (size_t)(t + 2) * kstep;
            const char* a3 = a2 + kstepA; const char* b3 = b2 + kstep;
            unsigned wA[NH][2];
#pragma unroll
            for (int h = 0; h < NH; ++h)
#pragma unroll
                for (int i = 0; i < 2; ++i) wA[h][i] = (GA && last) ? nvA[h][i] : vA[h][i];
            PG8_LDB(B0, 0, 0); PG8_LDB(B1, 0, 1); PG8_SCHED; PG8_LDA(At, 0, 0); PG8_STAGEA(PG8_SA(1, 1), a1, 1, vA);
            PG8_WAIT_V(8); PG8_WAIT_L(0); PG8_BAR; PG8_MMA(0, 0, At, B0); PG8_MMA(0, 1, At, B1); PG8_BAR; PG8_SCHED;
            PG8_LDA(At, 0, 1); PG8_STAGE(PG8_SB(0, 0), b2, voffB); PG8_STAGE(PG8_SB(0, 1), b2 + hstepB, voffB); PG8_STAGEA(PG8_SA(0, 0), a2, 0, wA);
            PG8_WAIT_V(8); PG8_WAIT_L(0); PG8_BAR; PG8_MMA(1, 0, At, B0); PG8_MMA(1, 1, At, B1); PG8_BAR; PG8_SCHED;
            PG8_LDB(B0, 1, 0); PG8_LDB(B1, 1, 1); PG8_SCHED; PG8_LDA(At, 1, 0); PG8_STAGEA(PG8_SA(0, 1), a2, 1, wA);
            PG8_WAIT_V(8); PG8_WAIT_L(0); PG8_BAR; PG8_MMA(0, 0, At, B0); PG8_MMA(0, 1, At, B1); PG8_BAR; PG8_SCHED;
            PG8_LDA(At, 1, 1); PG8_STAGE(PG8_SB(1, 0), b3, voffB); PG8_STAGE(PG8_SB(1, 1), b3 + hstepB, voffB); PG8_STAGEA(PG8_SA(1, 0), a3, 0, wA);
            PG8_WAIT_V(8); PG8_WAIT_L(0); PG8_BAR; PG8_MMA(1, 0, At, B0); PG8_MMA(1, 1, At, B1); PG8_BAR; PG8_SCHED;
        }
        if (wr == 0) PG8_BAR;
        if constexpr (Prob::F8) asm volatile("s_nop 15\n\ts_nop 7" ::: "memory");
        if constexpr (Epi::HAS_TAB) E(acc, cur, wr, wc, fr, fq, lds + EPI_TAB_OFF + (ui & 1) * 2048);
        else E(acc, cur, wr, wc, fr, fq);
        if (!has_next) break;
#pragma unroll
        for (int a = 0; a < 2; ++a)
#pragma unroll
            for (int b = 0; b < 2; ++b)
#pragma unroll
                for (int m = 0; m < 4; ++m)
#pragma unroll
                    for (int n = 0; n < 2; ++n) acc[a][b][m][n] = (f32x4){0.f, 0.f, 0.f, 0.f};
        cur = nxt; cA = nA; cB = nB; ++ui;
        if constexpr (GA) {
#pragma unroll
            for (int h = 0; h < NH; ++h)
#pragma unroll
                for (int i = 0; i < 2; ++i) vA[h][i] = nvA[h][i];
        }
        if (wr == 1) PG8_BAR;
    }
    PG8_WAIT_V(0);
    PG8_BAR;
#undef PG8_SA
#undef PG8_SB
#undef PG8_STAGE
#undef PG8_STAGEA
#undef PG8_LDA
#undef PG8_LDB
#undef PG8_MMA
#undef PG8_CAT
#undef PG8_WAIT_V
#undef PG8_WAIT_L
#undef PG8_BAR
#undef PG8_SCHED
}

template <bool F8_ = false, bool TILED_ = false> struct ProbPlainT {
    static constexpr bool GATHER = false, F8 = F8_;
    const bf16* A; const bf16* Bt; int lda, ldb, K;
    __device__ __forceinline__ const char* a_ptr(const Unit& u) const { return TILED_ ? (const char*)A + (size_t)u.pm * (K / BK) * 32768 : (const char*)(A + (size_t)u.pm * BM * lda); }
    __device__ __forceinline__ const char* b_ptr(const Unit& u) const { return (const char*)(Bt + (size_t)u.pn * BM * ldb); }
    __device__ __forceinline__ size_t hstep_a() const { return TILED_ ? (size_t)4096 : (size_t)HALF * lda * 2; }
    __device__ __forceinline__ size_t kstep_a() const { return TILED_ ? (size_t)32768 : (size_t)(BK * 2); }
    __device__ __forceinline__ void a_off(const Unit&, const int (&R)[2], const int (&C)[2], unsigned (&off)[1][2]) const {
#pragma unroll
        for (int i = 0; i < 2; ++i) {
            if (TILED_) { const int wr = R[i] >> 6, m = (R[i] >> 4) & 3, fr = R[i] & 15, cb = 2 * C[i]; off[0][i] = (unsigned)((((wr * 2 + (cb >> 6)) * 2) * 4 + m) * 1024 + fr * 64 + (cb & 63)); }
            else off[0][i] = (unsigned)(R[i] * lda + C[i]) * 2u;
        }
    }
};
typedef ProbPlainT<false> ProbPlain;
}

struct Args { const float* in[27]; float* out; unsigned char* ws; int ph_lo, ph_hi; };
struct Frame {
    LAS unsigned char* lds;
    int tid, lane, wave, G, bid;
    const float* const* in; unsigned char* ws; unsigned char* dout;
};
template <class T> __device__ __forceinline__ T* wsp(const Frame& F, size_t off) { return (T*)(F.ws + off); }
__device__ __forceinline__ Frame launder(const Frame& F0) {
    Frame F = F0; int t = F0.tid; asm volatile("" : "+v"(t)); F.tid = t; F.lane = t & 63; F.wave = __builtin_amdgcn_readfirstlane(t >> 6);
    int z = 0; asm volatile("" : "+s"(z));
    F.ws = F0.ws + z; F.dout = F0.dout + z; F.in = (const float* const*)((const char*)F0.in + z); return F;
}

__device__ __forceinline__ float row_rstd(const float* ssp, int r) {
    const f32x4* p = (const f32x4*)(ssp + (size_t)r * 16);
    const f32x4 a = p[0], b = p[1], c = p[2], d = p[3];
    const float s = ((a[0] + a[1]) + (a[2] + a[3])) + ((b[0] + b[1]) + (b[2] + b[3])) + ((c[0] + c[1]) + (c[2] + c[3])) + ((d[0] + d[1]) + (d[2] + d[3]));
    return rsqrtf(s * (1.0f / D) + EPS);
}

typedef pg8::Unit Unit;
struct EpiInproj {
    static constexpr bool HAS_TAB = false;
    const float* ssp; unsigned char* act;
    __device__ __forceinline__ void operator()(const f32x4 (&acc)[2][2][4][2], const Unit& u, int wr, int wc, int fr, int fq) const {
        static_assert(WS_UGM == WS_ACT && WS_Q == WS_ACT + 32 * MiB && WS_K == WS_ACT + 48 * MiB && WS_V == WS_ACT + 64 * MiB && WS_R == WS_ACT + 96 * MiB, "in-proj destination arithmetic");
        const unsigned pn = (unsigned)u.pn;
        const bool isu = pn < 2u;
        bf16* const base = (bf16*)(act + (size_t)((0x66443200u >> (4u * pn)) & 15u) * (16 * MiB));
        const unsigned stride = 512u >> ((0x0Cu >> pn) & 1u);
        const unsigned cb = ((pn >> 2) & pn & 1u) * 256u;
#pragma unroll
        for (int ai = 0; ai < 2; ++ai) {
            float rs4[4];
#pragma unroll
            for (int m = 0; m < 4; ++m) rs4[m] = row_rstd(ssp, u.pm * 256 + ai * 128 + wr * 64 + m * 16 + fr);
            CFENCE();
#pragma unroll
            for (int m = 0; m < 4; ++m) {
                const unsigned row = (unsigned)(u.pm * 256 + ai * 128 + wr * 64 + m * 16 + fr);
                const float rs = rs4[m];
                const unsigned ro = isu ? ((row >> 12) * 2097152u + (row & 4095u) * 16u) : row * stride;
#pragma unroll
                for (int bj = 0; bj < 2; ++bj) {
                    const unsigned cl = (unsigned)(bj * 128 + wc * 32 + 8 * fq);
                    f32x4 v0 = acc[ai][bj][m][0] * rs, v1 = acc[ai][bj][m][1] * rs;
                    const unsigned co = isu ? ((pn * 256u + cl) >> 4) * 65536u + ((cl >> 3) & 1u) * 8u : cb + cl;
                    u32x4 w; w.x = cvt_pk_bf16(v0[0], v0[1]); w.y = cvt_pk_bf16(v0[2], v0[3]); w.z = cvt_pk_bf16(v1[0], v1[1]); w.w = cvt_pk_bf16(v1[2], v1[3]);
                    *(u32x4*)(base + (size_t)(ro + co)) = w;
                }
            }
            CFENCE();
        }
    }
};
struct EpiGlu {
    static constexpr bool HAS_TAB = false;
    const bf16* ys5; bf16* yglu; const float* bglu;
    __device__ __forceinline__ void operator()(const f32x4 (&acc)[2][2][4][2], const Unit& u, int wr, int wc, int fr, int fq) const {
        const int colb = u.pn * 256 + wc * 32 + 8 * fq;
        const bf16* src = ys5 + (size_t)(u.pm * 256 + wr * 64 + fr) * 512 + colb;
        u32x4 nx[4][2];
#pragma unroll
        for (int g = 0; g < 4; ++g) { const bf16* s1 = src + (size_t)((g >> 2) * 128 + (g & 3) * 16) * 512; nx[g][0] = *(const u32x4*)s1; nx[g][1] = *(const u32x4*)(s1 + 128); }
#pragma unroll
        for (int g = 0; g < 8; ++g) {
            const int ai = g >> 2, m = g & 3;
            const u32x4 a2[2] = {nx[g & 3][0], nx[g & 3][1]};
            if (g < 4) { const int g1 = g + 4; const bf16* s1 = src + (size_t)((g1 >> 2) * 128 + (g1 & 3) * 16) * 512; nx[g & 3][0] = *(const u32x4*)s1; nx[g & 3][1] = *(const u32x4*)(s1 + 128); }
            CFENCE();
            const int row = u.pm * 256 + ai * 128 + wr * 64 + m * 16 + fr;
#pragma unroll
            for (int bj = 0; bj < 2; ++bj) {
                const int col = colb + bj * 128;
                const u32x4 a = a2[bj];
                const f32x4 b0 = *(const f32x4*)(bglu + col), b1 = *(const f32x4*)(bglu + col + 4);
                const f32x4 v0 = acc[ai][bj][m][0] + b0, v1 = acc[ai][bj][m][1] + b1;
                u32x4 w;
                w.x = cvt_pk_bf16(bflo(a.x) * sigmoidf_(v0[0]), bfhi(a.x) * sigmoidf_(v0[1]));
                w.y = cvt_pk_bf16(bflo(a.y) * sigmoidf_(v0[2]), bfhi(a.y) * sigmoidf_(v0[3]));
                w.z = cvt_pk_bf16(bflo(a.z) * sigmoidf_(v1[0]), bfhi(a.z) * sigmoidf_(v1[1]));
                w.w = cvt_pk_bf16(bflo(a.w) * sigmoidf_(v1[2]), bfhi(a.w) * sigmoidf_(v1[3]));
                *(u32x4*)(yglu + (size_t)row * 512 + col) = w;
            }
        }
        CFENCE();
    }
};
struct EpiResid {
    static constexpr bool HAS_TAB = false;
    bf16* xb; float* ssp; bf16* dst; bool wr_ssp;
    unsigned char* x8;
    float ascale;
    __device__ __forceinline__ void operator()(const f32x4 (&acc)[2][2][4][2], const Unit& u, int wr, int wc, int fr, int fq) const {
        const int colb = u.pn * 256 + wc * 32 + 8 * fq;
        const bf16* src = xb + (size_t)(u.pm * 256 + wr * 64 + fr) * D + colb;
        u32x4 nx[4][2];
#pragma unroll
        for (int g = 0; g < 4; ++g) { const bf16* s1 = src + (size_t)((g >> 2) * 128 + (g & 3) * 16) * D; nx[g][0] = *(const u32x4*)s1; nx[g][1] = *(const u32x4*)(s1 + 128); }
#pragma unroll
        for (int g = 0; g < 8; ++g) {
            const int ai = g >> 2, m = g & 3;
            const u32x4 a2[2] = {nx[g & 3][0], nx[g & 3][1]};
            if (g < 4) { const int g1 = g + 4; const bf16* s1 = src + (size_t)((g1 >> 2) * 128 + (g1 & 3) * 16) * D; nx[g & 3][0] = *(const u32x4*)s1; nx[g & 3][1] = *(const u32x4*)(s1 + 128); }
            CFENCE();
            const int row = u.pm * 256 + ai * 128 + wr * 64 + m * 16 + fr;
            float ss = 0.f;
#pragma unroll
            for (int bj = 0; bj < 2; ++bj) {
                const int col = colb + bj * 128;
                const u32x4 a = a2[bj];
                const f32x4 v0 = acc[ai][bj][m][0] * ascale + (f32x4){bflo(a.x), bfhi(a.x), bflo(a.y), bfhi(a.y)};
                const f32x4 v1 = acc[ai][bj][m][1] * ascale + (f32x4){bflo(a.z), bfhi(a.z), bflo(a.w), bfhi(a.w)};
                ss += (v0[0] * v0[0] + v0[1] * v0[1]) + (v0[2] * v0[2] + v0[3] * v0[3]) + (v1[0] * v1[0] + v1[1] * v1[1]) + (v1[2] * v1[2] + v1[3] * v1[3]);
                u32x4 w; w.x = cvt_pk_bf16(v0[0], v0[1]); w.y = cvt_pk_bf16(v0[2], v0[3]); w.z = cvt_pk_bf16(v1[0], v1[1]); w.w = cvt_pk_bf16(v1[2], v1[3]);
                *(u32x4*)(dst + (size_t)row * D + col) = w;
                if (x8) { u32x2 q; q.x = pk4_fp8(v0[0], v0[1], v0[2], v0[3]); q.y = pk4_fp8(v1[0], v1[1], v1[2], v1[3]); *(u32x2*)(x8 + (size_t)row * D + col) = q; }
            }
            ss += __shfl_xor(ss, 16); ss += __shfl_xor(ss, 32);
            if (fq == 0 && wr_ssp) ssp[(size_t)row * 16 + u.pn * 4 + wc] = ss;
        }
        CFENCE();
    }
};
template <bool F8> struct EpiSwigluT {
    static constexpr bool HAS_TAB = false;
    const float* ssp; bf16* h; int ldh;
    __device__ __forceinline__ void operator()(const f32x4 (&acc)[2][2][4][2], const Unit& u, int wr, int wc, int fr, int fq) const {
#pragma unroll
        for (int ai = 0; ai < 2; ++ai) {
            float rs4[4];
#pragma unroll
            for (int m = 0; m < 4; ++m) rs4[m] = row_rstd(ssp, u.pm * 256 + ai * 128 + wr * 64 + m * 16 + fr);
            CFENCE();
#pragma unroll
            for (int m = 0; m < 4; ++m) {
                const int row = u.pm * 256 + ai * 128 + wr * 64 + m * 16 + fr;
                const float rs = rs4[m] * (F8 ? 1.0f / F8_SW_UP : 1.0f);
                const float hs = F8 ? F8_SH : 1.0f, nrs = rs * -1.4426950408889634f, cc = rs * rs * hs;
                const f32x4 ga = acc[ai][0][m][0], gb = acc[ai][0][m][1], ua = acc[ai][1][m][0], ub = acc[ai][1][m][1];
                const f32x2 p0 = swiglu2((f32x2){ga[0], ga[1]}, (f32x2){ua[0], ua[1]}, nrs, cc), p1 = swiglu2((f32x2){ga[2], ga[3]}, (f32x2){ua[2], ua[3]}, nrs, cc);
                const f32x2 p2 = swiglu2((f32x2){gb[0], gb[1]}, (f32x2){ub[0], ub[1]}, nrs, cc), p3 = swiglu2((f32x2){gb[2], gb[3]}, (f32x2){ub[2], ub[3]}, nrs, cc);
                const f32x4 h0 = {p0[0], p0[1], p1[0], p1[1]}, h1 = {p2[0], p2[1], p3[0], p3[1]};
                const int col = u.pn * 128 + wc * 32 + 8 * fq;
                static_assert(!F8, "the dense tile-major hidden layout is written for bf16");
                const size_t to = ((size_t)u.pm * (2 * ldh / 128) + 2 * u.pn + (wc >> 1)) * 32768 + (size_t)(((((wr * 2 + (wc & 1)) * 2 + ai) * 4 + m) * 1024) + fr * 64 + 16 * fq);
                if constexpr (F8) { u32x2 q; q.x = pk4_fp8(h0[0], h0[1], h0[2], h0[3]); q.y = pk4_fp8(h1[0], h1[1], h1[2], h1[3]); *(u32x2*)((unsigned char*)h + (size_t)row * ldh + col) = q; }
                else { u32x4 w; w.x = cvt_pk_bf16(h0[0], h0[1]); w.y = cvt_pk_bf16(h0[2], h0[3]); w.z = cvt_pk_bf16(h1[0], h1[1]); w.w = cvt_pk_bf16(h1[2], h1[3]); *(u32x4*)((unsigned char*)h + to) = w; }
            }
            CFENCE();
        }
    }
};

struct MoeTab { LAS int* cnt; LAS int* cb; LAS short* tl_list; LAS short* tl_sub; };
__device__ __forceinline__ MoeTab moe_tab(const Frame& F) {
    MoeTab T; T.cnt = (LAS int*)(F.lds + MOE_TAB_OFF); T.cb = T.cnt + 16; T.tl_list = (LAS short*)(T.cb + 8); T.tl_sub = T.tl_list + 288; return T;
}
__device__ __forceinline__ void moe_build_tables(const Frame& F) {
    MoeTab T = moe_tab(F);
    if (F.tid < 16) { const unsigned* gc = wsp<unsigned>(F, WS_CTL) + CW_CNT; int c = (int)__hip_atomic_load(gc + F.tid, __ATOMIC_RELAXED, __HIP_MEMORY_SCOPE_AGENT); if (c > 32768) c = 32768; T.cnt[F.tid] = c; }
    __syncthreads();
    if (F.tid < 16) {
        int tot = 0;
#pragma unroll 1
        for (int l = 0; l < F.tid; ++l) tot += (T.cnt[l] + 255) >> 8;
        const int nt_ = (T.cnt[F.tid] + 255) >> 8;
#pragma unroll 1
        for (int s = 0; s < nt_; ++s) { T.tl_list[tot + s] = (short)F.tid; T.tl_sub[tot + s] = (short)s; }
    }
    if (F.tid == 0) {
        int tr0 = 0, tr1 = 0;
#pragma unroll 1
        for (int l = 0; l < 16; ++l) { const int nt_ = (T.cnt[l] + 255) >> 8; if (l < 8) tr0 += nt_; else tr1 += nt_; }
        const int c0 = (tr0 > 64 + MOE_CAP_TILES) ? tr0 - MOE_CAP_TILES : (tr0 < 64 ? tr0 : 64);
        const int c3 = (tr1 > 64 + MOE_CAP_TILES) ? tr1 - MOE_CAP_TILES : (tr1 < 64 ? tr1 : 64);
        T.cb[0] = 0; T.cb[1] = c0; T.cb[2] = tr0; T.cb[3] = tr0 + tr1 - c3; T.cb[4] = tr0 + tr1;
    }
    __syncthreads();
}
struct MoeOrder {
    MoeTab T; int t0, ntile, nN, lo, nloc, j, nbx, nheavy, skip;
    __device__ __forceinline__ void init(const MoeTab& T_, int chunk, int nN_, int G, int bid, int nheavy_, int skip_) {
        T = T_; t0 = T.cb[chunk]; ntile = T.cb[chunk + 1] - t0; nN = nN_;
        const int total = ntile * nN, x = bid & 7, q = total >> 3, r = total & 7;
        lo = (x < r) ? x * (q + 1) : r * (q + 1) + (x - r) * q; nloc = q + (x < r ? 1 : 0);
        j = bid >> 3; nbx = (G - x + 7) >> 3; nheavy = nheavy_; skip = skip_;
    }
    __device__ __forceinline__ int nheavy_next() const { return nloc % nbx; }
    __device__ __forceinline__ bool next(int i, Unit& u) const {
        int k;
        if (j < nheavy) k = skip * (nbx - nheavy) + i * nbx + j;
        else k = (i < skip) ? i * (nbx - nheavy) + (j - nheavy) : skip * (nbx - nheavy) + (i - skip) * nbx + j;
        if (k >= nloc) return false;
        const int idx = lo + k, nig = 8 * nN, gid = idx / nig, fm = gid * 8, gsz = (ntile - fm) < 8 ? (ntile - fm) : 8, w = idx - gid * nig;
        const int tl = fm + w % gsz; u.pm = tl; u.pn = w / gsz; u.e = T.tl_list[t0 + tl]; u.sub = T.tl_sub[t0 + tl]; return true;
    }
};
constexpr int MOE_ESZ = USE_F8_MOE ? 1 : 2;
struct ProbMoeUp {
    static constexpr bool GATHER = true, F8 = USE_F8_MOE != 0;
    const void* xa; const void* wgu; const int* tok; MoeTab T; int lda, ldb, K;
    __device__ __forceinline__ const char* a_ptr(const Unit&) const { return (const char*)xa; }
    __device__ __forceinline__ size_t hstep_a() const { return 0; }
    __device__ __forceinline__ size_t kstep_a() const { return 128; }
    __device__ __forceinline__ const char* b_ptr(const Unit& u) const { return (const char*)wgu + ((size_t)(u.e & 7) * (2 * DFE) + (size_t)u.pn * 256) * D * MOE_ESZ; }
    __device__ __forceinline__ void a_off(const Unit& u, const int (&R)[2], const int (&C)[2], unsigned (&off)[2][2]) const {
        const int cnt = T.cnt[u.e];
#pragma unroll
        for (int h = 0; h < 2; ++h)
#pragma unroll
            for (int i = 0; i < 2; ++i) { int p = u.sub * 256 + h * 128 + R[i]; p = (p < cnt) ? p : 0; const int t = tok[u.e * 32768 + p]; off[h][i] = (unsigned)(t * lda + C[i]) * 2u; }
    }
    __device__ __forceinline__ void atab_issue(const Unit& u, LAS unsigned char* tab, int wid, int lane) const {
        if (wid < 4) { const int cnt = T.cnt[u.e]; int p = u.sub * 256 + wid * 64 + lane; p = (p < cnt) ? p : 0;
            __builtin_amdgcn_global_load_lds((const unsigned*)(tok + u.e * 32768 + p), (LAS unsigned*)(tab + wid * 256), 4, 0, 0); }
    }
    __device__ __forceinline__ void a_off_tab(const LAS unsigned char* tab, const int (&R)[2], const int (&C)[2], unsigned (&off)[2][2]) const {
#pragma unroll
        for (int h = 0; h < 2; ++h)
#pragma unroll
            for (int i = 0; i < 2; ++i) { const int t = *(const LAS int*)(tab + (h * 128 + R[i]) * 4); off[h][i] = (unsigned)(t * lda + C[i]) * 2u; }
    }
};
struct ProbMoeDown {
    static constexpr bool GATHER = false, F8 = USE_F8_MOE != 0;
    const void* h; const void* wd; int lda, ldb, K;
    static constexpr bool TILED = USE_F8_MOE != 0;
    __device__ __forceinline__ const char* a_ptr(const Unit& u) const { return TILED ? (const char*)h + (size_t)u.pm * (DFE / 128) * 32768 : (const char*)h + (size_t)u.pm * 256 * DFE * MOE_ESZ; }
    __device__ __forceinline__ const char* b_ptr(const Unit& u) const { return (const char*)wd + ((size_t)(u.e & 7) * D + (size_t)u.pn * 256) * DFE * MOE_ESZ; }
    __device__ __forceinline__ size_t hstep_a() const { return TILED ? (size_t)2048 : (size_t)128 * lda * 2; }
    __device__ __forceinline__ size_t kstep_a() const { return TILED ? (size_t)32768 : (size_t)128; }
    __device__ __forceinline__ void a_off(const Unit&, const int (&R)[2], const int (&C)[2], unsigned (&off)[1][2]) const {
#pragma unroll
        for (int i = 0; i < 2; ++i) {
            if (TILED) { const int wr = R[i] >> 6, m = (R[i] >> 4) & 3, fr = R[i] & 15, cb = 2 * C[i]; off[0][i] = (unsigned)((((wr * 4 + (cb >> 5)) * 2) * 4 + m) * 512 + fr * 32 + (cb & 31)); }
            else off[0][i] = (unsigned)(R[i] * lda + C[i]) * 2u;
        }
    }
};
struct EpiSwigluMoe {
    static constexpr bool HAS_TAB = true;
    const float* rl; void* h; MoeTab T;
    __device__ __forceinline__ void tab_issue(const Unit& u, LAS unsigned char* tab, int wid, int lane) const {
        if (wid < 4) { const int cnt = T.cnt[u.e]; int p = u.sub * 256 + wid * 64 + lane; p = (p < cnt) ? p : 0;
            __builtin_amdgcn_global_load_lds((const unsigned*)(rl + u.e * 32768 + p), (LAS unsigned*)(tab + wid * 256), 4, 0, 0); }
    }
    __device__ __forceinline__ void operator()(const f32x4 (&acc)[2][2][4][2], const Unit& u, int wr, int wc, int fr, int fq, const LAS unsigned char* tab) const {
        constexpr bool F8 = USE_F8_MOE != 0;
        const int cnt = T.cnt[u.e];
        float rs8[8];
#pragma unroll
        for (int g = 0; g < 8; ++g) { const int rl_ = (g >> 2) * 128 + wr * 64 + (g & 3) * 16 + fr, p = u.sub * 256 + rl_; const float v = *(const LAS float*)(tab + rl_ * 4); rs8[g] = (p < cnt) ? v * (F8 ? 1.0f / F8_SW_UP : 1.0f) : 0.f; }
        CFENCE();
#pragma unroll
        for (int ai = 0; ai < 2; ++ai)
#pragma unroll
            for (int m = 0; m < 4; ++m) {
                const int rl_ = ai * 128 + wr * 64 + m * 16 + fr;
                const float rs = rs8[ai * 4 + m];
                const float hs = F8 ? F8_SH : 1.0f, nrs = rs * -1.4426950408889634f, cc = rs * rs * hs;
                const f32x4 ga = acc[ai][0][m][0], gb = acc[ai][0][m][1], ua = acc[ai][1][m][0], ub = acc[ai][1][m][1];
                const f32x2 p0 = swiglu2((f32x2){ga[0], ga[1]}, (f32x2){ua[0], ua[1]}, nrs, cc), p1 = swiglu2((f32x2){ga[2], ga[3]}, (f32x2){ua[2], ua[3]}, nrs, cc);
                const f32x2 p2 = swiglu2((f32x2){gb[0], gb[1]}, (f32x2){ub[0], ub[1]}, nrs, cc), p3 = swiglu2((f32x2){gb[2], gb[3]}, (f32x2){ub[2], ub[3]}, nrs, cc);
                const f32x4 h0 = {p0[0], p0[1], p1[0], p1[1]}, h1 = {p2[0], p2[1], p3[0], p3[1]};
                const size_t eo = F8 ? ((size_t)(u.pm * (DFE / 128) + u.pn) * 32768 + (size_t)((((wr * 4 + wc) * 2 + ai) * 4 + m) * 512 + fr * 32 + 8 * fq))
                                     : ((size_t)(u.pm * 256 + rl_) * DFE + u.pn * 128 + wc * 32 + 8 * fq);
                if constexpr (F8) { u32x2 q; q.x = pk4_fp8(h0[0], h0[1], h0[2], h0[3]); q.y = pk4_fp8(h1[0], h1[1], h1[2], h1[3]); *(u32x2*)((unsigned char*)h + eo) = q; }
                else { u32x4 w; w.x = cvt_pk_bf16(h0[0], h0[1]); w.y = cvt_pk_bf16(h0[2], h0[3]); w.z = cvt_pk_bf16(h1[0], h1[1]); w.w = cvt_pk_bf16(h1[2], h1[3]); *(u32x4*)((bf16*)h + eo) = w; }
            }
        CFENCE();
    }
};
struct EpiMoeDown {
    static constexpr bool HAS_TAB = false;
    const int* tok; const float* wl; const bf16* xb; bf16* xo; MoeTab T; bool dry;
    __device__ __forceinline__ void operator()(const f32x4 (&acc)[2][2][4][2], const Unit& u, int wr, int wc, int fr, int fq) const {
        const int cnt = T.cnt[u.e]; const bf16* src = (u.e < 8) ? xb : (const bf16*)xo;
        const int colb = u.pn * 256 + wc * 32 + 8 * fq;
        int t8[8]; float w8[8];
#pragma unroll
        for (int g = 0; g < 8; ++g) { const int p = u.sub * 256 + (g >> 2) * 128 + wr * 64 + (g & 3) * 16 + fr; const bool ok = p < cnt; const int pc = ok ? p : 0;
            const int t_ = tok[u.e * 32768 + pc]; const float w_ = wl[u.e * 32768 + pc];
            t8[g] = ok ? t_ : -1; w8[g] = ok ? w_ * (USE_F8_MOE ? 1.0f / (F8_SH * F8_SW_DN) : 1.0f) : 0.f; }
        CFENCE();
        u32x4 nx[4][2];
#pragma unroll
        for (int g = 0; g < 4; ++g) { const bf16* s0 = src + (size_t)(t8[g] < 0 ? 0 : t8[g]) * D + colb; nx[g][0] = *(const u32x4*)s0; nx[g][1] = *(const u32x4*)(s0 + 128); }
#pragma unroll
        for (int g = 0; g < 8; ++g) {
            const int ai = g >> 2, m = g & 3;
            const u32x4 a2[2] = {nx[g & 3][0], nx[g & 3][1]};
            if (g < 4) { const bf16* s1 = src + (size_t)(t8[g + 4] < 0 ? 0 : t8[g + 4]) * D + colb; nx[g & 3][0] = *(const u32x4*)s1; nx[g & 3][1] = *(const u32x4*)(s1 + 128); }
            CFENCE();
            if (t8[g] >= 0) {
#pragma unroll
                for (int bj = 0; bj < 2; ++bj) {
                    const u32x4 a = a2[bj];
                    const f32x4 v0 = acc[ai][bj][m][0] * w8[g] + (f32x4){bflo(a.x), bfhi(a.x), bflo(a.y), bfhi(a.y)};
                    const f32x4 v1 = acc[ai][bj][m][1] * w8[g] + (f32x4){bflo(a.z), bfhi(a.z), bflo(a.w), bfhi(a.w)};
                    u32x4 w; w.x = cvt_pk_bf16(v0[0], v0[1]); w.y = cvt_pk_bf16(v0[2], v0[3]); w.z = cvt_pk_bf16(v1[0], v1[1]); w.w = cvt_pk_bf16(v1[2], v1[3]);
                    if (!dry) *(u32x4*)(xo + (size_t)t8[g] * D + colb + bj * 128) = w;
                }
            }
        }
        CFENCE();
    }
};

__device__ __forceinline__ void p0_tr_item(const float* src, int ldsrc, int ncol0, int k0, const float* gain, bf16* dst, int K, int drow0, LAS float* scr, int lane) {
    float gv[8]; f32x4 v8[8];
#pragma unroll
    for (int i = 0; i < 8; ++i) gv[i] = 1.0f;
    if (gain) {
#pragma unroll
        for (int i = 0; i < 8; ++i) gv[i] = gain[k0 + 8 * i + (lane >> 3)];
    }
#pragma unroll
    for (int i = 0; i < 8; ++i) v8[i] = *(const f32x4*)(src + (size_t)(k0 + 8 * i + (lane >> 3)) * ldsrc + ncol0 + 4 * (lane & 7));
    CFENCE();
#pragma unroll
    for (int i = 0; i < 8; ++i) { const int kk = 8 * i + (lane >> 3), c4 = lane & 7; *(LAS f32x4*)(scr + kk * 36 + 4 * c4) = v8[i] * gv[i]; }
    LDS_WAIT(); CFENCE();
    const int c = lane & 7;
#pragma unroll
    for (int j = 0; j < 4; ++j) { const int n = (lane >> 3) + 8 * j; const LAS float* s = scr + (8 * c) * 36 + n;
        u32x4 o; o.x = pk2(s[0 * 36], s[1 * 36]); o.y = pk2(s[2 * 36], s[3 * 36]); o.z = pk2(s[4 * 36], s[5 * 36]); o.w = pk2(s[6 * 36], s[7 * 36]);
        *(u32x4*)(dst + (size_t)(drow0 + n) * K + k0 + 8 * c) = o; }
    LDS_WAIT(); CFENCE();
}
__device__ __forceinline__ void p0_tr_item_f8(const float* src, int ldsrc, int ncol0, int k0, const float* gain, float scale, unsigned char* dst, int K, int drow0, LAS float* scr, int lane) {
    float gv[8]; f32x4 v8[8];
#pragma unroll
    for (int i = 0; i < 8; ++i) gv[i] = 1.0f;
    if (gain) {
#pragma unroll
        for (int i = 0; i < 8; ++i) gv[i] = gain[k0 + 8 * i + (lane >> 3)];
    }
#pragma unroll
    for (int i = 0; i < 8; ++i) v8[i] = *(const f32x4*)(src + (size_t)(k0 + 8 * i + (lane >> 3)) * ldsrc + ncol0 + 4 * (lane & 7));
    CFENCE();
#pragma unroll
    for (int i = 0; i < 8; ++i) { const int kk = 8 * i + (lane >> 3), c4 = lane & 7; *(LAS f32x4*)(scr + kk * 36 + 4 * c4) = v8[i] * (gv[i] * scale); }
    LDS_WAIT(); CFENCE();
    const int c = lane & 7;
#pragma unroll
    for (int j = 0; j < 4; ++j) { const int n = (lane >> 3) + 8 * j; const LAS float* s = scr + (8 * c) * 36 + n;
        u32x2 o; o.x = pk4_fp8(s[0 * 36], s[1 * 36], s[2 * 36], s[3 * 36]); o.y = pk4_fp8(s[4 * 36], s[5 * 36], s[6 * 36], s[7 * 36]);
        *(u32x2*)(dst + (size_t)(drow0 + n) * K + k0 + 8 * c) = o; }
    LDS_WAIT(); CFENCE();
}
__device__ __forceinline__ void p0_s5_unit(const Frame& F, int l, int g) {
    LAS float* AP = (LAS float*)F.lds;
    LAS float* BB = AP + 64 * 17 * 2;
    LAS float* CC = BB + 64 * 16 * 2;
    LAS float* KT = CC + 16 * 64 * 2;
    const float* lre = F.in[3] + (l * 32 + g) * 64; const float* lim = F.in[4] + (l * 32 + g) * 64; const float ldt = F.in[5][l * 32 + g];
    const float* bre = F.in[6] + (size_t)(l * 32 + g) * 1024; const float* bim = F.in[7] + (size_t)(l * 32 + g) * 1024;
    const float* cre = F.in[8] + (size_t)(l * 32 + g) * 1024; const float* cim = F.in[9] + (size_t)(l * 32 + g) * 1024;
    const int tid = F.tid;
    for (int i = tid; i < 64 * 17; i += 512) {
        const int p = i / 17, tau = i % 17;
        const double lr = fmin((double)lre[p], -1e-4), li = (double)lim[p], dt = exp((double)ldt);
        const double mg = exp(lr * dt * tau), ph = li * dt * tau;
        AP[i * 2] = (float)(mg * cos(ph)); AP[i * 2 + 1] = (float)(mg * sin(ph));
    }
    for (int i = tid; i < 1024; i += 512) {
        const int p = i >> 4;
        const double lr = fmin((double)lre[p], -1e-4), li = (double)lim[p], dt = exp((double)ldt);
        const double mg = exp(lr * dt), ar = mg * cos(li * dt), ai = mg * sin(li * dt), nr = ar - 1.0, ni = ai, den = lr * lr + li * li;
        const double fr = (nr * lr + ni * li) / den, fi = (ni * lr - nr * li) / den;
        const double br = bre[i], bi = bim[i];
        BB[i * 2] = (float)(fr * br - fi * bi); BB[i * 2 + 1] = (float)(fr * bi + fi * br);
        CC[i * 2] = cre[i]; CC[i * 2 + 1] = cim[i];
    }
    __syncthreads();
    for (int i = tid; i < 4096; i += 512) {
        const int tau = i >> 8, c = (i >> 4) & 15, c2 = i & 15; float s = 0.f;
        for (int p = 0; p < 64; ++p) {
            const float xr = CC[(c * 64 + p) * 2], xi = CC[(c * 64 + p) * 2 + 1], ar = AP[(p * 17 + tau) * 2], ai = AP[(p * 17 + tau) * 2 + 1];
            const float zr = xr * ar - xi * ai, zi = xr * ai + xi * ar;
            s += zr * BB[(p * 16 + c2) * 2] - zi * BB[(p * 16 + c2) * 2 + 1];
        }
        KT[i] = s;
    }
    __syncthreads();
    bf16* MQ = wsp<bf16>(F, WS_S5MQ) + (size_t)(l * 32 + g) * 256 * 384;
    for (int i = tid; i < 256 * 48; i += 512) {
        const int m = i / 48, k8 = (i % 48) * 8, t = m >> 4, c = m & 15; float v[8];
#pragma unroll
        for (int j = 0; j < 8; ++j) {
            const int kc = k8 + j;
            if (kc < 256) { const int s = kc >> 4, c2 = kc & 15; v[j] = (s <= t) ? KT[((t - s) * 16 + c) * 16 + c2] : 0.f; }
            else { const int pp = kc - 256, p = pp & 63; const float xr = CC[(c * 64 + p) * 2], xi = CC[(c * 64 + p) * 2 + 1], ar = AP[(p * 17 + t + 1) * 2], ai = AP[(p * 17 + t + 1) * 2 + 1];
                   v[j] = (pp < 64) ? (xr * ar - xi * ai) : -(xr * ai + xi * ar); }
        }
        u32x4 o; o.x = pk2(v[0], v[1]); o.y = pk2(v[2], v[3]); o.z = pk2(v[4], v[5]); o.w = pk2(v[6], v[7]);
        *(u32x4*)(MQ + (size_t)m * 384 + k8) = o;
    }
    bf16* PM = wsp<bf16>(F, WS_S5P) + (size_t)(l * 32 + g) * 128 * 256;
    for (int i = tid; i < 128 * 32; i += 512) {
        const int pp = i >> 5, k8 = (i & 31) * 8, p = pp & 63; float v[8];
#pragma unroll
        for (int j = 0; j < 8; ++j) {
            const int kc = k8 + j, s = kc >> 4, c2 = kc & 15;
            const float ar = AP[(p * 17 + 15 - s) * 2], ai = AP[(p * 17 + 15 - s) * 2 + 1], br = BB[(p * 16 + c2) * 2], bi = BB[(p * 16 + c2) * 2 + 1];
            v[j] = (pp < 64) ? (ar * br - ai * bi) : (ar * bi + ai * br);
        }
        u32x4 o; o.x = pk2(v[0], v[1]); o.y = pk2(v[2], v[3]); o.z = pk2(v[4], v[5]); o.w = pk2(v[6], v[7]);
        *(u32x4*)(PM + (size_t)pp * 256 + k8) = o;
    }
    float* A16 = wsp<float>(F, WS_S5A16) + (size_t)(l * 32 + g) * 128;
    if (tid < 64) { A16[tid * 2] = AP[(tid * 17 + 16) * 2]; A16[tid * 2 + 1] = AP[(tid * 17 + 16) * 2 + 1]; }
    __syncthreads();
}
__device__ __forceinline__ void p0_prologue(const Frame& F) {
    if (F.bid == 0 && F.tid < 16) __hip_atomic_store(wsp<unsigned>(F, WS_CTL) + CW_CNT + F.tid, 0u, __ATOMIC_RELAXED, __HIP_MEMORY_SCOPE_AGENT);
#ifndef PROBE_S5U
#define PROBE_S5U 1
#endif
#pragma unroll 1
    for (int pr = 0; pr < PROBE_S5U; ++pr) for (int un = F.bid; un < 64; un += F.G) p0_s5_unit(F, un >> 5, un & 31);
    LAS float* scr = (LAS float*)(F.lds + F.wave * 16384);
    const int gw = F.bid * 8 + F.wave, NGW = F.G * 8, lane = F.lane;
    constexpr int I_IN = 16 * 64, I_GLU = 8 * 16, I_OUT = 16 * 32, I_FGU = 16 * 176, I_FD = 44 * 32, I_MGU = 16 * 224, I_MD = 56 * 32;
    constexpr int NITEMS = 2 * (I_IN + I_GLU + I_OUT) + I_FGU + I_FD + 8 * (I_MGU + I_MD);
    const bool split = F.G > 64;
    const int N1 = split ? ((NITEMS / NGW > 4) ? (NITEMS / NGW - 4) * NGW : 0) : NITEMS;
    int step = NGW;
    for (int it = gw; ; it += step) {
        if (step == NGW && it >= N1) { if (!split || F.bid < 64) break; it = N1 + (F.bid - 64) * 8 + F.wave; step = (F.G - 64) * 8; }
        if (it >= NITEMS) break;
        int r = it; bool done = false;
#pragma unroll
        for (int l = 0; l < 2; ++l) {
            if (done) break;
            if (r < I_IN) { p0_tr_item(F.in[2] + (size_t)l * D * DIN, DIN, 32 * (r % 64), 64 * (r / 64), F.in[1] + l * D, wsp<bf16>(F, WS_WIN) + (size_t)l * NPROJ * D, D, 32 * (r % 64), scr, lane); done = true; break; } r -= I_IN;
            if (r < I_GLU) { p0_tr_item(F.in[11] + (size_t)l * 512 * 512, 512, 32 * (r % 16), 64 * (r / 16), nullptr, wsp<bf16>(F, WS_WGLU) + (size_t)l * 512 * 512, 512, 32 * (r % 16), scr, lane); done = true; break; } r -= I_GLU;
            if (r < I_OUT) { p0_tr_item(F.in[17] + (size_t)l * D * D, D, 32 * (r % 32), 64 * (r / 32), nullptr, wsp<bf16>(F, WS_WOUT) + (size_t)l * D * D, D, 32 * (r % 32), scr, lane); done = true; break; } r -= I_OUT;
        }
        if (done) continue;
        if (r < I_FGU) { const int nb = r % 176, kb = r / 176, n0 = 32 * nb, T = n0 >> 8, hf = (n0 >> 7) & 1, j0 = n0 & 127;
            if (USE_F8_FFN) p0_tr_item_f8(hf ? F.in[20] : F.in[19], DFF, 128 * T + j0, 64 * kb, F.in[18], F8_SW_UP, wsp<unsigned char>(F, WS_WFGU), D, n0, scr, lane);
            else p0_tr_item(hf ? F.in[20] : F.in[19], DFF, 128 * T + j0, 64 * kb, F.in[18], wsp<bf16>(F, WS_WFGU), D, n0, scr, lane);
            continue; } r -= I_FGU;
        if (r < I_FD) {
            if (USE_F8_FFN) p0_tr_item_f8(F.in[21], D, 32 * (r % 32), 64 * (r / 32), nullptr, F8_SW_DN, wsp<unsigned char>(F, WS_WFD), DFF, 32 * (r % 32), scr, lane);
            else p0_tr_item(F.in[21], D, 32 * (r % 32), 64 * (r / 32), nullptr, wsp<bf16>(F, WS_WFD), DFF, 32 * (r % 32), scr, lane);
            continue; } r -= I_FD;
        const int e = r / (I_MGU + I_MD); r -= e * (I_MGU + I_MD);
        if (r < I_MGU) { const int nb = r % 224, kb = r / 224, n0 = 32 * nb, T = n0 >> 8, hf = (n0 >> 7) & 1, j0 = n0 & 127;
            if (USE_F8_MOE) p0_tr_item_f8((hf ? F.in[24] : F.in[23]) + (size_t)e * D * DFE, DFE, 128 * T + j0, 64 * kb, F.in[18] + D, F8_SW_UP, wsp<unsigned char>(F, WS_MGU) + (size_t)e * 2 * DFE * D, D, n0, scr, lane);
            else p0_tr_item((hf ? F.in[24] : F.in[23]) + (size_t)e * D * DFE, DFE, 128 * T + j0, 64 * kb, F.in[18] + D, wsp<bf16>(F, WS_MGU) + (size_t)e * 2 * DFE * D, D, n0, scr, lane);
            continue; } r -= I_MGU;
        if (USE_F8_MOE) p0_tr_item_f8(F.in[25] + (size_t)e * DFE * D, D, 32 * (r % 32), 64 * (r / 32), nullptr, F8_SW_DN, wsp<unsigned char>(F, WS_MD) + (size_t)e * D * DFE, DFE, 32 * (r % 32), scr, lane);
        else p0_tr_item(F.in[25] + (size_t)e * DFE * D, D, 32 * (r % 32), 64 * (r / 32), nullptr, wsp<bf16>(F, WS_MD) + (size_t)e * D * DFE, DFE, 32 * (r % 32), scr, lane);
    }
    for (int it = F.bid * 512 + F.tid; it < 2 * 16 * 1024; it += F.G * 512) {
        const int l = it >> 14, r = (it >> 10) & 15, k = it & 1023;
        wsp<bf16>(F, WS_WGT)[it] = (bf16)f2bf(F.in[1][l * D + k] * F.in[2][(size_t)l * D * DIN + (size_t)k * DIN + 2048 + r]);
    }
    for (int it = F.bid * 512 + F.tid; it < 2 * 256 * 16; it += F.G * 512) {
        const int l = it >> 12, k = (it >> 4) & 255, r = it & 15;
        wsp<bf16>(F, WS_WA2T)[it] = (bf16)f2bf(F.in[14][(size_t)l * 16 * 256 + r * 256 + k]);
    }
    bf16* xb = wsp<bf16>(F, WS_XB); float* ssp = wsp<float>(F, WS_SSP);
    f32x4 xn[4];
    if (gw < M) {
#pragma unroll
        for (int j = 0; j < 4; ++j) xn[j] = ((const f32x4*)(F.in[0] + (size_t)gw * D) + lane)[64 * j];
    }
    for (int m = gw; m < M; m += NGW) {
        f32x4 xc[4]; float s = 0.f;
#pragma unroll
        for (int j = 0; j < 4; ++j) xc[j] = xn[j];
        if (m + NGW < M) {
#pragma unroll
            for (int j = 0; j < 4; ++j) xn[j] = ((const f32x4*)(F.in[0] + (size_t)(m + NGW) * D) + lane)[64 * j];
        }
        CFENCE();
        u32x2* o8 = (u32x2*)(xb + (size_t)m * D) + lane;
#pragma unroll
        for (int j = 0; j < 4; ++j) { const f32x4 v = xc[j]; s += (v[0] * v[0] + v[1] * v[1]) + (v[2] * v[2] + v[3] * v[3]); u32x2 w; w.x = pk2(v[0], v[1]); w.y = pk2(v[2], v[3]); o8[64 * j] = w; }
        s = wave_sum(s);
        if (lane < 16) ssp[(size_t)m * 16 + lane] = (lane == 0) ? s : 0.f;
    }
}

__device__ __forceinline__ bf16x8 frag_row(const LAS unsigned char* base, int stride, int row0, int k0, int lane) {
    return *(const LAS bf16x8*)(base + (row0 + (lane & 15)) * stride + (k0 + 8 * (lane >> 4)) * 2);
}
__device__ __forceinline__ s16x4 lds_tr(const LAS unsigned char* p) { return __builtin_bit_cast(s16x4, __builtin_amdgcn_ds_read_tr16_b64_v4i16((LAS v4i16_t*)p)); }
__device__ __forceinline__ bf16x8 frag_tr(const LAS unsigned char* base, int stride, int r0, int c0, int lane) {
    const int i = lane & 15, q = i >> 2, p = i & 3, g = lane >> 4;
    const LAS unsigned char* a = base + (r0 + 8 * g + q) * stride + (c0 + 4 * p) * 2;
    const s16x4 lo = lds_tr(a), hi = lds_tr(a + 4 * stride);
    return (bf16x8){lo[0], lo[1], lo[2], lo[3], hi[0], hi[1], hi[2], hi[3]};
}
__device__ __forceinline__ bf16x8 frag_tr_perm(const LAS unsigned char* base, int stride, int r0, int c0, int lane) {
    const int i = lane & 15, q = i >> 2, p = i & 3, g = lane >> 4;
    const LAS unsigned char* a = base + (r0 + 4 * g + q) * stride + (c0 + 4 * p) * 2;
    const s16x4 lo = lds_tr(a), hi = lds_tr(a + 16 * stride);
    return (bf16x8){lo[0], lo[1], lo[2], lo[3], hi[0], hi[1], hi[2], hi[3]};
}
#define MFMA16(a, b, c) __builtin_amdgcn_mfma_f32_16x16x32_bf16((a), (b), (c), 0, 0, 0)

__device__ __forceinline__ void glow_pass(const Frame& F, int l) {
    const int lane = F.lane, fr = lane & 15, fq = lane >> 4;
    const bf16* wg = wsp<bf16>(F, WS_WGT) + (size_t)l * 16 * 1024;
    bf16x8 wf[32];
#pragma unroll
    for (int ks = 0; ks < 32; ++ks) wf[ks] = *(const bf16x8*)(wg + fr * 1024 + 32 * ks + 8 * fq);
    const bf16* xb = wsp<bf16>(F, WS_XB); const float* ssp = wsp<float>(F, WS_SSP); bf16* gl = wsp<bf16>(F, WS_GL);
    for (int m0 = 16 * (F.bid * 8 + F.wave); m0 < M; m0 += 16 * F.G * 8) {
        f32x4 acc = {0.f, 0.f, 0.f, 0.f};
        const bf16* xr = xb + (size_t)(m0 + fr) * D + 8 * fq;
        const float rs = row_rstd(ssp, m0 + fr);
        u32x4 an[8];
#pragma unroll
        for (int kk = 0; kk < 8; ++kk) an[kk] = *(const u32x4*)(xr + 32 * kk);
#pragma unroll
        for (int kg = 0; kg < 4; ++kg) {
            u32x4 a8[8];
#pragma unroll
            for (int kk = 0; kk < 8; ++kk) a8[kk] = an[kk];
            if (kg < 3) {
#pragma unroll
                for (int kk = 0; kk < 8; ++kk) an[kk] = *(const u32x4*)(xr + 32 * (8 * (kg + 1) + kk));
            }
            CFENCE();
#pragma unroll
            for (int kk = 0; kk < 8; ++kk) acc = MFMA16(wf[8 * kg + kk], __builtin_bit_cast(bf16x8, a8[kk]), acc);
        }
        u32x2 o; o.x = cvt_pk_bf16(acc[0] * rs, acc[1] * rs); o.y = cvt_pk_bf16(acc[2] * rs, acc[3] * rs);
        *(u32x2*)(gl + (size_t)(m0 + fr) * 16 + 4 * fq) = o;
    }
}
constexpr int S5_USTR = 528, S5_SSTR = 272, S5_HSTR = 272;
__device__ __forceinline__ void s5_unit(const Frame& F, int l, int un) {
    const int b = un >> 5, g = un & 31, tid = F.tid, lane = F.lane, w = F.wave, fq = lane >> 4, fr = lane & 15;
    LAS unsigned char* hb = F.lds; LAS unsigned char* useg = F.lds + 64 * S5_HSTR; LAS unsigned char* slds = useg + 64 * S5_USTR;
    const bf16* PM = wsp<bf16>(F, WS_S5P) + (size_t)(l * 32 + g) * 128 * 256;
    const bf16* MQ = wsp<bf16>(F, WS_S5MQ) + (size_t)(l * 32 + g) * 256 * 384;
    bf16x8 pf[8], mq0[12], mq1[12];
#pragma unroll
    for (int ks = 0; ks < 8; ++ks) pf[ks] = *(const bf16x8*)(PM + (size_t)(16 * w + fr) * 256 + 32 * ks + 8 * fq);
#pragma unroll
    for (int ks = 0; ks < 12; ++ks) { mq0[ks] = *(const bf16x8*)(MQ + (size_t)(16 * w + fr) * 384 + 32 * ks + 8 * fq); mq1[ks] = *(const bf16x8*)(MQ + (size_t)(16 * (w + 8) + fr) * 384 + 32 * ks + 8 * fq); }
    const float* A16 = wsp<float>(F, WS_S5A16) + (size_t)(l * 32 + g) * 128;
    const float a_re = A16[(lane & 63) * 2], a_im = A16[(lane & 63) * 2 + 1];
    const f32x4 dsk = *(const f32x4*)(F.in[10] + l * 512 + g * 16 + 4 * fq);
    float hr = 0.f, hi = 0.f;
    const bf16* ug = wsp<bf16>(F, WS_UGM) + (size_t)((b * 32 + g) * 4096) * 16;
    bf16* ys5 = (bf16*)(F.dout + DO_YS5);
    u32x4 upre[4];
#pragma unroll
    for (int i = 0; i < 4; ++i) upre[i] = *(const u32x4*)(ug + (size_t)(tid + 512 * i) * 8);
    for (int seg = 0; seg < 4; ++seg) {
#pragma unroll
        for (int i = 0; i < 4; ++i) { const int idx = tid + 512 * i; *(LAS u32x4*)(useg + (idx >> 5) * S5_USTR + (idx & 31) * 16) = upre[i]; }
        if (seg < 3) {
#pragma unroll
            for (int i = 0; i < 4; ++i) upre[i] = *(const u32x4*)(ug + (size_t)(seg + 1) * 16384 + (size_t)(tid + 512 * i) * 8);
        }
        __syncthreads();
#ifndef PROBE_S5
#define PROBE_S5 0
#endif
#pragma unroll 1
        for (int pr1 = 0; pr1 < (PROBE_S5 == 1 ? 2 : 1); ++pr1)
        {
            f32x4 acc4[4];
#pragma unroll
            for (int nt = 0; nt < 4; ++nt) acc4[nt] = (f32x4){0.f, 0.f, 0.f, 0.f};
#pragma unroll
            for (int kb = 0; kb < 8; kb += 2) {
                bf16x8 ub[2][4];
#pragma unroll
                for (int ks = 0; ks < 2; ++ks)
#pragma unroll
                    for (int nt = 0; nt < 4; ++nt) ub[ks][nt] = frag_row(useg, S5_USTR, 16 * nt, 32 * (kb + ks), lane);
                __builtin_amdgcn_sched_barrier(0);
#pragma unroll
                for (int ks = 0; ks < 2; ++ks)
#pragma unroll
                    for (int nt = 0; nt < 4; ++nt) acc4[nt] = MFMA16(ub[ks][nt], pf[kb + ks], acc4[nt]);
                __builtin_amdgcn_sched_barrier(0);
            }
#pragma unroll
            for (int nt = 0; nt < 4; ++nt) *(LAS f32x4*)(slds + (16 * w + fr) * S5_SSTR + (16 * nt + 4 * fq) * 4) = acc4[nt];
        }
        __syncthreads();
        if (w == 0) {
            const LAS unsigned char* sre = slds + lane * S5_SSTR; const LAS unsigned char* sim = slds + (64 + lane) * S5_SSTR;
            const float hr0 = hr, hi0 = hi;
            const f32x2 are2 = {a_re, a_re}, aim2 = {-a_im, a_im};
#pragma unroll 1
            for (int pr2 = 0; pr2 < (PROBE_S5 == 2 ? 2 : 1); ++pr2) { hr = hr0; hi = hi0;
#pragma unroll 1
            for (int n0 = 0; n0 < 64; n0 += 16) {
                LAS unsigned char* hw = hb + n0 * S5_HSTR + lane * 2;
                f32x4 cr4[4], ci4[4];
#pragma unroll
                for (int q = 0; q < 4; ++q) { cr4[q] = *(const LAS f32x4*)(sre + n0 * 4 + q * 16); ci4[q] = *(const LAS f32x4*)(sim + n0 * 4 + q * 16); }
                CFENCE();
#pragma unroll
                for (int j = 0; j < 16; ++j) {
                    const f32x2 s2 = {cr4[j >> 2][j & 3], ci4[j >> 2][j & 3]};
                    const unsigned hp = cvt_pk_bf16(hr, hi);
                    *(LAS unsigned short*)(hw + j * S5_HSTR) = (unsigned short)hp; *(LAS unsigned short*)(hw + j * S5_HSTR + 128) = (unsigned short)(hp >> 16);
                    const f32x2 hv = {hr, hi}, hx = {hi, hr};
                    const f32x2 nh = hv * are2 + (hx * aim2 + s2);
                    hr = nh[0]; hi = nh[1];
                }
            }
            }
        }
        __syncthreads();
#pragma unroll 1
        for (int pr3 = 0; pr3 < (PROBE_S5 == 3 ? 2 : 1); ++pr3)
#pragma unroll
        for (int nt = 0; nt < 4; ++nt) {
            f32x4 a0 = {0.f, 0.f, 0.f, 0.f}, a1 = {0.f, 0.f, 0.f, 0.f};
#pragma unroll
            for (int kb = 0; kb < 12; kb += 4) {
                bf16x8 bb[4];
#pragma unroll
                for (int ks = 0; ks < 4; ++ks) bb[ks] = (kb < 8) ? frag_row(useg, S5_USTR, 16 * nt, 32 * (kb + ks), lane) : frag_row(hb, S5_HSTR, 16 * nt, 32 * ks, lane);
                __builtin_amdgcn_sched_barrier(0);
#pragma unroll
                for (int ks = 0; ks < 4; ++ks) { a0 = MFMA16(mq0[kb + ks], bb[ks], a0); a1 = MFMA16(mq1[kb + ks], bb[ks], a1); }
                __builtin_amdgcn_sched_barrier(0);
            }
            const int chunk = 16 * nt + fr;
#pragma unroll
            for (int hh = 0; hh < 2; ++hh) {
                const int t = w + 8 * hh; const f32x4 a = hh ? a1 : a0;
                const u32x2 uu = *(const LAS u32x2*)(useg + chunk * S5_USTR + (t * 16 + 4 * fq) * 2);
                const float y0 = gelu_tanh(a[0] + dsk[0] * bflo(uu.x)), y1 = gelu_tanh(a[1] + dsk[1] * bfhi(uu.x)), y2 = gelu_tanh(a[2] + dsk[2] * bflo(uu.y)), y3 = gelu_tanh(a[3] + dsk[3] * bfhi(uu.y));
                u32x2 o; o.x = cvt_pk_bf16(y0, y1); o.y = cvt_pk_bf16(y2, y3);
                const int token = b * 4096 + seg * 1024 + chunk * 16 + t;
                *(u32x2*)(ys5 + (size_t)token * 512 + g * 16 + 4 * fq) = o;
            }
        }
        __syncthreads();
    }
}

constexpr int GL_TSTR = 144;
__device__ __forceinline__ void gla_ld_tile(const bf16* g, int pitch, u32x4 (&r)[8], int lane) {
#pragma unroll
    for (int i = 0; i < 8; ++i) { const int idx = lane + 64 * i; r[i] = *(const u32x4*)(g + (size_t)(idx >> 3) * pitch + (idx & 7) * 8); }
}
__device__ __forceinline__ void gla_st_tile(LAS unsigned char* img, const u32x4 (&r)[8], int lane) {
#pragma unroll
    for (int i = 0; i < 8; ++i) { const int idx = lane + 64 * i; *(LAS u32x4*)(img + (idx >> 3) * GL_TSTR + (idx & 7) * 16) = r[i]; }
}
__device__ __forceinline__ void gla_loga_tile(const Frame& F, int l, int row0, int h, LAS unsigned char* img, int lane_) {
    int lane = lane_; asm volatile("" : "+v"(lane));
    const int fr = lane & 15, fq = lane >> 4;
    const bf16* wa = wsp<bf16>(F, WS_WA2T) + (size_t)l * 256 * 16 + (size_t)(h * 64) * 16; const bf16* gl = wsp<bf16>(F, WS_GL) + (size_t)row0 * 16;
    const float* ba = F.in[15] + l * 256 + h * 64;
    bf16x8 af[4], bfr[4];
    const u32x4 zero4 = {0u, 0u, 0u, 0u};
#pragma unroll
    for (int i = 0; i < 4; ++i) {
        const u32x4 a = (fq < 2) ? *(const u32x4*)(wa + (size_t)(16 * i + fr) * 16 + 8 * fq) : zero4;
        const u32x4 b = (fq < 2) ? *(const u32x4*)(gl + (size_t)(16 * i + fr) * 16 + 8 * fq) : zero4;
        af[i] = __builtin_bit_cast(bf16x8, a); bfr[i] = __builtin_bit_cast(bf16x8, b);
    }
    float b44[4];
#pragma unroll
    for (int mt = 0; mt < 4; ++mt) b44[mt] = ba[16 * mt + fr];
    CFENCE();
#pragma unroll
    for (int mt = 0; mt < 4; ++mt) {
        const float b1 = b44[mt];
#pragma unroll
        for (int nt = 0; nt < 4; ++nt) {
            f32x4 z = {0.f, 0.f, 0.f, 0.f};
            z = MFMA16(bfr[nt], af[mt], z);
            float la[4];
#pragma unroll
            for (int j = 0; j < 4; ++j) { const float v = z[j] + b1; la[j] = (fminf(v, 0.f) - __logf(1.0f + __expf(-fabsf(v)))) * 0.0625f; }
            u32x2 o; o.x = cvt_pk_bf16(la[0], la[1]); o.y = cvt_pk_bf16(la[2], la[3]);
            *(LAS u32x2*)(img + (16 * mt + fr) * GL_TSTR + (16 * nt + 4 * fq) * 2) = o;
        }
    }
}
__device__ __forceinline__ void gla_row(const LAS unsigned char* img, int lane, u32x4 (&r)[8]) {
#pragma unroll
    for (int i = 0; i < 8; ++i) r[i] = *(const LAS u32x4*)(img + lane * GL_TSTR + i * 16);
}
#define GLA_ROWV(r, t) ((((t) & 1) ? bfhi((r)[(t) >> 3][((t) >> 1) & 3]) : bflo((r)[(t) >> 3][((t) >> 1) & 3])))
__device__ __forceinline__ float gla_col(const LAS unsigned char* img, int t, int lane) { return bf2f(*(const LAS bf16*)(img + t * GL_TSTR + lane * 2)); }
__device__ __forceinline__ void gla_a_unit(const Frame& F, int l, int wu) {
    const int lane = F.lane, fq = lane >> 4, fr = lane & 15;
    const int bh = wu >> 6, n = wu & 63, b = bh >> 2, h = bh & 3, row0 = b * 4096 + n * 64;
    LAS unsigned char* ra = F.lds + F.wave * WAVE_LDS; LAS unsigned char* rb = ra + 64 * GL_TSTR;
    const bf16* vp = wsp<bf16>(F, WS_V) + (size_t)row0 * 512 + h * 128;
    u32x4 t1[8], tv[8];
    gla_ld_tile(wsp<bf16>(F, WS_K) + (size_t)row0 * 256 + h * 64, 256, t1, lane);
    gla_ld_tile(vp, 512, tv, lane);
    gla_loga_tile(F, l, row0, h, ra, lane);
    gla_st_tile(rb, t1, lane);
    CFENCE();
    u32x4 lg[8]; gla_row(ra, lane, lg);
    float tot = 0.f;
#pragma unroll
    for (int t = 0; t < 64; ++t) tot += GLA_ROWV(lg, t);
    wsp<float>(F, WS_DEC)[(size_t)wu * 64 + lane] = __expf(tot);
    float cum = 0.f; u32x4 pk[8];
#pragma unroll
    for (int t8 = 0; t8 < 8; ++t8) {
        float ke[8], kc[8];
#pragma unroll
        for (int tt = 0; tt < 8; ++tt) kc[tt] = gla_col(rb, t8 * 8 + tt, lane);
        CFENCE();
#pragma unroll
        for (int tt = 0; tt < 8; ++tt) { const int t = t8 * 8 + tt; cum += GLA_ROWV(lg, t); ke[tt] = kc[tt] * __expf(tot - cum); }
        pk[t8].x = cvt_pk_bf16(ke[0], ke[1]); pk[t8].y = cvt_pk_bf16(ke[2], ke[3]); pk[t8].z = cvt_pk_bf16(ke[4], ke[5]); pk[t8].w = cvt_pk_bf16(ke[6], ke[7]);
    }
    CFENCE();
#pragma unroll
    for (int t8 = 0; t8 < 8; ++t8) *(LAS u32x4*)(ra + lane * GL_TSTR + t8 * 16) = pk[t8];
    bf16* ut = (bf16*)(F.dout + DO_UT) + (size_t)wu * 8192;
#pragma unroll
    for (int hv = 0; hv < 2; ++hv) {
        CFENCE();
        gla_st_tile(rb, tv, lane);
        if (hv == 0) gla_ld_tile(vp + 64, 512, tv, lane);
        CFENCE();
#pragma unroll
        for (int mt = 0; mt < 4; ++mt)
#pragma unroll
            for (int nt = 0; nt < 4; ++nt) {
                f32x4 acc = {0.f, 0.f, 0.f, 0.f};
#pragma unroll
                for (int ks = 0; ks < 2; ++ks) acc = MFMA16(frag_row(ra, GL_TSTR, 16 * mt, 32 * ks, lane), frag_tr(rb, GL_TSTR, 32 * ks, 16 * nt, lane), acc);
                { u32x2 o; o.x = cvt_pk_bf16(acc[0], acc[1]); o.y = cvt_pk_bf16(acc[2], acc[3]);
                  *(u32x2*)(ut + (size_t)(hv * 64 + nt * 16 + fr) * 64 + mt * 16 + 4 * fq) = o; }
            }
    }
}
__device__ __forceinline__ void gla_b_scan(const Frame& F) {
    const bf16* ut = (const bf16*)(F.dout + DO_UT); bf16* st = (bf16*)(F.dout + DO_ST); const float* dec = wsp<float>(F, WS_DEC);
    LAS float* dl = (LAS float*)F.lds;
    for (int blk = F.bid; blk < 256; blk += F.G) {
        const int bh = blk >> 3, e = (blk & 7) * 1024 + F.tid * 2, k = e & 63;
        __syncthreads();
#pragma unroll
        for (int i = 0; i < 2; ++i) *(LAS f32x4*)(dl + (F.tid + 512 * i) * 4) = *(const f32x4*)(dec + (size_t)bh * 4096 + (size_t)(F.tid + 512 * i) * 4);
        __syncthreads();
        f32x2 s2 = {0.f, 0.f};
        const bf16* up = ut + (size_t)bh * 64 * 8192 + e; bf16* sp = st + (size_t)bh * 64 * 8192 + e;
        unsigned un16[16];
#pragma unroll
        for (int j = 0; j < 16; ++j) un16[j] = *(const unsigned*)(up + (size_t)j * 8192);
#pragma unroll 1
        for (int n0 = 0; n0 < 64; n0 += 16) {
            unsigned u16[16];
#pragma unroll
            for (int j = 0; j < 16; ++j) u16[j] = un16[j];
            if (n0 < 48) {
#pragma unroll
                for (int j = 0; j < 16; ++j) un16[j] = *(const unsigned*)(up + (size_t)(n0 + 16 + j) * 8192);
            }
            CFENCE();
#pragma unroll
            for (int j = 0; j < 16; ++j) {
                const f32x2 d = *(const LAS f32x2*)(dl + (n0 + j) * 64 + k);
                *(unsigned*)(sp + (size_t)(n0 + j) * 8192) = cvt_pk_bf16(s2[0], s2[1]);
                s2 = d * s2 + (f32x2){bflo(u16[j]), bfhi(u16[j])};
            }
        }
    }
}
__device__ __forceinline__ void gla_c_unit(const Frame& F, int l, int wu) {
    const int lane = F.lane, fq = lane >> 4, fr = lane & 15;
    const int bh = wu >> 6, n = wu & 63, b = bh >> 2, h = bh & 3, row0 = b * 4096 + n * 64;
    LAS unsigned char* qtt = F.lds + F.wave * WAVE_LDS; LAS unsigned char* ktt = qtt + 64 * GL_TSTR;
    const bf16* vp = wsp<bf16>(F, WS_V) + (size_t)row0 * 512 + h * 128;
    u32x4 t1[8], t2[8], tv[8];
    gla_loga_tile(F, l, row0, h, qtt, lane);
    CFENCE();
    gla_ld_tile(wsp<bf16>(F, WS_K) + (size_t)row0 * 256 + h * 64, 256, t1, lane);
    gla_ld_tile(wsp<bf16>(F, WS_Q) + (size_t)row0 * 256 + h * 64, 256, t2, lane);
    gla_st_tile(ktt, t1, lane);
    CFENCE();
    unsigned e1p[32]; float cum = 0.f; u32x4 pkk[8], pkq[8];
    u32x4 lg[8]; gla_row(qtt, lane, lg);
#pragma unroll
    for (int t8 = 0; t8 < 8; ++t8) {
        float kt[8], e8[8], kc[8];
#pragma unroll
        for (int tt = 0; tt < 8; ++tt) kc[tt] = gla_col(ktt, t8 * 8 + tt, lane);
        CFENCE();
#pragma unroll
        for (int tt = 0; tt < 8; ++tt) { const int t = t8 * 8 + tt; cum += GLA_ROWV(lg, t); e8[tt] = __expf(cum); kt[tt] = kc[tt] * __builtin_amdgcn_rcpf(e8[tt]); }
#pragma unroll
        for (int j = 0; j < 4; ++j) e1p[t8 * 4 + j] = cvt_pk_bf16(e8[2 * j], e8[2 * j + 1]);
        pkk[t8].x = cvt_pk_bf16(kt[0], kt[1]); pkk[t8].y = cvt_pk_bf16(kt[2], kt[3]); pkk[t8].z = cvt_pk_bf16(kt[4], kt[5]); pkk[t8].w = cvt_pk_bf16(kt[6], kt[7]);
    }
    CFENCE();
    gla_st_tile(qtt, t2, lane);
    gla_ld_tile(vp, 512, tv, lane);
    CFENCE();
#pragma unroll
    for (int t8 = 0; t8 < 8; ++t8) {
        float qt[8], qc[8];
#pragma unroll
        for (int tt = 0; tt < 8; ++tt) qc[tt] = gla_col(qtt, t8 * 8 + tt, lane);
        CFENCE();
#pragma unroll
        for (int tt = 0; tt < 8; ++tt) { const int t = t8 * 8 + tt; const unsigned ep = e1p[t >> 1]; qt[tt] = qc[tt] * ((t & 1) ? bfhi(ep) : bflo(ep)) * 0.125f; }
        pkq[t8].x = cvt_pk_bf16(qt[0], qt[1]); pkq[t8].y = cvt_pk_bf16(qt[2], qt[3]); pkq[t8].z = cvt_pk_bf16(qt[4], qt[5]); pkq[t8].w = cvt_pk_bf16(qt[6], qt[7]);
    }
    CFENCE();
#pragma unroll
    for (int t8 = 0; t8 < 8; ++t8) { *(LAS u32x4*)(qtt + lane * GL_TSTR + t8 * 16) = pkq[t8]; *(LAS u32x4*)(ktt + lane * GL_TSTR + t8 * 16) = pkk[t8]; }
    CFENCE();
    u32x2 sc[4][4];
#pragma unroll
    for (int mt = 0; mt < 4; ++mt)
#pragma unroll
        for (int nt = 0; nt < 4; ++nt) {
            if (mt > nt) { sc[mt][nt] = (u32x2){0u, 0u}; continue; }
            f32x4 acc = {0.f, 0.f, 0.f, 0.f};
#pragma unroll
            for (int ks = 0; ks < 2; ++ks) acc = MFMA16(frag_tr(ktt, GL_TSTR, 32 * ks, 16 * mt, lane), frag_tr(qtt, GL_TSTR, 32 * ks, 16 * nt, lane), acc);
            if (mt == nt) {
#pragma unroll
                for (int rg = 0; rg < 4; ++rg) if (4 * fq + rg > fr) acc[rg] = 0.f;
            }
            sc[mt][nt].x = cvt_pk_bf16(acc[0], acc[1]); sc[mt][nt].y = cvt_pk_bf16(acc[2], acc[3]);
        }
    const bf16* st = (const bf16*)(F.dout + DO_ST) + (size_t)wu * 8192;
    f32x4 o[8][4];
#pragma unroll
    for (int hv = 0; hv < 2; ++hv) {
        CFENCE();
        gla_st_tile(ktt, tv, lane);
        CFENCE();
#pragma unroll
        for (int dt = 0; dt < 4; ++dt) {
            const int dvt = hv * 4 + dt;
            bf16x8 sfr[2], vfr[2];
#pragma unroll
            for (int ks = 0; ks < 2; ++ks) { sfr[ks] = *(const bf16x8*)(st + (size_t)(dvt * 16 + fr) * 64 + 32 * ks + 8 * fq); vfr[ks] = frag_tr_perm(ktt, GL_TSTR, 32 * ks, 16 * dt, lane); }
#pragma unroll
            for (int nt = 0; nt < 4; ++nt) {
                f32x4 acc = {0.f, 0.f, 0.f, 0.f};
#pragma unroll
                for (int ks = 0; ks < 2; ++ks) {
                    if (2 * ks <= nt) {
                        const u32x4 bw = {sc[2 * ks][nt].x, sc[2 * ks][nt].y, sc[2 * ks + 1][nt].x, sc[2 * ks + 1][nt].y};
                        acc = MFMA16(vfr[ks], __builtin_bit_cast(bf16x8, bw), acc);
                    }
                    acc = MFMA16(sfr[ks], frag_tr(qtt, GL_TSTR, 32 * ks, 16 * nt, lane), acc);
                }
                o[dvt][nt] = acc;
            }
        }
        if (hv == 0) gla_ld_tile(vp + 64, 512, tv, lane);
    }
    const float* gn = F.in[16] + l * 512 + h * 128;
    const bf16* rp = wsp<bf16>(F, WS_R) + (size_t)row0 * 512 + h * 128;
    bf16* mx = wsp<bf16>(F, WS_MIXED) + (size_t)row0 * D + 512 + h * 128;
    float rs4[4];
#pragma unroll
    for (int nt = 0; nt < 4; ++nt) {
        float ss = 0.f;
#pragma unroll
        for (int dvt = 0; dvt < 8; ++dvt) { const f32x4 x = o[dvt][nt]; ss += (x[0] * x[0] + x[1] * x[1]) + (x[2] * x[2] + x[3] * x[3]); }
        ss += __shfl_xor(ss, 16); ss += __shfl_xor(ss, 32);
        rs4[nt] = rsqrtf(ss * (1.0f / 128.0f) + EPS);
    }
    f32x4 gN = *(const f32x4*)(gn + 4 * fq); u32x2 rN[4];
#pragma unroll
    for (int nt = 0; nt < 4; ++nt) rN[nt] = *(const u32x2*)(rp + (size_t)(16 * nt + fr) * 512 + 4 * fq);
#pragma unroll
    for (int dvt = 0; dvt < 8; ++dvt) {
        const int dv = 16 * dvt + 4 * fq;
        const f32x4 g = gN; u32x2 rc[4];
#pragma unroll
        for (int nt = 0; nt < 4; ++nt) rc[nt] = rN[nt];
        if (dvt < 7) {
            gN = *(const f32x4*)(gn + dv + 16);
#pragma unroll
            for (int nt = 0; nt < 4; ++nt) rN[nt] = *(const u32x2*)(rp + (size_t)(16 * nt + fr) * 512 + dv + 16);
        }
        CFENCE();
#pragma unroll
        for (int nt = 0; nt < 4; ++nt) {
            const int i = 16 * nt + fr; const float rs = rs4[nt]; const u32x2 rr = rc[nt]; const f32x4 x = o[dvt][nt];
            u32x2 w; w.x = cvt_pk_bf16(x[0] * rs * g[0] * siluf_(bflo(rr.x)), x[1] * rs * g[1] * siluf_(bfhi(rr.x))); w.y = cvt_pk_bf16(x[2] * rs * g[2] * siluf_(bflo(rr.y)), x[3] * rs * g[3] * siluf_(bfhi(rr.y)));
            *(u32x2*)(mx + (size_t)i * D + dv) = w;
        }
    }
}
__device__ __forceinline__ void s5_fin_rows(const Frame& F, int l) {
    const int lane = F.lane, gw = F.bid * 8 + F.wave, NGW = F.G * 8;
    const bf16* y = wsp<bf16>(F, WS_UGM); bf16* mx = wsp<bf16>(F, WS_MIXED);
    const float* gn = F.in[13] + l * 512 + lane * 8; const f32x4 g0 = *(const f32x4*)gn, g1 = *(const f32x4*)(gn + 4);
    u32x4 an = {0u, 0u, 0u, 0u};
    if (gw < M) an = *((const u32x4*)(y + (size_t)gw * 512) + lane);
    for (int row = gw; row < M; row += NGW) {
        const u32x4 a = an;
        if (row + NGW < M) an = *((const u32x4*)(y + (size_t)(row + NGW) * 512) + lane);
        CFENCE();
        float v[8] = {bflo(a.x), bfhi(a.x), bflo(a.y), bfhi(a.y), bflo(a.z), bfhi(a.z), bflo(a.w), bfhi(a.w)}; float s = 0.f;
#pragma unroll
        for (int j = 0; j < 8; ++j) s += v[j] * v[j];
        s = wave_sum(s); const float rs = rsqrtf(s * (1.0f / 512.0f) + EPS);
        u32x4 w; w.x = cvt_pk_bf16(v[0] * rs * g0[0], v[1] * rs * g0[1]); w.y = cvt_pk_bf16(v[2] * rs * g0[2], v[3] * rs * g0[3]); w.z = cvt_pk_bf16(v[4] * rs * g1[0], v[5] * rs * g1[1]); w.w = cvt_pk_bf16(v[6] * rs * g1[2], v[7] * rs * g1[3]);
        *((u32x4*)(mx + (size_t)row * D) + lane) = w;
    }
}
__device__ __forceinline__ void moe_router(const Frame& F) {
    const int lane = F.lane, fr = lane & 15, fq = lane >> 4;
    const float* gain = F.in[18] + D; const float* wr_ = F.in[22];
    constexpr int RT_OFF = 16384, RT_STR = 2064;
    {
        const int k0 = 2 * F.tid;
        const f32x2 g2 = *(const f32x2*)(gain + k0);
        const f32x4 wa = *(const f32x4*)(wr_ + k0 * 8), wb = *(const f32x4*)(wr_ + k0 * 8 + 4), wc_ = *(const f32x4*)(wr_ + k0 * 8 + 8), wd = *(const f32x4*)(wr_ + k0 * 8 + 12);
        const float w0[8] = {wa[0], wa[1], wa[2], wa[3], wb[0], wb[1], wb[2], wb[3]}, w1_[8] = {wc_[0], wc_[1], wc_[2], wc_[3], wd[0], wd[1], wd[2], wd[3]};
#pragma unroll
        for (int e = 0; e < 8; ++e) {
            const float a = g2[0] * w0[e], b2 = g2[1] * w1_[e];
            const unsigned ah = f2bf(a), bh = f2bf(b2), al = f2bf(a - bf2f(ah)), bl = f2bf(b2 - bf2f(bh));
            *(LAS unsigned*)(F.lds + RT_OFF + e * RT_STR + k0 * 2) = ah | (bh << 16);
            *(LAS unsigned*)(F.lds + RT_OFF + (8 + e) * RT_STR + k0 * 2) = al | (bl << 16);
        }
    }
    __syncthreads();
    bf16x8 wf[32];
#pragma unroll
    for (int ks = 0; ks < 32; ++ks) wf[ks] = *(const LAS bf16x8*)(F.lds + RT_OFF + fr * RT_STR + (32 * ks + 8 * fq) * 2);
    const bf16* xb = wsp<bf16>(F, WS_XB); int* tok = wsp<int>(F, WS_TOK); float* wl = wsp<float>(F, WS_WL); float* rl = wsp<float>(F, WS_RL);
    unsigned* cnt = wsp<unsigned>(F, WS_CTL) + CW_CNT;
    LAS int* lcnt = (LAS int*)F.lds; LAS int* lbase = lcnt + 16; LAS int* rinfo = lbase + 16; LAS float* rw = (LAS float*)(rinfo + 1024); LAS float* rr = rw + 1024;
    const int rows_per_wg = ((M + F.G - 1) / F.G + 15) & ~15, r0 = F.bid * rows_per_wg, r1 = (r0 + rows_per_wg < M) ? r0 + rows_per_wg : M;
    if (F.tid < 16) lcnt[F.tid] = 0;
    __syncthreads();
    for (int m0 = r0 + 16 * F.wave; m0 < r1; m0 += 128) {
        f32x4 acc = {0.f, 0.f, 0.f, 0.f}; float ss = 0.f;
        const bf16* xr = xb + (size_t)(m0 + fr) * D + 8 * fq;
#pragma unroll
        for (int kg = 0; kg < 4; ++kg) {
            u32x4 a8[8];
#pragma unroll
            for (int kk = 0; kk < 8; ++kk) a8[kk] = *(const u32x4*)(xr + 32 * (8 * kg + kk));
            CFENCE();
#pragma unroll
            for (int kk = 0; kk < 8; ++kk) {
                const u32x4 a = a8[kk];
                const float x0 = bflo(a.x), x1 = bfhi(a.x), x2 = bflo(a.y), x3 = bfhi(a.y), x4 = bflo(a.z), x5 = bfhi(a.z), x6 = bflo(a.w), x7 = bfhi(a.w);
                ss += (x0 * x0 + x1 * x1) + (x2 * x2 + x3 * x3) + (x4 * x4 + x5 * x5) + (x6 * x6 + x7 * x7);
                acc = MFMA16(wf[8 * kg + kk], __builtin_bit_cast(bf16x8, a), acc);
            }
        }
        ss += __shfl_xor(ss, 16); ss += __shfl_xor(ss, 32);
        float lg4[4];
#pragma unroll
        for (int j = 0; j < 4; ++j) lg4[j] = acc[j] + __shfl_xor(acc[j], 32);
        float lg[8];
#pragma unroll
        for (int j = 0; j < 4; ++j) { const float o = __shfl_xor(lg4[j], 16); lg[j] = (fq & 1) ? o : lg4[j]; lg[4 + j] = (fq & 1) ? lg4[j] : o; }
        const float rs = rsqrtf(ss * (1.0f / D) + EPS);
        int e1 = 0; float l1 = lg[0];
#pragma unroll
        for (int e = 1; e < 8; ++e) if (lg[e] > l1) { l1 = lg[e]; e1 = e; }
        int e2 = -1; float l2 = -3.0e38f;
#pragma unroll
        for (int e = 0; e < 8; ++e) if (e != e1 && lg[e] > l2) { l2 = lg[e]; e2 = e; }
        const float w1 = 1.0f / (1.0f + __expf((l2 - l1) * rs));
        if (fq == 0) {
            const int p1 = __hip_atomic_fetch_add(lcnt + e1, 1, __ATOMIC_RELAXED, __HIP_MEMORY_SCOPE_WORKGROUP);
            const int p2 = __hip_atomic_fetch_add(lcnt + 8 + e2, 1, __ATOMIC_RELAXED, __HIP_MEMORY_SCOPE_WORKGROUP);
            const int i = m0 + fr - r0; rinfo[i] = e1 | (e2 << 4) | (p1 << 8) | (p2 << 20); rw[i] = w1; rr[i] = rs;
        }
    }
    __syncthreads();
    if (F.tid < 16) lbase[F.tid] = (int)__hip_atomic_fetch_add(cnt + F.tid, (unsigned)lcnt[F.tid], __ATOMIC_RELAXED, __HIP_MEMORY_SCOPE_AGENT);
    __syncthreads();
    for (int i = F.tid; i < r1 - r0; i += 512) {
        const int inf = rinfo[i], e1 = inf & 15, e2 = (inf >> 4) & 15, p1 = lbase[e1] + ((inf >> 8) & 4095), p2 = lbase[8 + e2] + ((inf >> 20) & 4095);
        const float w1 = rw[i], rs = rr[i];
        tok[e1 * 32768 + p1] = r0 + i; wl[e1 * 32768 + p1] = w1; rl[e1 * 32768 + p1] = rs;
        tok[(8 + e2) * 32768 + p2] = r0 + i; wl[(8 + e2) * 32768 + p2] = 1.0f - w1; rl[(8 + e2) * 32768 + p2] = rs;
    }
    __syncthreads();
}
__device__ __forceinline__ void final_norm(const Frame& F, bool from_xb) {
    const int lane = F.lane, gw = F.bid * 8 + F.wave, NGW = F.G * 8;
    const bf16* xo = from_xb ? wsp<bf16>(F, WS_XB) : wsp<bf16>(F, WS_XO); const float* g = F.in[26]; float* out = (float*)F.dout;
    f32x4 gv[4];
#pragma unroll
    for (int hh = 0; hh < 2; ++hh) { gv[2 * hh] = *(const f32x4*)(g + hh * 512 + lane * 8); gv[2 * hh + 1] = *(const f32x4*)(g + hh * 512 + lane * 8 + 4); }
    u32x4 n0 = {0u, 0u, 0u, 0u}, n1 = n0;
    if (gw < M) { n0 = *((const u32x4*)(xo + (size_t)gw * D) + lane); n1 = *((const u32x4*)(xo + (size_t)gw * D + 512) + lane); }
    for (int m = gw; m < M; m += NGW) {
        const u32x4 a0 = n0, a1 = n1;
        if (m + NGW < M) { n0 = *((const u32x4*)(xo + (size_t)(m + NGW) * D) + lane); n1 = *((const u32x4*)(xo + (size_t)(m + NGW) * D + 512) + lane); }
        CFENCE();
        const float x[16] = {bflo(a0.x), bfhi(a0.x), bflo(a0.y), bfhi(a0.y), bflo(a0.z), bfhi(a0.z), bflo(a0.w), bfhi(a0.w), bflo(a1.x), bfhi(a1.x), bflo(a1.y), bfhi(a1.y), bflo(a1.z), bfhi(a1.z), bflo(a1.w), bfhi(a1.w)};
        float ss = 0.f;
#pragma unroll
        for (int j = 0; j < 16; ++j) ss += x[j] * x[j];
        ss = wave_sum(ss); const float rs = rsqrtf(ss * (1.0f / D) + EPS);
#pragma unroll
        for (int hh = 0; hh < 2; ++hh) {
            const f32x4 g0 = gv[2 * hh], g1 = gv[2 * hh + 1];
            f32x4 o0 = {x[hh * 8 + 0] * rs * g0[0], x[hh * 8 + 1] * rs * g0[1], x[hh * 8 + 2] * rs * g0[2], x[hh * 8 + 3] * rs * g0[3]};
            f32x4 o1 = {x[hh * 8 + 4] * rs * g1[0], x[hh * 8 + 5] * rs * g1[1], x[hh * 8 + 6] * rs * g1[2], x[hh * 8 + 7] * rs * g1[3]};
            *(f32x4*)(out + (size_t)m * D + hh * 512 + lane * 8) = o0; *(f32x4*)(out + (size_t)m * D + hh * 512 + lane * 8 + 4) = o1;
        }
    }
}

__global__ void __launch_bounds__(512, 2) mk_fwd(Args args) {
    extern __shared__ __attribute__((aligned(16))) unsigned char lds_raw[];
    Frame F0;
    F0.lds = (LAS unsigned char*)lds_raw; F0.tid = threadIdx.x; F0.lane = F0.tid & 63; F0.wave = __builtin_amdgcn_readfirstlane(F0.tid >> 6);
    F0.G = gridDim.x; F0.bid = blockIdx.x; F0.in = args.in; F0.ws = args.ws; F0.dout = (unsigned char*)args.out;
    const Frame& F = F0;
    volatile LAS unsigned* MISC = (volatile LAS unsigned*)(F.lds + MISC_OFF);
    for (int u = F.tid; u < (LDS_BYTES - MISC_OFF) / 4; u += 512) MISC[u] = 0u;
    __syncthreads();
#if MK_N_LAUNCHES == 1
    XcdBarrier bar = xcd_barrier_post(wsp<unsigned>(F, WS_CTL) + CW_BAR, MISC);
#define GRID_BAR() xcd_barrier(bar)
#else
#define GRID_BAR() do {} while (0)
#endif
    const int lo = args.ph_lo, hi = args.ph_hi;
#ifndef PH_MASK
#define PH_MASK 0xFFFFFFu
#endif
#define IN(k) ((((PH_MASK) >> ((k) > 7 && (k) < 13 ? (k) - 7 : (k))) & 1u) && lo <= (k) && (k) < hi)
#define SEAM(k) do { if (IN(k) && IN((k) + 1)) GRID_BAR(); } while (0)
    LAS unsigned char* ring = F.lds;
#define xb wsp<bf16>(F, WS_XB)
#define ssp wsp<float>(F, WS_SSP)
#ifndef REP_PHASE
#define REP_PHASE (-1)
#endif
#ifndef REP_N
#define REP_N 0
#endif
#define REPS(k) (((k) == REP_PHASE) ? 1 + REP_N : 1)
#define REP_BEGIN(k) for (int rep = 0; rep < REPS(k); ++rep) {
#define REP_END(k) if (rep + 1 < REPS(k)) GRID_BAR(); }
    if (IN(0)) { REP_BEGIN(0) p0_prologue(launder(F0)); REP_END(0) } SEAM(0);

#pragma unroll 1
    for (int l = 0; l < 2; ++l) {
        const int pb = 1 + 7 * l;
        if (IN(pb)) {
            REP_BEGIN(1)
            const Frame F = launder(F0);
            pg8::ProbPlain P{xb, wsp<bf16>(F, WS_WIN) + (size_t)l * NPROJ * D, D, D, D};
            pg8::StaticOrder S; S.init(M / 256, 8, F.G, F.bid);
            EpiInproj E{ssp, F.ws + WS_ACT};
            pg8::gemm_phase(ring, P, S, E);
            glow_pass(launder(F0), l);
            REP_END(1)
        } SEAM(pb);
        if (IN(pb + 1)) {
            REP_BEGIN(2)
            const Frame F = launder(F0);
#ifndef PROBE_SUB
#define PROBE_SUB 0
#endif
#pragma unroll 1
            for (int pr = 0; pr < (PROBE_SUB == 1 ? 2 : 1); ++pr) for (int un = F.bid; un < 256; un += F.G) s5_unit(F, l, un);
#pragma unroll 1
            for (int pr = 0; pr < (PROBE_SUB == 2 ? 2 : 1); ++pr) for (int wu = F.bid * 8 + F.wave; wu < 2048; wu += F.G * 8) gla_a_unit(F, l, wu);
            REP_END(2)
        } SEAM(pb + 1);
        if (IN(pb + 2)) {
            REP_BEGIN(3)
            const Frame F = launder(F0);
            pg8::ProbPlain P{(const bf16*)(F.dout + DO_YS5), wsp<bf16>(F, WS_WGLU) + (size_t)l * 512 * 512, 512, 512, 512};
            pg8::StaticOrder S; S.init(M / 256, 2, F.G, F.bid);
            EpiGlu E{(const bf16*)(F.dout + DO_YS5), wsp<bf16>(F, WS_UGM), F.in[12] + l * 512};
            pg8::gemm_phase(ring, P, S, E);
#pragma unroll 1
            for (int pr = 0; pr < (PROBE_SUB == 3 ? 2 : 1); ++pr) gla_b_scan(launder(F0));
            REP_END(3)
        } SEAM(pb + 2);
        if (IN(pb + 3)) {
            REP_BEGIN(4)
            const Frame F = launder(F0);
#pragma unroll 1
            for (int pr = 0; pr < (PROBE_SUB == 4 ? 2 : 1); ++pr) for (int wu = F.bid * 8 + F.wave; wu < 2048; wu += F.G * 8) gla_c_unit(F, l, wu);
#pragma unroll 1
            for (int pr = 0; pr < (PROBE_SUB == 5 ? 2 : 1); ++pr) { s5_fin_rows(launder(F0), l); }
            REP_END(4)
        } SEAM(pb + 3);
        if (IN(pb + 4)) {
            REP_BEGIN(5)
            const Frame F = launder(F0);
            pg8::ProbPlain P{wsp<bf16>(F, WS_MIXED), wsp<bf16>(F, WS_WOUT) + (size_t)l * D * D, D, D, D};
            pg8::StaticOrder S; S.init(M / 256, 4, F.G, F.bid);
            const bool want8 = (l == 0) ? (USE_F8_FFN != 0) : (USE_F8_MOE != 0);
            EpiResid E{xb, ssp, rep ? (bf16*)F.dout : xb, rep == 0, (want8 && rep == 0) ? wsp<unsigned char>(F, WS_X8) : nullptr, 1.0f};
            pg8::gemm_phase(ring, P, S, E);
            REP_END(5)
        } SEAM(pb + 4);
        if (l == 0) {
            if (IN(6)) {
                REP_BEGIN(6)
                const Frame F = launder(F0);
                constexpr int KU = USE_F8_FFN ? D / 2 : D;
                pg8::ProbPlainT<USE_F8_FFN != 0> P{USE_F8_FFN ? wsp<bf16>(F, WS_X8) : xb, wsp<bf16>(F, WS_WFGU), KU, KU, KU};
                pg8::StaticOrder S; S.init(M / 256, 2 * DFF / 256, F.G, F.bid);
                EpiSwigluT<USE_F8_FFN != 0> E{ssp, wsp<bf16>(F, WS_HD), DFF};
                pg8::gemm_phase(ring, P, S, E);
                REP_END(6)
            } SEAM(6);
            if (IN(7)) {
                REP_BEGIN(7)
                const Frame F = launder(F0);
                constexpr int KD = USE_F8_FFN ? DFF / 2 : DFF;
                pg8::ProbPlainT<USE_F8_FFN != 0, true> P{wsp<bf16>(F, WS_HD), wsp<bf16>(F, WS_WFD), KD, KD, KD};
                pg8::StaticOrder S; S.init(M / 256, 4, F.G, F.bid);
                EpiResid E{xb, ssp, rep ? (bf16*)F.dout : xb, rep == 0, nullptr, USE_F8_FFN ? 1.0f / (F8_SH * F8_SW_DN) : 1.0f};
                pg8::gemm_phase(ring, P, S, E);
                REP_END(7)
            } SEAM(7);
        }
    }
    if (IN(13)) { moe_router(launder(F0)); } SEAM(13);
#pragma unroll 1
    for (int s = 0; s < 5; ++s) {
        if (IN(14 + s)) {
            const Frame F = launder(F0);
            if (s == 0 || lo == 14 + s) moe_build_tables(F);
            const MoeTab T = moe_tab(F);
            int nheavy = 0;
            if (s >= 1) {
                REP_BEGIN(15)
                constexpr int KD = DFE * MOE_ESZ / 2;
                ProbMoeDown P{((s - 1) & 1) ? (void*)wsp<bf16>(F, WS_H1) : (void*)F.dout, wsp<bf16>(F, WS_MD), KD, KD, KD};
                MoeOrder S; S.init(T, s - 1, 4, F.G, F.bid, 0, 0);
                nheavy = S.nheavy_next();
                EpiMoeDown E{wsp<int>(F, WS_TOK), wsp<float>(F, WS_WL), xb, wsp<bf16>(F, WS_XO), T, rep != 0};
                pg8::gemm_phase(ring, P, S, E);
                REP_END(15)
            }
            if (s < 4) {
                REP_BEGIN(14)
                constexpr int KU = D * MOE_ESZ / 2;
                ProbMoeUp P{USE_F8_MOE ? (const void*)wsp<unsigned char>(F, WS_X8) : (const void*)xb, wsp<bf16>(F, WS_MGU), wsp<int>(F, WS_TOK), T, KU, KU, KU};
                MoeOrder S; S.init(T, s, 2 * DFE / 256, F.G, F.bid, nheavy, 3);
                EpiSwigluMoe E{wsp<float>(F, WS_RL), (s & 1) ? (void*)wsp<bf16>(F, WS_H1) : (void*)F.dout, T};
                pg8::gemm_phase(ring, P, S, E);
                REP_END(14)
            }
        } SEAM(14 + s);
    }
    if (IN(19)) { REP_BEGIN(19) final_norm(launder(F0), hi > 50); REP_END(19) }
#undef xb
#undef ssp
#undef IN
#undef SEAM
}

extern "C" void kernel_launch(void* const* d_in, const int* in_sizes, int n_in, void* d_out, int out_size, void* d_ws, size_t ws_size, hipStream_t stream) {
    static int grid = 0;
    if (grid == 0) {
        if (n_in != 27 || in_sizes[0] != M * D || out_size != M * D || ws_size < WS_END) { fprintf(stderr, "kernel_launch: unexpected shapes (n_in %d, ws %zu < %zu?)\n", n_in, ws_size, (size_t)WS_END); grid = -1; return; }
        int dev = 0, cus = 0, per_cu = 0;
        if (hipGetDevice(&dev) != hipSuccess || hipDeviceGetAttribute(&cus, hipDeviceAttributeMultiprocessorCount, dev) != hipSuccess) { grid = -1; return; }
        if (hipFuncSetAttribute((const void*)mk_fwd, hipFuncAttributeMaxDynamicSharedMemorySize, LDS_BYTES) != hipSuccess) { fprintf(stderr, "kernel_launch: hipFuncSetAttribute failed\n"); grid = -1; return; }
        if (hipOccupancyMaxActiveBlocksPerMultiprocessor(&per_cu, (const void*)mk_fwd, 512, LDS_BYTES) != hipSuccess || per_cu < 1) fprintf(stderr, "kernel_launch: occupancy query says %d\n", per_cu);
        (void)hipGetLastError();
        grid = cus;
    }
    if (grid < 0) return;
    if (hipMemsetAsync((char*)d_ws + WS_CTL, 0, CTL_ZERO_BYTES, stream) != hipSuccess) return;
    Args a{};
    for (int i = 0; i < 27; ++i) a.in[i] = (const float*)d_in[i];
    a.out = (float*)d_out; a.ws = (unsigned char*)d_ws;
#if MK_N_LAUNCHES == 1
#ifdef PROBE_PREFIX
    a.ph_lo = 0; a.ph_hi = PROBE_PREFIX + 1;
    hipLaunchKernelGGL(mk_fwd, dim3(grid), dim3(512), LDS_BYTES, stream, a);
    if (hipMemsetAsync((char*)d_ws + WS_CTL, 0, CTL_ZERO_BYTES, stream) != hipSuccess) return;
#endif
    a.ph_lo = 0; a.ph_hi = NPHASE;
    hipLaunchKernelGGL(mk_fwd, dim3(grid), dim3(512), LDS_BYTES, stream, a);
#else
#ifdef EXP_STOP
    for (int p = 0; p <= EXP_STOP; ++p) { a.ph_lo = p; a.ph_hi = p + 1; hipLaunchKernelGGL(mk_fwd, dim3(grid), dim3(512), LDS_BYTES, stream, a); }
    a.ph_lo = 19; a.ph_hi = 100; hipLaunchKernelGGL(mk_fwd, dim3(grid), dim3(512), LDS_BYTES, stream, a);
#else
    for (int p = 0; p < NPHASE; ++p) { a.ph_lo = p; a.ph_hi = p + 1; hipLaunchKernelGGL(mk_fwd, dim3(grid), dim3(512), LDS_BYTES, stream, a); }
#endif
#endif
}
```

```cpp
#include <hip/hip_runtime.h>
#include <cstdio>
#include <cstdint>

#ifndef USE_F8_FFN_DOWN
#define USE_F8_FFN_DOWN 1
#endif
#ifndef USE_F8_FFN
#define USE_F8_FFN 0
#endif
#ifndef USE_F8_MOE
#define USE_F8_MOE 1
#endif
#ifndef MK_N_LAUNCHES
#define MK_N_LAUNCHES 1
#endif

#define LAS __attribute__((address_space(3)))
#define GAS __attribute__((address_space(1)))
typedef unsigned short bf16;
typedef short bf16x8 __attribute__((ext_vector_type(8)));
typedef short s16x4 __attribute__((ext_vector_type(4)));
typedef short v4i16_t __attribute__((ext_vector_type(4)));
typedef float f32x4 __attribute__((ext_vector_type(4)));
typedef float f32x2 __attribute__((ext_vector_type(2)));
typedef unsigned u32x4 __attribute__((ext_vector_type(4)));
typedef unsigned u32x2 __attribute__((ext_vector_type(2)));
typedef int i32x4_t __attribute__((ext_vector_type(4)));

constexpr int BATCH = 8, SEQ = 4096, D = 1024, M = BATCH * SEQ;
constexpr int DS5 = 512, NGRP = 32, NST = 64;
constexpr int GH = 4, DK = 64, DV = 128, DGK = 256, DGV = 512, NCH = SEQ / 64;
constexpr int DIN = 2064, NPROJ = 2304;
constexpr int DFF = 2816, NE = 8, DFE = 3584;
constexpr float EPS = 1e-6f;
constexpr int NPHASE = 20;

constexpr size_t MiB = 1u << 20;
constexpr size_t WS_CTL = 0, CTL_ZERO_BYTES = 2 * MiB;
constexpr size_t WS_SSP = 2 * MiB;
constexpr size_t WS_WIN = 4 * MiB;
constexpr size_t WS_WGLU = 13 * MiB;
constexpr size_t WS_WOUT = 14 * MiB;
constexpr size_t WS_WFGU = 18 * MiB;
constexpr size_t WS_WFD = 29 * MiB;
constexpr size_t WS_S5P = 35 * MiB;
constexpr size_t WS_S5MQ = 39 * MiB;
constexpr size_t WS_S5A16 = 51 * MiB;
constexpr size_t WS_WGT = 51 * MiB + 65536;
constexpr size_t WS_WA2T = 51 * MiB + 131072;
constexpr size_t WS_MGU = 52 * MiB;
constexpr size_t WS_MD = (USE_F8_MOE ? 108 : 164) * MiB;
constexpr size_t WS_X8 = (USE_F8_MOE ? 136 : 500) * MiB;
static_assert(USE_F8_MOE || !USE_F8_FFN, "x8 lives in the space the fp8 expert weights leave free");
constexpr size_t WS_XB = 220 * MiB;
constexpr size_t WS_ACT = 284 * MiB;
constexpr size_t WS_UGM = WS_ACT;
constexpr size_t WS_Q = WS_ACT + 32 * MiB;
constexpr size_t WS_K = WS_ACT + 48 * MiB;
constexpr size_t WS_V = WS_ACT + 64 * MiB;
constexpr size_t WS_R = WS_ACT + 96 * MiB;
constexpr size_t WS_GL = WS_ACT + 128 * MiB;
constexpr size_t WS_MIXED = WS_ACT + 144 * MiB;
constexpr size_t WS_HD = WS_ACT;
constexpr size_t WS_H1 = WS_ACT;
constexpr size_t WS_XO = WS_ACT + 120 * MiB;
constexpr size_t WS_TOK = WS_ACT + 184 * MiB;
constexpr size_t WS_WL = WS_ACT + 186 * MiB;
constexpr size_t WS_RL = WS_ACT + 188 * MiB;
constexpr size_t WS_DEC = WS_ACT + 208 * MiB;
constexpr size_t WS_END = WS_ACT + 209 * MiB;
constexpr size_t DO_UT = 0, DO_ST = 64 * MiB, DO_YS5 = 96 * MiB;
constexpr int MOE_CAP_TILES = 68;
constexpr int CW_BAR = 4096;
constexpr int CW_CNT = 16384;

constexpr int RING_BYTES = 131072;
constexpr int MOE_TAB_OFF = 131072;
constexpr int MISC_OFF = 147456;
constexpr int LDS_BYTES = 148480;
constexpr int WAVE_LDS = 18432;

#define LDS_WAIT() asm volatile("s_waitcnt lgkmcnt(0)" ::: "memory")
#define VM_WAIT() asm volatile("s_waitcnt vmcnt(0)" ::: "memory")
#define CFENCE() asm volatile("" ::: "memory")
__device__ __forceinline__ unsigned f2bf(float f) { unsigned u = __builtin_bit_cast(unsigned, f); return (u + 0x7fffu + ((u >> 16) & 1u)) >> 16; }
__device__ __forceinline__ unsigned pk2(float lo, float hi) { return f2bf(lo) | (f2bf(hi) << 16); }
__device__ __forceinline__ float bf2f(unsigned b) { return __builtin_bit_cast(float, b << 16); }
__device__ __forceinline__ float bflo(unsigned w) { return __builtin_bit_cast(float, w << 16); }
__device__ __forceinline__ float bfhi(unsigned w) { return __builtin_bit_cast(float, w & 0xffff0000u); }
typedef __bf16 bf16x2_t __attribute__((ext_vector_type(2)));
__device__ __forceinline__ unsigned cvt_pk_bf16(float lo, float hi) { const f32x2 v = {lo, hi}; return __builtin_bit_cast(unsigned, __builtin_convertvector(v, bf16x2_t)); }
__device__ __forceinline__ unsigned pk4_fp8(float a, float b, float c, float d) {
    a = __builtin_amdgcn_fmed3f(a, -448.f, 448.f); b = __builtin_amdgcn_fmed3f(b, -448.f, 448.f); c = __builtin_amdgcn_fmed3f(c, -448.f, 448.f); d = __builtin_amdgcn_fmed3f(d, -448.f, 448.f);
    int w = 0; w = __builtin_amdgcn_cvt_pk_fp8_f32(a, b, w, false); w = __builtin_amdgcn_cvt_pk_fp8_f32(c, d, w, true); return (unsigned)w;
}
__device__ __forceinline__ f32x2 swiglu2(f32x2 g, f32x2 u, float nrs, float c) {
    const f32x2 t = g * nrs;
    f32x2 d = {__builtin_amdgcn_exp2f(t[0]), __builtin_amdgcn_exp2f(t[1])};
    d = d + 1.0f;
    const f32x2 r = {__builtin_amdgcn_rcpf(d[0]), __builtin_amdgcn_rcpf(d[1])};
    return (g * u) * (r * c);
}
constexpr float F8_SW_UP = 64.f, F8_SH = 4.f, F8_SW_DN = 128.f;
__device__ __forceinline__ float wave_sum(float v) {
#pragma unroll
    for (int o = 1; o < 64; o <<= 1) v += __shfl_xor(v, o);
    return v;
}
__device__ __forceinline__ float sigmoidf_(float z) { return __builtin_amdgcn_rcpf(1.0f + __expf(-z)); }
__device__ __forceinline__ float siluf_(float z) { return z * __builtin_amdgcn_rcpf(1.0f + __expf(-z)); }
__device__ __forceinline__ float gelu_tanh(float y) { const float z = 0.7978845608028654f * (y + 0.044715f * y * y * y); return y * __builtin_amdgcn_rcpf(1.0f + __expf(-2.0f * z)); }

#define XB_TMO      128
#define XB_XCNT(j)  (256  + 64 * (j))
#define XB_XSUB(j)  (1280 + 64 * (j))
#define XB_XGEN(j)  (2304 + 64 * (j))
#define XB_TOP      3328
#define XB_TOPGEN   3392
#define XCD_BAR_WORDS 3456
#define XB_SPIN_CAP (1u << 18)
__device__ __forceinline__ unsigned xb_ld(unsigned* p)              { return __hip_atomic_load(p, __ATOMIC_RELAXED, __HIP_MEMORY_SCOPE_AGENT); }
__device__ __forceinline__ unsigned xb_add(unsigned* p, unsigned v) { return __hip_atomic_fetch_add(p, v, __ATOMIC_RELAXED, __HIP_MEMORY_SCOPE_AGENT); }
__device__ __forceinline__ unsigned xb_xcc_id() { return (unsigned)__builtin_amdgcn_s_getreg((3 << 11) | 20) & 0xFu; }
#define XB_SPIN(cond, bar) do { unsigned _sp = 0; while (cond) { __builtin_amdgcn_s_sleep(1); \
    if ((++_sp & 255u) == 0u) { if (xb_ld(&(bar)[XB_TMO])) break; if (_sp > XB_SPIN_CAP) { atomicAdd(&(bar)[XB_TMO], 1u); break; } } } } while (0)
struct XcdBarrier { unsigned* bar; unsigned x; volatile LAS unsigned* st; };
__device__ __forceinline__ XcdBarrier xcd_barrier_post(unsigned* bar, volatile LAS unsigned* st) {
    XcdBarrier b; b.bar = bar; b.x = xb_xcc_id(); b.st = st;
    if (threadIdx.x == 0) (void)xb_add(&bar[XB_XCNT(b.x)], 1u);
    return b;
}
__device__ __forceinline__ void xcd_barrier_complete(unsigned* bar, unsigned x, unsigned& nloc, unsigned& nx) {
    const unsigned G = gridDim.x * gridDim.y * gridDim.z;
    unsigned sum, cnt, mine, sp = 0u;
    for (;;) {
        sum = 0u; cnt = 0u; mine = 0u;
#pragma unroll
        for (unsigned j = 0; j < 16; ++j) { const unsigned c = xb_ld(&bar[XB_XCNT(j)]); sum += c; cnt += (c > 0u) ? 1u : 0u; mine = (j == x) ? c : mine; }
        if (sum == G) break;
        __builtin_amdgcn_s_sleep(1);
        if ((++sp & 255u) == 0u) { if (xb_ld(&bar[XB_TMO])) break; if (sp > XB_SPIN_CAP) { atomicAdd(&bar[XB_TMO], 1u); break; } }
    }
    nloc = mine > 0u ? mine : 1u; nx = cnt > 0u ? cnt : 1u;
}
__device__ __forceinline__ void xcd_barrier(const XcdBarrier& b) {
    asm volatile("s_waitcnt vmcnt(0)" ::: "memory");
    __syncthreads();
    if (threadIdx.x == 0) {
        unsigned* bar = b.bar;
        __builtin_amdgcn_s_waitcnt(0);
        unsigned nloc = b.st[0], nx = b.st[1];
        if (nloc == 0u) { xcd_barrier_complete(bar, b.x, nloc, nx); b.st[0] = nloc; b.st[1] = nx; }
        const unsigned old = xb_add(&bar[XB_XSUB(b.x)], 1u);
        const unsigned gen = old / nloc;
        if (old + 1u == (gen + 1u) * nloc) {
            __builtin_amdgcn_fence(__ATOMIC_RELEASE, "agent");
            asm volatile("s_waitcnt vmcnt(0)" ::: "memory");
            const unsigned og = xb_add(&bar[XB_TOP], 1u);
            const unsigned tg = og / nx;
            if (og + 1u == (tg + 1u) * nx) xb_add(&bar[XB_TOPGEN], 1u);
            else XB_SPIN(xb_ld(&bar[XB_TOPGEN]) == tg, bar);
            __builtin_amdgcn_fence(__ATOMIC_ACQUIRE, "agent");
            xb_add(&bar[XB_XGEN(b.x)], 1u);
            asm volatile("s_waitcnt vmcnt(0)" ::: "memory");
        } else {
            XB_SPIN(xb_ld(&bar[XB_XGEN(b.x)]) == gen, bar);
            __builtin_amdgcn_fence(__ATOMIC_ACQUIRE, "agent");
            asm volatile("s_waitcnt vmcnt(0)" ::: "memory");
        }
    }
    __syncthreads();
}

namespace pg8 {
constexpr int BM = 256, BK = 64, HALF = 128, HTB = HALF * BK * 2, STAGE_BYTES = 8 * HTB, NXCD = 8, WGM = 8;
constexpr int A_TAB_OFF = 131072 + 8192;
constexpr int EPI_TAB_OFF = 131072 + 4096;
__host__ __device__ __forceinline__ int lds_byte(int r, int c) { const int st = (r >> 4) * 2 + (c >> 5), rr = r & 15, cc = c & 31, ob = rr * 64 + cc * 2; return st * 1024 + (ob ^ (((ob >> 9) & 1) << 5)); }
__host__ __device__ __forceinline__ void stage_rc(int b, int& R, int& C) { const int st = b / 1024, sb = b % 1024, swz = sb ^ (((sb >> 9) & 1) << 5); R = (st >> 1) * 16 + swz / 64; C = (st & 1) * 32 + (swz % 64) / 2; }
__host__ __device__ __forceinline__ int perm32(int rho) { const int n = rho >> 4, i = rho & 15; return 8 * (i >> 2) + 4 * n + (i & 3); }

struct Unit { int pm, pn, e, sub; };

struct StaticOrder {
    int nM, nN, nwg, G, c;
    __device__ __forceinline__ void init(int nM_, int nN_, int G_, int c_) { nM = nM_; nN = nN_; nwg = nM * nN; G = G_; c = c_; }
    __device__ __forceinline__ bool next(int i, Unit& u) const {
        const long L = (long)i * G + c; if (L >= nwg) return false;
        int wgid = (int)L; { const int q = nwg / NXCD, r = nwg % NXCD, xcd = wgid % NXCD, off = wgid / NXCD; wgid = (xcd < r ? xcd * (q + 1) : r * (q + 1) + (xcd - r) * q) + off; }
        const int nig = WGM * nN, gid = wgid / nig, fm = gid * WGM, gsz = (nM - fm) < WGM ? (nM - fm) : WGM;
        u.pm = fm + ((wgid % nig) % gsz); u.pn = (wgid % nig) / gsz; u.e = 0; u.sub = 0; return true;
    }
};

template <class Epi, class Sched, class Prob>
__device__ __forceinline__ void gemm_phase(LAS unsigned char* lds, const Prob& P, const Sched& S, const Epi& E) {
    int tid_ = threadIdx.x; asm volatile("" : "+v"(tid_));
    const int tid = tid_, wid = __builtin_amdgcn_readfirstlane(tid >> 6), lane = tid & 63, wr = wid >> 2, wc = wid & 3, fr = lane & 15, fq = lane >> 4;
    const int K = P.K, nt = K / BK;
    int Rr[2], Cc[2]; unsigned voffB[2];
#pragma unroll
    for (int i = 0; i < 2; ++i) { int R, C; stage_rc(tid * 16 + i * 8192, R, C); Rr[i] = R; Cc[i] = C; const int Rb = (R & ~31) + perm32(R & 31); voffB[i] = (unsigned)(Rb * P.ldb + C) * 2u; }
    const size_t kstep = (size_t)(BK * 2);
    const size_t hstepB = (size_t)HALF * P.ldb * 2;
    const unsigned ldsw = (unsigned)wid * 1024u;
    const int aoff = lds_byte(wr * 64 + fr, fq * 8), boff = lds_byte(wc * 32 + fr, fq * 8);
#define PG8_SA(b, h) (((b) * 2 + (h)) * HTB)
#define PG8_SB(b, h) ((4 + (b) * 2 + (h)) * HTB)
#define PG8_STAGE(bufoff, gbase, voff) do { _Pragma("unroll") for (int _i = 0; _i < 2; ++_i) \
        __builtin_amdgcn_global_load_lds((const unsigned*)((const char*)(gbase) + (voff)[_i]), (LAS unsigned*)(lds + (bufoff) + ldsw + _i * 8192), 16, 0, 0); } while (0)
#define PG8_LDA(dst, b, h) do { _Pragma("unroll") for (int m = 0; m < 4; ++m) _Pragma("unroll") for (int k = 0; k < 2; ++k) dst[m][k] = *(const LAS bf16x8*)(lds + PG8_SA(b, h) + aoff + m * 2048 + k * 1024); } while (0)
#define PG8_LDB(dst, b, h) do { _Pragma("unroll") for (int n = 0; n < 2; ++n) _Pragma("unroll") for (int k = 0; k < 2; ++k) dst[n][k] = *(const LAS bf16x8*)(lds + PG8_SB(b, h) + boff + n * 2048 + k * 1024); } while (0)
#define PG8_CAT(x) __builtin_shufflevector(__builtin_bit_cast(i32x4_t, (x)[0]), __builtin_bit_cast(i32x4_t, (x)[1]), 0, 1, 2, 3, 4, 5, 6, 7)
#define PG8_MMA(ai, bj, At, Bt) do { __builtin_amdgcn_s_setprio(1); _Pragma("unroll") for (int m = 0; m < 4; ++m) _Pragma("unroll") for (int n = 0; n < 2; ++n) { \
        if constexpr (Prob::F8) asm volatile("v_mfma_scale_f32_16x16x128_f8f6f4 %0, %1, %2, %0, %3, %3 op_sel_hi:[0,0,0]" : "+v"(acc[ai][bj][m][n]) : "v"(PG8_CAT(Bt[n])), "v"(PG8_CAT(At[m])), "v"(f8one)); \
        else { _Pragma("unroll") for (int k = 0; k < 2; ++k) acc[ai][bj][m][n] = __builtin_amdgcn_mfma_f32_16x16x32_bf16(Bt[n][k], At[m][k], acc[ai][bj][m][n], 0, 0, 0); } } \
        __builtin_amdgcn_s_setprio(0); } while (0)
#define PG8_WAIT_V(n) asm volatile("s_waitcnt vmcnt(" #n ")" ::: "memory")
#define PG8_WAIT_L(n) asm volatile("s_waitcnt lgkmcnt(" #n ")" ::: "memory")
#define PG8_BAR __builtin_amdgcn_s_barrier()
#define PG8_SCHED __builtin_amdgcn_sched_barrier(0)
    const int f8one = 0x7f7f7f7f;
    Unit cur, nxt; int ui = 0;
    if (!S.next(0, cur)) return;
    f32x4 acc[2][2][4][2];
#pragma unroll
    for (int a = 0; a < 2; ++a)
#pragma unroll
        for (int b = 0; b < 2; ++b)
#pragma unroll
            for (int m = 0; m < 4; ++m)
#pragma unroll
                for (int n = 0; n < 2; ++n) acc[a][b][m][n] = (f32x4){0.f, 0.f, 0.f, 0.f};
    bf16x8 At[4][2], B0[2][2], B1[2][2];
    constexpr bool GA = Prob::GATHER;
    constexpr int NH = GA ? 2 : 1;
    unsigned vA[NH][2], nvA[NH][2];
    const size_t hstepA = GA ? (size_t)0 : P.hstep_a();
    const size_t kstepA = P.kstep_a();
    P.a_off(cur, Rr, Cc, vA);
    const char* cA = P.a_ptr(cur); const char* cB = P.b_ptr(cur);
#define PG8_STAGEA(bufoff, gbase, h, arr) do { _Pragma("unroll") for (int _i = 0; _i < 2; ++_i) \
        __builtin_amdgcn_global_load_lds((const unsigned*)((const char*)(gbase) + (GA ? (size_t)0 : (size_t)(h) * hstepA) + (arr)[GA ? (h) : 0][_i]), (LAS unsigned*)(lds + (bufoff) + ldsw + _i * 8192), 16, 0, 0); } while (0)
    if constexpr (GA) { Unit u1; if (S.next(1, u1)) P.atab_issue(u1, lds + A_TAB_OFF + 1024, wid, lane); }
    PG8_STAGE(PG8_SB(0, 0), cB, voffB); PG8_STAGE(PG8_SB(0, 1), cB + hstepB, voffB); PG8_STAGEA(PG8_SA(0, 0), cA, 0, vA); PG8_STAGEA(PG8_SA(0, 1), cA, 1, vA);
    if (wr == 1) PG8_BAR;
    PG8_WAIT_V(2); PG8_BAR;
    PG8_STAGE(PG8_SB(1, 0), cB + kstep, voffB); PG8_STAGEA(PG8_SA(1, 0), cA + kstepA, 0, vA); PG8_STAGE(PG8_SB(1, 1), cB + hstepB + kstep, voffB);
    PG8_WAIT_V(6); PG8_BAR;
    for (;;) {
        const bool has_next = S.next(ui + 1, nxt);
        const char* nA = has_next ? P.a_ptr(nxt) : cA; const char* nB = has_next ? P.b_ptr(nxt) : cB;
        if constexpr (GA) {
            if (has_next) { int R2[2], C2[2], t2 = tid; asm volatile("" : "+v"(t2));
#pragma unroll
                for (int i = 0; i < 2; ++i) stage_rc(t2 * 16 + i * 8192, R2[i], C2[i]);
                P.a_off_tab(lds + A_TAB_OFF + ((ui + 1) & 1) * 1024, R2, C2, nvA);
                Unit n2; if (S.next(ui + 2, n2)) P.atab_issue(n2, lds + A_TAB_OFF + (ui & 1) * 1024, wid, lane); }
            else {
#pragma unroll
                for (int h = 0; h < NH; ++h)
#pragma unroll
                    for (int i = 0; i < 2; ++i) nvA[h][i] = vA[h][i];
            }
        }
        if constexpr (Epi::HAS_TAB) E.tab_issue(cur, lds + EPI_TAB_OFF + (ui & 1) * 2048, wid, lane);
        for (int t = 0; t < nt; t += 2) {
            const bool last = (t == nt - 2);
            const char* a1 = cA + (size_t)(t + 1) * kstepA;
            const char* a2 = last ? nA : cA + (size_t)(t + 2) * kstepA; const char* b2 = last ? nB : cB + (size_t)(t + 2) * kstep;
            const char* a3 = a2 + kstepA; const char* b3 = b2 + kstep;
            unsigned wA[NH][2];
#pragma unroll
            for (int h = 0; h < NH; ++h)
#pragma unroll
                for (int i = 0; i < 2; ++i) wA[h][i] = (GA && last) ? nvA[h][i] : vA[h][i];
            PG8_LDB(B0, 0, 0); PG8_LDB(B1, 0, 1); PG8_SCHED; PG8_LDA(At, 0, 0); PG8_STAGEA(PG8_SA(1, 1), a1, 1, vA);
            PG8_WAIT_V(8); PG8_WAIT_L(0); PG8_BAR; PG8_MMA(0, 0, At, B0); PG8_MMA(0, 1, At, B1); PG8_BAR; PG8_SCHED;
            PG8_LDA(At, 0, 1); PG8_STAGE(PG8_SB(0, 0), b2, voffB); PG8_STAGE(PG8_SB(0, 1), b2 + hstepB, voffB); PG8_STAGEA(PG8_SA(0, 0), a2, 0, wA);
            PG8_WAIT_V(8); PG8_WAIT_L(0); PG8_BAR; PG8_MMA(1, 0, At, B0); PG8_MMA(1, 1, At, B1); PG8_BAR; PG8_SCHED;
            PG8_LDB(B0, 1, 0); PG8_LDB(B1, 1, 1); PG8_SCHED; PG8_LDA(At, 1, 0); PG8_STAGEA(PG8_SA(0, 1), a2, 1, wA);
            PG8_WAIT_V(8); PG8_WAIT_L(0); PG8_BAR; PG8_MMA(0, 0, At, B0); PG8_MMA(0, 1, At, B1); PG8_BAR; PG8_SCHED;
            PG8_LDA(At, 1, 1); PG8_STAGE(PG8_SB(1, 0), b3, voffB); PG8_STAGE(PG8_SB(1, 1), b3 + hstepB, voffB); PG8_STAGEA(PG8_SA(1, 0), a3, 0, wA);
            PG8_WAIT_V(8); PG8_WAIT_L(0); PG8_BAR; PG8_MMA(1, 0, At, B0); PG8_MMA(1, 1, At, B1); PG8_BAR; PG8_SCHED;
        }
        if (wr == 0) PG8_BAR;
        if constexpr (Prob::F8) asm volatile("s_nop 15\n\ts_nop 7" ::: "memory");
        if constexpr (Epi::HAS_TAB) E(acc, cur, wr, wc, fr, fq, lds + EPI_TAB_OFF + (ui & 1) * 2048);
        else E(acc, cur, wr, wc, fr, fq);
        if (!has_next) break;
#pragma unroll
        for (int a = 0; a < 2; ++a)
#pragma unroll
            for (int b = 0; b < 2; ++b)
#pragma unroll
                for (int m = 0; m < 4; ++m)
#pragma unroll
                    for (int n = 0; n < 2; ++n) acc[a][b][m][n] = (f32x4){0.f, 0.f, 0.f, 0.f};
        cur = nxt; cA = nA; cB = nB; ++ui;
        if constexpr (GA) {
#pragma unroll
            for (int h = 0; h < NH; ++h)
#pragma unroll
                for (int i = 0; i < 2; ++i) vA[h][i] = nvA[h][i];
        }
        if (wr == 1) PG8_BAR;
    }
    PG8_WAIT_V(0);
    PG8_BAR;
#undef PG8_SA
#undef PG8_SB
#undef PG8_STAGE
#undef PG8_STAGEA
#undef PG8_LDA
#undef PG8_LDB
#undef PG8_MMA
#undef PG8_CAT
#undef PG8_WAIT_V
#undef PG8_WAIT_L
#undef PG8_BAR
#undef PG8_SCHED
}

template <bool F8_ = false, bool TILED_ = false> struct ProbPlainT {
    static constexpr bool GATHER = false, F8 = F8_;
    const bf16* A; const bf16* Bt; int lda, ldb, K;
    __device__ __forceinline__ const char* a_ptr(const Unit& u) const { return TILED_ ? (const char*)A + (size_t)u.pm * (K / BK) * 32768 : (const char*)(A + (size_t)u.pm * BM * lda); }
    __device__ __forceinline__ const char* b_ptr(const Unit& u) const { return (const char*)(Bt + (size_t)u.pn * BM * ldb); }
    __device__ __forceinline__ size_t hstep_a() const { return TILED_ ? (F8_ ? (size_t)2048 : (size_t)4096) : (size_t)HALF * lda * 2; }
    __device__ __forceinline__ size_t kstep_a() const { return TILED_ ? (size_t)32768 : (size_t)(BK * 2); }
    __device__ __forceinline__ void a_off(const Unit&, const int (&R)[2], const int (&C)[2], unsigned (&off)[1][2]) const {
#pragma unroll
        for (int i = 0; i < 2; ++i) {
            if (TILED_ && F8_) { const int wr = R[i] >> 6, m = (R[i] >> 4) & 3, fr = R[i] & 15, cb = 2 * C[i]; off[0][i] = (unsigned)((((wr * 4 + (cb >> 5)) * 2) * 4 + m) * 512 + fr * 32 + (cb & 31)); }
            else if (TILED_) { const int wr = R[i] >> 6, m = (R[i] >> 4) & 3, fr = R[i] & 15, cb = 2 * C[i]; off[0][i] = (unsigned)((((wr * 2 + (cb >> 6)) * 2) * 4 + m) * 1024 + fr * 64 + (cb & 63)); }
            else off[0][i] = (unsigned)(R[i] * lda + C[i]) * 2u;
        }
    }
};
typedef ProbPlainT<false> ProbPlain;
}

struct Args { const float* in[27]; float* out; unsigned char* ws; int ph_lo, ph_hi; };
struct Frame {
    LAS unsigned char* lds;
    int tid, lane, wave, G, bid;
    const float* const* in; unsigned char* ws; unsigned char* dout;
};
template <class T> __device__ __forceinline__ T* wsp(const Frame& F, size_t off) { return (T*)(F.ws + off); }
__device__ __forceinline__ Frame launder(const Frame& F0) {
    Frame F = F0; int t = F0.tid; asm volatile("" : "+v"(t)); F.tid = t; F.lane = t & 63; F.wave = __builtin_amdgcn_readfirstlane(t >> 6);
    int z = 0; asm volatile("" : "+s"(z));
    F.ws = F0.ws + z; F.dout = F0.dout + z; F.in = (const float* const*)((const char*)F0.in + z); return F;
}

__device__ __forceinline__ float row_rstd(const float* ssp, int r) {
    const f32x4* p = (const f32x4*)(ssp + (size_t)r * 16);
    const f32x4 a = p[0], b = p[1], c = p[2], d = p[3];
    const float s = ((a[0] + a[1]) + (a[2] + a[3])) + ((b[0] + b[1]) + (b[2] + b[3])) + ((c[0] + c[1]) + (c[2] + c[3])) + ((d[0] + d[1]) + (d[2] + d[3]));
    return rsqrtf(s * (1.0f / D) + EPS);
}

typedef pg8::Unit Unit;
struct EpiInproj {
    static constexpr bool HAS_TAB = false;
    const float* ssp; unsigned char* act;
    __device__ __forceinline__ void operator()(const f32x4 (&acc)[2][2][4][2], const Unit& u, int wr, int wc, int fr, int fq) const {
        static_assert(WS_UGM == WS_ACT && WS_Q == WS_ACT + 32 * MiB && WS_K == WS_ACT + 48 * MiB && WS_V == WS_ACT + 64 * MiB && WS_R == WS_ACT + 96 * MiB, "in-proj destination arithmetic");
        const unsigned pn = (unsigned)u.pn;
        const bool isu = pn < 2u;
        bf16* const base = (bf16*)(act + (size_t)((0x66443200u >> (4u * pn)) & 15u) * (16 * MiB));
        const unsigned stride = 512u >> ((0x0Cu >> pn) & 1u);
        const unsigned cb = ((pn >> 2) & pn & 1u) * 256u;
#pragma unroll
        for (int ai = 0; ai < 2; ++ai) {
            float rs4[4];
#pragma unroll
            for (int m = 0; m < 4; ++m) rs4[m] = row_rstd(ssp, u.pm * 256 + ai * 128 + wr * 64 + m * 16 + fr);
            CFENCE();
#pragma unroll
            for (int m = 0; m < 4; ++m) {
                const unsigned row = (unsigned)(u.pm * 256 + ai * 128 + wr * 64 + m * 16 + fr);
                const float rs = rs4[m];
                const unsigned ro = isu ? ((row >> 12) * 2097152u + (row & 4095u) * 16u) : row * stride;
#pragma unroll
                for (int bj = 0; bj < 2; ++bj) {
                    const unsigned cl = (unsigned)(bj * 128 + wc * 32 + 8 * fq);
                    f32x4 v0 = acc[ai][bj][m][0] * rs, v1 = acc[ai][bj][m][1] * rs;
                    const unsigned co = isu ? ((pn * 256u + cl) >> 4) * 65536u + ((cl >> 3) & 1u) * 8u : cb + cl;
                    u32x4 w; w.x = cvt_pk_bf16(v0[0], v0[1]); w.y = cvt_pk_bf16(v0[2], v0[3]); w.z = cvt_pk_bf16(v1[0], v1[1]); w.w = cvt_pk_bf16(v1[2], v1[3]);
                    *(u32x4*)(base + (size_t)(ro + co)) = w;
                }
            }
            CFENCE();
        }
    }
};
struct EpiGlu {
    static constexpr bool HAS_TAB = false;
    const bf16* ys5; bf16* yglu; const float* bglu;
    __device__ __forceinline__ void operator()(const f32x4 (&acc)[2][2][4][2], const Unit& u, int wr, int wc, int fr, int fq) const {
        const int colb = u.pn * 256 + wc * 32 + 8 * fq;
        const bf16* src = ys5 + (size_t)(u.pm * 256 + wr * 64 + fr) * 512 + colb;
        u32x4 nx[4][2];
#pragma unroll
        for (int g = 0; g < 4; ++g) { const bf16* s1 = src + (size_t)((g >> 2) * 128 + (g & 3) * 16) * 512; nx[g][0] = *(const u32x4*)s1; nx[g][1] = *(const u32x4*)(s1 + 128); }
#pragma unroll
        for (int g = 0; g < 8; ++g) {
            const int ai = g >> 2, m = g & 3;
            const u32x4 a2[2] = {nx[g & 3][0], nx[g & 3][1]};
            if (g < 4) { const int g1 = g + 4; const bf16* s1 = src + (size_t)((g1 >> 2) * 128 + (g1 & 3) * 16) * 512; nx[g & 3][0] = *(const u32x4*)s1; nx[g & 3][1] = *(const u32x4*)(s1 + 128); }
            CFENCE();
            const int row = u.pm * 256 + ai * 128 + wr * 64 + m * 16 + fr;
#pragma unroll
            for (int bj = 0; bj < 2; ++bj) {
                const int col = colb + bj * 128;
                const u32x4 a = a2[bj];
                const f32x4 b0 = *(const f32x4*)(bglu + col), b1 = *(const f32x4*)(bglu + col + 4);
                const f32x4 v0 = acc[ai][bj][m][0] + b0, v1 = acc[ai][bj][m][1] + b1;
                u32x4 w;
                w.x = cvt_pk_bf16(bflo(a.x) * sigmoidf_(v0[0]), bfhi(a.x) * sigmoidf_(v0[1]));
                w.y = cvt_pk_bf16(bflo(a.y) * sigmoidf_(v0[2]), bfhi(a.y) * sigmoidf_(v0[3]));
                w.z = cvt_pk_bf16(bflo(a.z) * sigmoidf_(v1[0]), bfhi(a.z) * sigmoidf_(v1[1]));
                w.w = cvt_pk_bf16(bflo(a.w) * sigmoidf_(v1[2]), bfhi(a.w) * sigmoidf_(v1[3]));
                *(u32x4*)(yglu + (size_t)row * 512 + col) = w;
            }
        }
        CFENCE();
    }
};
struct EpiResid {
    static constexpr bool HAS_TAB = false;
    bf16* xb; float* ssp; bf16* dst; bool wr_ssp;
    unsigned char* x8;
    float ascale;
    __device__ __forceinline__ void operator()(const f32x4 (&acc)[2][2][4][2], const Unit& u, int wr, int wc, int fr, int fq) const {
        const int colb = u.pn * 256 + wc * 32 + 8 * fq;
        const bf16* src = xb + (size_t)(u.pm * 256 + wr * 64 + fr) * D + colb;
        constexpr int PF = USE_F8_FFN_DOWN ? 2 : 4;
        u32x4 nx[PF][2];
#pragma unroll
        for (int g = 0; g < PF; ++g) { const bf16* s1 = src + (size_t)((g >> 2) * 128 + (g & 3) * 16) * D; nx[g][0] = *(const u32x4*)s1; nx[g][1] = *(const u32x4*)(s1 + 128); }
#pragma unroll
        for (int g = 0; g < 8; ++g) {
            const int ai = g >> 2, m = g & 3;
            const u32x4 a2[2] = {nx[g % PF][0], nx[g % PF][1]};
            if (g + PF < 8) { const int g1 = g + PF; const bf16* s1 = src + (size_t)((g1 >> 2) * 128 + (g1 & 3) * 16) * D; nx[g % PF][0] = *(const u32x4*)s1; nx[g % PF][1] = *(const u32x4*)(s1 + 128); }
            CFENCE();
            const int row = u.pm * 256 + ai * 128 + wr * 64 + m * 16 + fr;
            float ss = 0.f;
#pragma unroll
            for (int bj = 0; bj < 2; ++bj) {
                const int col = colb + bj * 128;
                const u32x4 a = a2[bj];
                const f32x4 v0 = acc[ai][bj][m][0] * ascale + (f32x4){bflo(a.x), bfhi(a.x), bflo(a.y), bfhi(a.y)};
                const f32x4 v1 = acc[ai][bj][m][1] * ascale + (f32x4){bflo(a.z), bfhi(a.z), bflo(a.w), bfhi(a.w)};
                ss += (v0[0] * v0[0] + v0[1] * v0[1]) + (v0[2] * v0[2] + v0[3] * v0[3]) + (v1[0] * v1[0] + v1[1] * v1[1]) + (v1[2] * v1[2] + v1[3] * v1[3]);
                u32x4 w; w.x = cvt_pk_bf16(v0[0], v0[1]); w.y = cvt_pk_bf16(v0[2], v0[3]); w.z = cvt_pk_bf16(v1[0], v1[1]); w.w = cvt_pk_bf16(v1[2], v1[3]);
                *(u32x4*)(dst + (size_t)row * D + col) = w;
                if (x8) { u32x2 q; q.x = pk4_fp8(v0[0], v0[1], v0[2], v0[3]); q.y = pk4_fp8(v1[0], v1[1], v1[2], v1[3]); *(u32x2*)(x8 + (size_t)row * D + col) = q; }
            }
            ss += __shfl_xor(ss, 16); ss += __shfl_xor(ss, 32);
            if (fq == 0 && wr_ssp) ssp[(size_t)row * 16 + u.pn * 4 + wc] = ss;
        }
        CFENCE();
    }
};
template <bool F8, bool F8OUT = F8> struct EpiSwigluT {
    static constexpr bool HAS_TAB = false;
    const float* ssp; bf16* h; int ldh;
    __device__ __forceinline__ void operator()(const f32x4 (&acc)[2][2][4][2], const Unit& u, int wr, int wc, int fr, int fq) const {
#pragma unroll
        for (int ai = 0; ai < 2; ++ai) {
            float rs4[4];
#pragma unroll
            for (int m = 0; m < 4; ++m) rs4[m] = row_rstd(ssp, u.pm * 256 + ai * 128 + wr * 64 + m * 16 + fr);
            CFENCE();
#pragma unroll
            for (int m = 0; m < 4; ++m) {
                const int row = u.pm * 256 + ai * 128 + wr * 64 + m * 16 + fr;
                const float rs = rs4[m] * (F8 ? 1.0f / F8_SW_UP : 1.0f);
                const float hs = F8OUT ? F8_SH : 1.0f, nrs = rs * -1.4426950408889634f, cc = rs * rs * hs;
                const f32x4 ga = acc[ai][0][m][0], gb = acc[ai][0][m][1], ua = acc[ai][1][m][0], ub = acc[ai][1][m][1];
                const f32x2 p0 = swiglu2((f32x2){ga[0], ga[1]}, (f32x2){ua[0], ua[1]}, nrs, cc), p1 = swiglu2((f32x2){ga[2], ga[3]}, (f32x2){ua[2], ua[3]}, nrs, cc);
                const f32x2 p2 = swiglu2((f32x2){gb[0], gb[1]}, (f32x2){ub[0], ub[1]}, nrs, cc), p3 = swiglu2((f32x2){gb[2], gb[3]}, (f32x2){ub[2], ub[3]}, nrs, cc);
                const f32x4 h0 = {p0[0], p0[1], p1[0], p1[1]}, h1 = {p2[0], p2[1], p3[0], p3[1]};
                const int col = u.pn * 128 + wc * 32 + 8 * fq;
                static_assert(!F8, "the dense up GEMM stays bf16 in this build");
                const size_t to = ((size_t)u.pm * (2 * ldh / 128) + 2 * u.pn + (wc >> 1)) * 32768 + (size_t)(((((wr * 2 + (wc & 1)) * 2 + ai) * 4 + m) * 1024) + fr * 64 + 16 * fq);
                if constexpr (F8OUT) { u32x2 q; q.x = pk4_fp8(h0[0], h0[1], h0[2], h0[3]); q.y = pk4_fp8(h1[0], h1[1], h1[2], h1[3]);
                    *(u32x2*)((unsigned char*)h + ((size_t)u.pm * (ldh / 128) + u.pn) * 32768 + (size_t)((((wr * 4 + wc) * 2 + ai) * 4 + m) * 512 + fr * 32 + 8 * fq)) = q; }
                else { u32x4 w; w.x = cvt_pk_bf16(h0[0], h0[1]); w.y = cvt_pk_bf16(h0[2], h0[3]); w.z = cvt_pk_bf16(h1[0], h1[1]); w.w = cvt_pk_bf16(h1[2], h1[3]); *(u32x4*)((unsigned char*)h + to) = w; }
            }
            CFENCE();
        }
    }
};

struct MoeTab { LAS int* cnt; LAS int* cb; LAS short* tl_list; LAS short* tl_sub; };
__device__ __forceinline__ MoeTab moe_tab(const Frame& F) {
    MoeTab T; T.cnt = (LAS int*)(F.lds + MOE_TAB_OFF); T.cb = T.cnt + 16; T.tl_list = (LAS short*)(T.cb + 8); T.tl_sub = T.tl_list + 288; return T;
}
__device__ __forceinline__ void moe_build_tables(const Frame& F) {
    MoeTab T = moe_tab(F);
    if (F.tid < 16) { const unsigned* gc = wsp<unsigned>(F, WS_CTL) + CW_CNT; int c = (int)__hip_atomic_load(gc + F.tid, __ATOMIC_RELAXED, __HIP_MEMORY_SCOPE_AGENT); if (c > 32768) c = 32768; T.cnt[F.tid] = c; }
    __syncthreads();
    if (F.tid < 16) {
        int tot = 0;
#pragma unroll 1
        for (int l = 0; l < F.tid; ++l) tot += (T.cnt[l] + 255) >> 8;
        const int nt_ = (T.cnt[F.tid] + 255) >> 8;
#pragma unroll 1
        for (int s = 0; s < nt_; ++s) { T.tl_list[tot + s] = (short)F.tid; T.tl_sub[tot + s] = (short)s; }
    }
    if (F.tid == 0) {
        int tr0 = 0, tr1 = 0;
#pragma unroll 1
        for (int l = 0; l < 16; ++l) { const int nt_ = (T.cnt[l] + 255) >> 8; if (l < 8) tr0 += nt_; else tr1 += nt_; }
        const int c0 = (tr0 > 64 + MOE_CAP_TILES) ? tr0 - MOE_CAP_TILES : (tr0 < 64 ? tr0 : 64);
        const int c3 = (tr1 > 64 + MOE_CAP_TILES) ? tr1 - MOE_CAP_TILES : (tr1 < 64 ? tr1 : 64);
        T.cb[0] = 0; T.cb[1] = c0; T.cb[2] = tr0; T.cb[3] = tr0 + tr1 - c3; T.cb[4] = tr0 + tr1;
    }
    __syncthreads();
}
struct MoeOrder {
    MoeTab T; int t0, ntile, nN, lo, nloc, j, nbx, nheavy, skip;
    __device__ __forceinline__ void init(const MoeTab& T_, int chunk, int nN_, int G, int bid, int nheavy_, int skip_) {
        T = T_; t0 = T.cb[chunk]; ntile = T.cb[chunk + 1] - t0; nN = nN_;
        const int total = ntile * nN, x = bid & 7, q = total >> 3, r = total & 7;
        lo = (x < r) ? x * (q + 1) : r * (q + 1) + (x - r) * q; nloc = q + (x < r ? 1 : 0);
        j = bid >> 3; nbx = (G - x + 7) >> 3; nheavy = nheavy_; skip = skip_;
    }
    __device__ __forceinline__ int nheavy_next() const { return nloc % nbx; }
    __device__ __forceinline__ bool next(int i, Unit& u) const {
        int k;
        if (j < nheavy) k = skip * (nbx - nheavy) + i * nbx + j;
        else k = (i < skip) ? i * (nbx - nheavy) + (j - nheavy) : skip * (nbx - nheavy) + (i - skip) * nbx + j;
        if (k >= nloc) return false;
        const int idx = lo + k, nig = 8 * nN, gid = idx / nig, fm = gid * 8, gsz = (ntile - fm) < 8 ? (ntile - fm) : 8, w = idx - gid * nig;
        const int tl = fm + w % gsz; u.pm = tl; u.pn = w / gsz; u.e = T.tl_list[t0 + tl]; u.sub = T.tl_sub[t0 + tl]; return true;
    }
};
constexpr int MOE_ESZ = USE_F8_MOE ? 1 : 2;
struct ProbMoeUp {
    static constexpr bool GATHER = true, F8 = USE_F8_MOE != 0;
    const void* xa; const void* wgu; const int* tok; MoeTab T; int lda, ldb, K;
    __device__ __forceinline__ const char* a_ptr(const Unit&) const { return (const char*)xa; }
    __device__ __forceinline__ size_t hstep_a() const { return 0; }
    __device__ __forceinline__ size_t kstep_a() const { return 128; }
    __device__ __forceinline__ const char* b_ptr(const Unit& u) const { return (const char*)wgu + ((size_t)(u.e & 7) * (2 * DFE) + (size_t)u.pn * 256) * D * MOE_ESZ; }
    __device__ __forceinline__ void a_off(const Unit& u, const int (&R)[2], const int (&C)[2], unsigned (&off)[2][2]) const {
        const int cnt = T.cnt[u.e];
#pragma unroll
        for (int h = 0; h < 2; ++h)
#pragma unroll
            for (int i = 0; i < 2; ++i) { int p = u.sub * 256 + h * 128 + R[i]; p = (p < cnt) ? p : 0; const int t = tok[u.e * 32768 + p]; off[h][i] = (unsigned)(t * lda + C[i]) * 2u; }
    }
    __device__ __forceinline__ void atab_issue(const Unit& u, LAS unsigned char* tab, int wid, int lane) const {
        if (wid < 4) { const int cnt = T.cnt[u.e]; int p = u.sub * 256 + wid * 64 + lane; p = (p < cnt) ? p : 0;
            __builtin_amdgcn_global_load_lds((const unsigned*)(tok + u.e * 32768 + p), (LAS unsigned*)(tab + wid * 256), 4, 0, 0); }
    }
    __device__ __forceinline__ void a_off_tab(const LAS unsigned char* tab, const int (&R)[2], const int (&C)[2], unsigned (&off)[2][2]) const {
#pragma unroll
        for (int h = 0; h < 2; ++h)
#pragma unroll
            for (int i = 0; i < 2; ++i) { const int t = *(const LAS int*)(tab + (h * 128 + R[i]) * 4); off[h][i] = (unsigned)(t * lda + C[i]) * 2u; }
    }
};
struct ProbMoeDown {
    static constexpr bool GATHER = false, F8 = USE_F8_MOE != 0;
    const void* h; const void* wd; int lda, ldb, K;
    static constexpr bool TILED = USE_F8_MOE != 0;
    __device__ __forceinline__ const char* a_ptr(const Unit& u) const { return TILED ? (const char*)h + (size_t)u.pm * (DFE / 128) * 32768 : (const char*)h + (size_t)u.pm * 256 * DFE * MOE_ESZ; }
    __device__ __forceinline__ const char* b_ptr(const Unit& u) const { return (const char*)wd + ((size_t)(u.e & 7) * D + (size_t)u.pn * 256) * DFE * MOE_ESZ; }
    __device__ __forceinline__ size_t hstep_a() const { return TILED ? (size_t)2048 : (size_t)128 * lda * 2; }
    __device__ __forceinline__ size_t kstep_a() const { return TILED ? (size_t)32768 : (size_t)128; }
    __device__ __forceinline__ void a_off(const Unit&, const int (&R)[2], const int (&C)[2], unsigned (&off)[1][2]) const {
#pragma unroll
        for (int i = 0; i < 2; ++i) {
            if (TILED) { const int wr = R[i] >> 6, m = (R[i] >> 4) & 3, fr = R[i] & 15, cb = 2 * C[i]; off[0][i] = (unsigned)((((wr * 4 + (cb >> 5)) * 2) * 4 + m) * 512 + fr * 32 + (cb & 31)); }
            else off[0][i] = (unsigned)(R[i] * lda + C[i]) * 2u;
        }
    }
};
struct EpiSwigluMoe {
    static constexpr bool HAS_TAB = true;
    const float* rl; void* h; MoeTab T;
    __device__ __forceinline__ void tab_issue(const Unit& u, LAS unsigned char* tab, int wid, int lane) const {
        if (wid < 4) { const int cnt = T.cnt[u.e]; int p = u.sub * 256 + wid * 64 + lane; p = (p < cnt) ? p : 0;
            __builtin_amdgcn_global_load_lds((const unsigned*)(rl + u.e * 32768 + p), (LAS unsigned*)(tab + wid * 256), 4, 0, 0); }
    }
    __device__ __forceinline__ void operator()(const f32x4 (&acc)[2][2][4][2], const Unit& u, int wr, int wc, int fr, int fq, const LAS unsigned char* tab) const {
        constexpr bool F8 = USE_F8_MOE != 0;
        const int cnt = T.cnt[u.e];
        float rs8[8];
#pragma unroll
        for (int g = 0; g < 8; ++g) { const int rl_ = (g >> 2) * 128 + wr * 64 + (g & 3) * 16 + fr, p = u.sub * 256 + rl_; const float v = *(const LAS float*)(tab + rl_ * 4); rs8[g] = (p < cnt) ? v * (F8 ? 1.0f / F8_SW_UP : 1.0f) : 0.f; }
        CFENCE();
#pragma unroll
        for (int ai = 0; ai < 2; ++ai)
#pragma unroll
            for (int m = 0; m < 4; ++m) {
                const int rl_ = ai * 128 + wr * 64 + m * 16 + fr;
                const float rs = rs8[ai * 4 + m];
                const float hs = F8 ? F8_SH : 1.0f, nrs = rs * -1.4426950408889634f, cc = rs * rs * hs;
                const f32x4 ga = acc[ai][0][m][0], gb = acc[ai][0][m][1], ua = acc[ai][1][m][0], ub = acc[ai][1][m][1];
                const f32x2 p0 = swiglu2((f32x2){ga[0], ga[1]}, (f32x2){ua[0], ua[1]}, nrs, cc), p1 = swiglu2((f32x2){ga[2], ga[3]}, (f32x2){ua[2], ua[3]}, nrs, cc);
                const f32x2 p2 = swiglu2((f32x2){gb[0], gb[1]}, (f32x2){ub[0], ub[1]}, nrs, cc), p3 = swiglu2((f32x2){gb[2], gb[3]}, (f32x2){ub[2], ub[3]}, nrs, cc);
                const f32x4 h0 = {p0[0], p0[1], p1[0], p1[1]}, h1 = {p2[0], p2[1], p3[0], p3[1]};
                const size_t eo = F8 ? ((size_t)(u.pm * (DFE / 128) + u.pn) * 32768 + (size_t)((((wr * 4 + wc) * 2 + ai) * 4 + m) * 512 + fr * 32 + 8 * fq))
                                     : ((size_t)(u.pm * 256 + rl_) * DFE + u.pn * 128 + wc * 32 + 8 * fq);
                if constexpr (F8) { u32x2 q; q.x = pk4_fp8(h0[0], h0[1], h0[2], h0[3]); q.y = pk4_fp8(h1[0], h1[1], h1[2], h1[3]); *(u32x2*)((unsigned char*)h + eo) = q; }
                else { u32x4 w; w.x = cvt_pk_bf16(h0[0], h0[1]); w.y = cvt_pk_bf16(h0[2], h0[3]); w.z = cvt_pk_bf16(h1[0], h1[1]); w.w = cvt_pk_bf16(h1[2], h1[3]); *(u32x4*)((bf16*)h + eo) = w; }
            }
        CFENCE();
    }
};
struct EpiMoeDown {
    static constexpr bool HAS_TAB = false;
    const int* tok; const float* wl; const bf16* xb; bf16* xo; MoeTab T; bool dry;
    __device__ __forceinline__ void operator()(const f32x4 (&acc)[2][2][4][2], const Unit& u, int wr, int wc, int fr, int fq) const {
        const int cnt = T.cnt[u.e]; const bf16* src = (u.e < 8) ? xb : (const bf16*)xo;
        const int colb = u.pn * 256 + wc * 32 + 8 * fq;
        int t8[8]; float w8[8];
#pragma unroll
        for (int g = 0; g < 8; ++g) { const int p = u.sub * 256 + (g >> 2) * 128 + wr * 64 + (g & 3) * 16 + fr; const bool ok = p < cnt; const int pc = ok ? p : 0;
            const int t_ = tok[u.e * 32768 + pc]; const float w_ = wl[u.e * 32768 + pc];
            t8[g] = ok ? t_ : -1; w8[g] = ok ? w_ * (USE_F8_MOE ? 1.0f / (F8_SH * F8_SW_DN) : 1.0f) : 0.f; }
        CFENCE();
        u32x4 nx[4][2];
#pragma unroll
        for (int g = 0; g < 4; ++g) { const bf16* s0 = src + (size_t)(t8[g] < 0 ? 0 : t8[g]) * D + colb; nx[g][0] = *(const u32x4*)s0; nx[g][1] = *(const u32x4*)(s0 + 128); }
#pragma unroll
        for (int g = 0; g < 8; ++g) {
            const int ai = g >> 2, m = g & 3;
            const u32x4 a2[2] = {nx[g & 3][0], nx[g & 3][1]};
            if (g < 4) { const bf16* s1 = src + (size_t)(t8[g + 4] < 0 ? 0 : t8[g + 4]) * D + colb; nx[g & 3][0] = *(const u32x4*)s1; nx[g & 3][1] = *(const u32x4*)(s1 + 128); }
            CFENCE();
            if (t8[g] >= 0) {
#pragma unroll
                for (int bj = 0; bj < 2; ++bj) {
                    const u32x4 a = a2[bj];
                    const f32x4 v0 = acc[ai][bj][m][0] * w8[g] + (f32x4){bflo(a.x), bfhi(a.x), bflo(a.y), bfhi(a.y)};
                    const f32x4 v1 = acc[ai][bj][m][1] * w8[g] + (f32x4){bflo(a.z), bfhi(a.z), bflo(a.w), bfhi(a.w)};
                    u32x4 w; w.x = cvt_pk_bf16(v0[0], v0[1]); w.y = cvt_pk_bf16(v0[2], v0[3]); w.z = cvt_pk_bf16(v1[0], v1[1]); w.w = cvt_pk_bf16(v1[2], v1[3]);
                    if (!dry) *(u32x4*)(xo + (size_t)t8[g] * D + colb + bj * 128) = w;
                }
            }
        }
        CFENCE();
    }
};

__device__ __forceinline__ void p0_tr_item(const float* src, int ldsrc, int ncol0, int k0, const float* gain, bf16* dst, int K, int drow0, LAS float* scr, int lane) {
    float gv[8]; f32x4 v8[8];
#pragma unroll
    for (int i = 0; i < 8; ++i) gv[i] = 1.0f;
    if (gain) {
#pragma unroll
        for (int i = 0; i < 8; ++i) gv[i] = gain[k0 + 8 * i + (lane >> 3)];
    }
#pragma unroll
    for (int i = 0; i < 8; ++i) v8[i] = *(const f32x4*)(src + (size_t)(k0 + 8 * i + (lane >> 3)) * ldsrc + ncol0 + 4 * (lane & 7));
    CFENCE();
#pragma unroll
    for (int i = 0; i < 8; ++i) { const int kk = 8 * i + (lane >> 3), c4 = lane & 7; *(LAS f32x4*)(scr + kk * 36 + 4 * c4) = v8[i] * gv[i]; }
    LDS_WAIT(); CFENCE();
    const int c = lane & 7;
#pragma unroll
    for (int j = 0; j < 4; ++j) { const int n = (lane >> 3) + 8 * j; const LAS float* s = scr + (8 * c) * 36 + n;
        u32x4 o; o.x = pk2(s[0 * 36], s[1 * 36]); o.y = pk2(s[2 * 36], s[3 * 36]); o.z = pk2(s[4 * 36], s[5 * 36]); o.w = pk2(s[6 * 36], s[7 * 36]);
        *(u32x4*)(dst + (size_t)(drow0 + n) * K + k0 + 8 * c) = o; }
    LDS_WAIT(); CFENCE();
}
__device__ __forceinline__ void p0_tr_item_f8(const float* src, int ldsrc, int ncol0, int k0, const float* gain, float scale, unsigned char* dst, int K, int drow0, LAS float* scr, int lane) {
    float gv[8]; f32x4 v8[8];
#pragma unroll
    for (int i = 0; i < 8; ++i) gv[i] = 1.0f;
    if (gain) {
#pragma unroll
        for (int i = 0; i < 8; ++i) gv[i] = gain[k0 + 8 * i + (lane >> 3)];
    }
#pragma unroll
    for (int i = 0; i < 8; ++i) v8[i] = *(const f32x4*)(src + (size_t)(k0 + 8 * i + (lane >> 3)) * ldsrc + ncol0 + 4 * (lane & 7));
    CFENCE();
#pragma unroll
    for (int i = 0; i < 8; ++i) { const int kk = 8 * i + (lane >> 3), c4 = lane & 7; *(LAS f32x4*)(scr + kk * 36 + 4 * c4) = v8[i] * (gv[i] * scale); }
    LDS_WAIT(); CFENCE();
    const int c = lane & 7;
#pragma unroll
    for (int j = 0; j < 4; ++j) { const int n = (lane >> 3) + 8 * j; const LAS float* s = scr + (8 * c) * 36 + n;
        u32x2 o; o.x = pk4_fp8(s[0 * 36], s[1 * 36], s[2 * 36], s[3 * 36]); o.y = pk4_fp8(s[4 * 36], s[5 * 36], s[6 * 36], s[7 * 36]);
        *(u32x2*)(dst + (size_t)(drow0 + n) * K + k0 + 8 * c) = o; }
    LDS_WAIT(); CFENCE();
}
__device__ __forceinline__ void p0_s5_unit(const Frame& F, int l, int g) {
    LAS float* AP = (LAS float*)F.lds;
    LAS float* BB = AP + 64 * 17 * 2;
    LAS float* CC = BB + 64 * 16 * 2;
    LAS float* KT = CC + 16 * 64 * 2;
    const float* lre = F.in[3] + (l * 32 + g) * 64; const float* lim = F.in[4] + (l * 32 + g) * 64; const float ldt = F.in[5][l * 32 + g];
    const float* bre = F.in[6] + (size_t)(l * 32 + g) * 1024; const float* bim = F.in[7] + (size_t)(l * 32 + g) * 1024;
    const float* cre = F.in[8] + (size_t)(l * 32 + g) * 1024; const float* cim = F.in[9] + (size_t)(l * 32 + g) * 1024;
    const int tid = F.tid;
    for (int i = tid; i < 64 * 17; i += 512) {
        const int p = i / 17, tau = i % 17;
        const double lr = fmin((double)lre[p], -1e-4), li = (double)lim[p], dt = exp((double)ldt);
        const double mg = exp(lr * dt * tau), ph = li * dt * tau;
        AP[i * 2] = (float)(mg * cos(ph)); AP[i * 2 + 1] = (float)(mg * sin(ph));
    }
    for (int i = tid; i < 1024; i += 512) {
        const int p = i >> 4;
        const double lr = fmin((double)lre[p], -1e-4), li = (double)lim[p], dt = exp((double)ldt);
        const double mg = exp(lr * dt), ar = mg * cos(li * dt), ai = mg * sin(li * dt), nr = ar - 1.0, ni = ai, den = lr * lr + li * li;
        const double fr = (nr * lr + ni * li) / den, fi = (ni * lr - nr * li) / den;
        const double br = bre[i], bi = bim[i];
        BB[i * 2] = (float)(fr * br - fi * bi); BB[i * 2 + 1] = (float)(fr * bi + fi * br);
        CC[i * 2] = cre[i]; CC[i * 2 + 1] = cim[i];
    }
    __syncthreads();
    for (int i = tid; i < 4096; i += 512) {
        const int tau = i >> 8, c = (i >> 4) & 15, c2 = i & 15; float s = 0.f;
        for (int p = 0; p < 64; ++p) {
            const float xr = CC[(c * 64 + p) * 2], xi = CC[(c * 64 + p) * 2 + 1], ar = AP[(p * 17 + tau) * 2], ai = AP[(p * 17 + tau) * 2 + 1];
            const float zr = xr * ar - xi * ai, zi = xr * ai + xi * ar;
            s += zr * BB[(p * 16 + c2) * 2] - zi * BB[(p * 16 + c2) * 2 + 1];
        }
        KT[i] = s;
    }
    __syncthreads();
    bf16* MQ = wsp<bf16>(F, WS_S5MQ) + (size_t)(l * 32 + g) * 256 * 384;
    for (int i = tid; i < 256 * 48; i += 512) {
        const int m = i / 48, k8 = (i % 48) * 8, t = m >> 4, c = m & 15; float v[8];
#pragma unroll
        for (int j = 0; j < 8; ++j) {
            const int kc = k8 + j;
            if (kc < 256) { const int s = kc >> 4, c2 = kc & 15; v[j] = (s <= t) ? KT[((t - s) * 16 + c) * 16 + c2] : 0.f; }
            else { const int pp = kc - 256, p = pp & 63; const float xr = CC[(c * 64 + p) * 2], xi = CC[(c * 64 + p) * 2 + 1], ar = AP[(p * 17 + t + 1) * 2], ai = AP[(p * 17 + t + 1) * 2 + 1];
                   v[j] = (pp < 64) ? (xr * ar - xi * ai) : -(xr * ai + xi * ar); }
        }
        u32x4 o; o.x = pk2(v[0], v[1]); o.y = pk2(v[2], v[3]); o.z = pk2(v[4], v[5]); o.w = pk2(v[6], v[7]);
        *(u32x4*)(MQ + (size_t)m * 384 + k8) = o;
    }
    bf16* PM = wsp<bf16>(F, WS_S5P) + (size_t)(l * 32 + g) * 128 * 256;
    for (int i = tid; i < 128 * 32; i += 512) {
        const int pp = i >> 5, k8 = (i & 31) * 8, p = pp & 63; float v[8];
#pragma unroll
        for (int j = 0; j < 8; ++j) {
            const int kc = k8 + j, s = kc >> 4, c2 = kc & 15;
            const float ar = AP[(p * 17 + 15 - s) * 2], ai = AP[(p * 17 + 15 - s) * 2 + 1], br = BB[(p * 16 + c2) * 2], bi = BB[(p * 16 + c2) * 2 + 1];
            v[j] = (pp < 64) ? (ar * br - ai * bi) : (ar * bi + ai * br);
        }
        u32x4 o; o.x = pk2(v[0], v[1]); o.y = pk2(v[2], v[3]); o.z = pk2(v[4], v[5]); o.w = pk2(v[6], v[7]);
        *(u32x4*)(PM + (size_t)pp * 256 + k8) = o;
    }
    float* A16 = wsp<float>(F, WS_S5A16) + (size_t)(l * 32 + g) * 128;
    if (tid < 64) { A16[tid * 2] = AP[(tid * 17 + 16) * 2]; A16[tid * 2 + 1] = AP[(tid * 17 + 16) * 2 + 1]; }
    __syncthreads();
}
__device__ __forceinline__ void p0_prologue(const Frame& F) {
    if (F.bid == 0 && F.tid < 16) __hip_atomic_store(wsp<unsigned>(F, WS_CTL) + CW_CNT + F.tid, 0u, __ATOMIC_RELAXED, __HIP_MEMORY_SCOPE_AGENT);
#ifndef PROBE_S5U
#define PROBE_S5U 1
#endif
#pragma unroll 1
    for (int pr = 0; pr < PROBE_S5U; ++pr) for (int un = F.bid; un < 64; un += F.G) p0_s5_unit(F, un >> 5, un & 31);
    LAS float* scr = (LAS float*)(F.lds + F.wave * 16384);
    const int gw = F.bid * 8 + F.wave, NGW = F.G * 8, lane = F.lane;
    constexpr int I_IN = 16 * 64, I_GLU = 8 * 16, I_OUT = 16 * 32, I_FGU = 16 * 176, I_FD = 44 * 32, I_MGU = 16 * 224, I_MD = 56 * 32;
    constexpr int NITEMS = 2 * (I_IN + I_GLU + I_OUT) + I_FGU + I_FD + 8 * (I_MGU + I_MD);
    const bool split = F.G > 64;
    const int N1 = split ? ((NITEMS / NGW > 4) ? (NITEMS / NGW - 4) * NGW : 0) : NITEMS;
    int step = NGW;
    for (int it = gw; ; it += step) {
        if (step == NGW && it >= N1) { if (!split || F.bid < 64) break; it = N1 + (F.bid - 64) * 8 + F.wave; step = (F.G - 64) * 8; }
        if (it >= NITEMS) break;
        int r = it; bool done = false;
#pragma unroll
        for (int l = 0; l < 2; ++l) {
            if (done) break;
            if (r < I_IN) { p0_tr_item(F.in[2] + (size_t)l * D * DIN, DIN, 32 * (r % 64), 64 * (r / 64), F.in[1] + l * D, wsp<bf16>(F, WS_WIN) + (size_t)l * NPROJ * D, D, 32 * (r % 64), scr, lane); done = true; break; } r -= I_IN;
            if (r < I_GLU) { p0_tr_item(F.in[11] + (size_t)l * 512 * 512, 512, 32 * (r % 16), 64 * (r / 16), nullptr, wsp<bf16>(F, WS_WGLU) + (size_t)l * 512 * 512, 512, 32 * (r % 16), scr, lane); done = true; break; } r -= I_GLU;
            if (r < I_OUT) { p0_tr_item(F.in[17] + (size_t)l * D * D, D, 32 * (r % 32), 64 * (r / 32), nullptr, wsp<bf16>(F, WS_WOUT) + (size_t)l * D * D, D, 32 * (r % 32), scr, lane); done = true; break; } r -= I_OUT;
        }
        if (done) continue;
        if (r < I_FGU) { const int nb = r % 176, kb = r / 176, n0 = 32 * nb, T = n0 >> 8, hf = (n0 >> 7) & 1, j0 = n0 & 127;
            if (USE_F8_FFN) p0_tr_item_f8(hf ? F.in[20] : F.in[19], DFF, 128 * T + j0, 64 * kb, F.in[18], F8_SW_UP, wsp<unsigned char>(F, WS_WFGU), D, n0, scr, lane);
            else p0_tr_item(hf ? F.in[20] : F.in[19], DFF, 128 * T + j0, 64 * kb, F.in[18], wsp<bf16>(F, WS_WFGU), D, n0, scr, lane);
            continue; } r -= I_FGU;
        if (r < I_FD) {
            if (USE_F8_FFN || USE_F8_FFN_DOWN) p0_tr_item_f8(F.in[21], D, 32 * (r % 32), 64 * (r / 32), nullptr, F8_SW_DN, wsp<unsigned char>(F, WS_WFD), DFF, 32 * (r % 32), scr, lane);
            else p0_tr_item(F.in[21], D, 32 * (r % 32), 64 * (r / 32), nullptr, wsp<bf16>(F, WS_WFD), DFF, 32 * (r % 32), scr, lane);
            continue; } r -= I_FD;
        const int e = r / (I_MGU + I_MD); r -= e * (I_MGU + I_MD);
        if (r < I_MGU) { const int nb = r % 224, kb = r / 224, n0 = 32 * nb, T = n0 >> 8, hf = (n0 >> 7) & 1, j0 = n0 & 127;
            if (USE_F8_MOE) p0_tr_item_f8((hf ? F.in[24] : F.in[23]) + (size_t)e * D * DFE, DFE, 128 * T + j0, 64 * kb, F.in[18] + D, F8_SW_UP, wsp<unsigned char>(F, WS_MGU) + (size_t)e * 2 * DFE * D, D, n0, scr, lane);
            else p0_tr_item((hf ? F.in[24] : F.in[23]) + (size_t)e * D * DFE, DFE, 128 * T + j0, 64 * kb, F.in[18] + D, wsp<bf16>(F, WS_MGU) + (size_t)e * 2 * DFE * D, D, n0, scr, lane);
            continue; } r -= I_MGU;
        if (USE_F8_MOE) p0_tr_item_f8(F.in[25] + (size_t)e * DFE * D, D, 32 * (r % 32), 64 * (r / 32), nullptr, F8_SW_DN, wsp<unsigned char>(F, WS_MD) + (size_t)e * D * DFE, DFE, 32 * (r % 32), scr, lane);
        else p0_tr_item(F.in[25] + (size_t)e * DFE * D, D, 32 * (r % 32), 64 * (r / 32), nullptr, wsp<bf16>(F, WS_MD) + (size_t)e * D * DFE, DFE, 32 * (r % 32), scr, lane);
    }
    for (int it = F.bid * 512 + F.tid; it < 2 * 16 * 1024; it += F.G * 512) {
        const int l = it >> 14, r = (it >> 10) & 15, k = it & 1023;
        wsp<bf16>(F, WS_WGT)[it] = (bf16)f2bf(F.in[1][l * D + k] * F.in[2][(size_t)l * D * DIN + (size_t)k * DIN + 2048 + r]);
    }
    for (int it = F.bid * 512 + F.tid; it < 2 * 256 * 16; it += F.G * 512) {
        const int l = it >> 12, k = (it >> 4) & 255, r = it & 15;
        wsp<bf16>(F, WS_WA2T)[it] = (bf16)f2bf(F.in[14][(size_t)l * 16 * 256 + r * 256 + k]);
    }
    bf16* xb = wsp<bf16>(F, WS_XB); float* ssp = wsp<float>(F, WS_SSP);
    f32x4 xn[4];
    if (gw < M) {
#pragma unroll
        for (int j = 0; j < 4; ++j) xn[j] = ((const f32x4*)(F.in[0] + (size_t)gw * D) + lane)[64 * j];
    }
    for (int m = gw; m < M; m += NGW) {
        f32x4 xc[4]; float s = 0.f;
#pragma unroll
        for (int j = 0; j < 4; ++j) xc[j] = xn[j];
        if (m + NGW < M) {
#pragma unroll
            for (int j = 0; j < 4; ++j) xn[j] = ((const f32x4*)(F.in[0] + (size_t)(m + NGW) * D) + lane)[64 * j];
        }
        CFENCE();
        u32x2* o8 = (u32x2*)(xb + (size_t)m * D) + lane;
#pragma unroll
        for (int j = 0; j < 4; ++j) { const f32x4 v = xc[j]; s += (v[0] * v[0] + v[1] * v[1]) + (v[2] * v[2] + v[3] * v[3]); u32x2 w; w.x = pk2(v[0], v[1]); w.y = pk2(v[2], v[3]); o8[64 * j] = w; }
        s = wave_sum(s);
        if (lane < 16) ssp[(size_t)m * 16 + lane] = (lane == 0) ? s : 0.f;
    }
}

__device__ __forceinline__ bf16x8 frag_row(const LAS unsigned char* base, int stride, int row0, int k0, int lane) {
    return *(const LAS bf16x8*)(base + (row0 + (lane & 15)) * stride + (k0 + 8 * (lane >> 4)) * 2);
}
__device__ __forceinline__ s16x4 lds_tr(const LAS unsigned char* p) { return __builtin_bit_cast(s16x4, __builtin_amdgcn_ds_read_tr16_b64_v4i16((LAS v4i16_t*)p)); }
__device__ __forceinline__ bf16x8 frag_tr(const LAS unsigned char* base, int stride, int r0, int c0, int lane) {
    const int i = lane & 15, q = i >> 2, p = i & 3, g = lane >> 4;
    const LAS unsigned char* a = base + (r0 + 8 * g + q) * stride + (c0 + 4 * p) * 2;
    const s16x4 lo = lds_tr(a), hi = lds_tr(a + 4 * stride);
    return (bf16x8){lo[0], lo[1], lo[2], lo[3], hi[0], hi[1], hi[2], hi[3]};
}
__device__ __forceinline__ bf16x8 frag_tr_perm(const LAS unsigned char* base, int stride, int r0, int c0, int lane) {
    const int i = lane & 15, q = i >> 2, p = i & 3, g = lane >> 4;
    const LAS unsigned char* a = base + (r0 + 4 * g + q) * stride + (c0 + 4 * p) * 2;
    const s16x4 lo = lds_tr(a), hi = lds_tr(a + 16 * stride);
    return (bf16x8){lo[0], lo[1], lo[2], lo[3], hi[0], hi[1], hi[2], hi[3]};
}
#define MFMA16(a, b, c) __builtin_amdgcn_mfma_f32_16x16x32_bf16((a), (b), (c), 0, 0, 0)

__device__ __forceinline__ void glow_pass(const Frame& F, int l) {
    const int lane = F.lane, fr = lane & 15, fq = lane >> 4;
    const bf16* wg = wsp<bf16>(F, WS_WGT) + (size_t)l * 16 * 1024;
    bf16x8 wf[32];
#pragma unroll
    for (int ks = 0; ks < 32; ++ks) wf[ks] = *(const bf16x8*)(wg + fr * 1024 + 32 * ks + 8 * fq);
    const bf16* xb = wsp<bf16>(F, WS_XB); const float* ssp = wsp<float>(F, WS_SSP); bf16* gl = wsp<bf16>(F, WS_GL);
    for (int m0 = 16 * (F.bid * 8 + F.wave); m0 < M; m0 += 16 * F.G * 8) {
        f32x4 acc = {0.f, 0.f, 0.f, 0.f};
        const bf16* xr = xb + (size_t)(m0 + fr) * D + 8 * fq;
        const float rs = row_rstd(ssp, m0 + fr);
        u32x4 an[8];
#pragma unroll
        for (int kk = 0; kk < 8; ++kk) an[kk] = *(const u32x4*)(xr + 32 * kk);
#pragma unroll
        for (int kg = 0; kg < 4; ++kg) {
            u32x4 a8[8];
#pragma unroll
            for (int kk = 0; kk < 8; ++kk) a8[kk] = an[kk];
            if (kg < 3) {
#pragma unroll
                for (int kk = 0; kk < 8; ++kk) an[kk] = *(const u32x4*)(xr + 32 * (8 * (kg + 1) + kk));
            }
            CFENCE();
#pragma unroll
            for (int kk = 0; kk < 8; ++kk) acc = MFMA16(wf[8 * kg + kk], __builtin_bit_cast(bf16x8, a8[kk]), acc);
        }
        u32x2 o; o.x = cvt_pk_bf16(acc[0] * rs, acc[1] * rs); o.y = cvt_pk_bf16(acc[2] * rs, acc[3] * rs);
        *(u32x2*)(gl + (size_t)(m0 + fr) * 16 + 4 * fq) = o;
    }
}
constexpr int S5_USTR = 528, S5_SSTR = 272, S5_HSTR = 272;
__device__ __forceinline__ void s5_unit(const Frame& F, int l, int un) {
    const int b = un >> 5, g = un & 31, tid = F.tid, lane = F.lane, w = F.wave, fq = lane >> 4, fr = lane & 15;
    LAS unsigned char* hb = F.lds; LAS unsigned char* useg = F.lds + 64 * S5_HSTR; LAS unsigned char* slds = useg + 64 * S5_USTR;
    const bf16* PM = wsp<bf16>(F, WS_S5P) + (size_t)(l * 32 + g) * 128 * 256;
    const bf16* MQ = wsp<bf16>(F, WS_S5MQ) + (size_t)(l * 32 + g) * 256 * 384;
    bf16x8 pf[8], mq0[12], mq1[12];
#pragma unroll
    for (int ks = 0; ks < 8; ++ks) pf[ks] = *(const bf16x8*)(PM + (size_t)(16 * w + fr) * 256 + 32 * ks + 8 * fq);
#pragma unroll
    for (int ks = 0; ks < 12; ++ks) { mq0[ks] = *(const bf16x8*)(MQ + (size_t)(16 * w + fr) * 384 + 32 * ks + 8 * fq); mq1[ks] = *(const bf16x8*)(MQ + (size_t)(16 * (w + 8) + fr) * 384 + 32 * ks + 8 * fq); }
    const float* A16 = wsp<float>(F, WS_S5A16) + (size_t)(l * 32 + g) * 128;
    const float a_re = A16[(lane & 63) * 2], a_im = A16[(lane & 63) * 2 + 1];
    const f32x4 dsk = *(const f32x4*)(F.in[10] + l * 512 + g * 16 + 4 * fq);
    float hr = 0.f, hi = 0.f;
    const bf16* ug = wsp<bf16>(F, WS_UGM) + (size_t)((b * 32 + g) * 4096) * 16;
    bf16* ys5 = (bf16*)(F.dout + DO_YS5);
    u32x4 upre[4];
#pragma unroll
    for (int i = 0; i < 4; ++i) upre[i] = *(const u32x4*)(ug + (size_t)(tid + 512 * i) * 8);
    for (int seg = 0; seg < 4; ++seg) {
#pragma unroll
        for (int i = 0; i < 4; ++i) { const int idx = tid + 512 * i; *(LAS u32x4*)(useg + (idx >> 5) * S5_USTR + (idx & 31) * 16) = upre[i]; }
        if (seg < 3) {
#pragma unroll
            for (int i = 0; i < 4; ++i) upre[i] = *(const u32x4*)(ug + (size_t)(seg + 1) * 16384 + (size_t)(tid + 512 * i) * 8);
        }
        __syncthreads();
#ifndef PROBE_S5
#define PROBE_S5 0
#endif
#pragma unroll 1
        for (int pr1 = 0; pr1 < (PROBE_S5 == 1 ? 2 : 1); ++pr1)
        {
            f32x4 acc4[4];
#pragma unroll
            for (int nt = 0; nt < 4; ++nt) acc4[nt] = (f32x4){0.f, 0.f, 0.f, 0.f};
            constexpr int KSB = USE_F8_FFN_DOWN ? 1 : 2;
#pragma unroll
            for (int kb = 0; kb < 8; kb += KSB) {
                bf16x8 ub[KSB][4];
#pragma unroll
                for (int ks = 0; ks < KSB; ++ks)
#pragma unroll
                    for (int nt = 0; nt < 4; ++nt) ub[ks][nt] = frag_row(useg, S5_USTR, 16 * nt, 32 * (kb + ks), lane);
                __builtin_amdgcn_sched_barrier(0);
#pragma unroll
                for (int ks = 0; ks < KSB; ++ks)
#pragma unroll
                    for (int nt = 0; nt < 4; ++nt) acc4[nt] = MFMA16(ub[ks][nt], pf[kb + ks], acc4[nt]);
                __builtin_amdgcn_sched_barrier(0);
            }
#pragma unroll
            for (int nt = 0; nt < 4; ++nt) *(LAS f32x4*)(slds + (16 * w + fr) * S5_SSTR + (16 * nt + 4 * fq) * 4) = acc4[nt];
        }
        __syncthreads();
        if (w == 0) {
            const LAS unsigned char* sre = slds + lane * S5_SSTR; const LAS unsigned char* sim = slds + (64 + lane) * S5_SSTR;
            const float hr0 = hr, hi0 = hi;
            const f32x2 are2 = {a_re, a_re}, aim2 = {-a_im, a_im};
#pragma unroll 1
            for (int pr2 = 0; pr2 < (PROBE_S5 == 2 ? 2 : 1); ++pr2) { hr = hr0; hi = hi0;
#pragma unroll 1
            for (int n0 = 0; n0 < 64; n0 += 16) {
                LAS unsigned char* hw = hb + n0 * S5_HSTR + lane * 2;
                f32x4 cr4[4], ci4[4];
#pragma unroll
                for (int q = 0; q < 4; ++q) { cr4[q] = *(const LAS f32x4*)(sre + n0 * 4 + q * 16); ci4[q] = *(const LAS f32x4*)(sim + n0 * 4 + q * 16); }
                CFENCE();
#pragma unroll
                for (int j = 0; j < 16; ++j) {
                    const f32x2 s2 = {cr4[j >> 2][j & 3], ci4[j >> 2][j & 3]};
                    const unsigned hp = cvt_pk_bf16(hr, hi);
                    *(LAS unsigned short*)(hw + j * S5_HSTR) = (unsigned short)hp; *(LAS unsigned short*)(hw + j * S5_HSTR + 128) = (unsigned short)(hp >> 16);
                    const f32x2 hv = {hr, hi}, hx = {hi, hr};
                    const f32x2 nh = hv * are2 + (hx * aim2 + s2);
                    hr = nh[0]; hi = nh[1];
                }
            }
            }
        }
        __syncthreads();
#pragma unroll 1
        for (int pr3 = 0; pr3 < (PROBE_S5 == 3 ? 2 : 1); ++pr3)
#pragma unroll
        for (int nt = 0; nt < 4; ++nt) {
            f32x4 a0 = {0.f, 0.f, 0.f, 0.f}, a1 = {0.f, 0.f, 0.f, 0.f};
#pragma unroll
            for (int kb = 0; kb < 12; kb += 4) {
                bf16x8 bb[4];
#pragma unroll
                for (int ks = 0; ks < 4; ++ks) bb[ks] = (kb < 8) ? frag_row(useg, S5_USTR, 16 * nt, 32 * (kb + ks), lane) : frag_row(hb, S5_HSTR, 16 * nt, 32 * ks, lane);
                __builtin_amdgcn_sched_barrier(0);
#pragma unroll
                for (int ks = 0; ks < 4; ++ks) { a0 = MFMA16(mq0[kb + ks], bb[ks], a0); a1 = MFMA16(mq1[kb + ks], bb[ks], a1); }
                __builtin_amdgcn_sched_barrier(0);
            }
            const int chunk = 16 * nt + fr;
#pragma unroll
            for (int hh = 0; hh < 2; ++hh) {
                const int t = w + 8 * hh; const f32x4 a = hh ? a1 : a0;
                const u32x2 uu = *(const LAS u32x2*)(useg + chunk * S5_USTR + (t * 16 + 4 * fq) * 2);
                const float y0 = gelu_tanh(a[0] + dsk[0] * bflo(uu.x)), y1 = gelu_tanh(a[1] + dsk[1] * bfhi(uu.x)), y2 = gelu_tanh(a[2] + dsk[2] * bflo(uu.y)), y3 = gelu_tanh(a[3] + dsk[3] * bfhi(uu.y));
                u32x2 o; o.x = cvt_pk_bf16(y0, y1); o.y = cvt_pk_bf16(y2, y3);
                const int token = b * 4096 + seg * 1024 + chunk * 16 + t;
                *(u32x2*)(ys5 + (size_t)token * 512 + g * 16 + 4 * fq) = o;
            }
        }
        __syncthreads();
    }
}

constexpr int GL_TSTR = 144;
__device__ __forceinline__ void gla_ld_tile(const bf16* g, int pitch, u32x4 (&r)[8], int lane) {
#pragma unroll
    for (int i = 0; i < 8; ++i) { const int idx = lane + 64 * i; r[i] = *(const u32x4*)(g + (size_t)(idx >> 3) * pitch + (idx & 7) * 8); }
}
__device__ __forceinline__ void gla_st_tile(LAS unsigned char* img, const u32x4 (&r)[8], int lane) {
#pragma unroll
    for (int i = 0; i < 8; ++i) { const int idx = lane + 64 * i; *(LAS u32x4*)(img + (idx >> 3) * GL_TSTR + (idx & 7) * 16) = r[i]; }
}
__device__ __forceinline__ void gla_loga_tile(const Frame& F, int l, int row0, int h, LAS unsigned char* img, int lane_) {
    int lane = lane_; asm volatile("" : "+v"(lane));
    const int fr = lane & 15, fq = lane >> 4;
    const bf16* wa = wsp<bf16>(F, WS_WA2T) + (size_t)l * 256 * 16 + (size_t)(h * 64) * 16; const bf16* gl = wsp<bf16>(F, WS_GL) + (size_t)row0 * 16;
    const float* ba = F.in[15] + l * 256 + h * 64;
    bf16x8 af[4], bfr[4];
    const u32x4 zero4 = {0u, 0u, 0u, 0u};
#pragma unroll
    for (int i = 0; i < 4; ++i) {
        const u32x4 a = (fq < 2) ? *(const u32x4*)(wa + (size_t)(16 * i + fr) * 16 + 8 * fq) : zero4;
        const u32x4 b = (fq < 2) ? *(const u32x4*)(gl + (size_t)(16 * i + fr) * 16 + 8 * fq) : zero4;
        af[i] = __builtin_bit_cast(bf16x8, a); bfr[i] = __builtin_bit_cast(bf16x8, b);
    }
    float b44[4];
#pragma unroll
    for (int mt = 0; mt < 4; ++mt) b44[mt] = ba[16 * mt + fr];
    CFENCE();
#pragma unroll
    for (int mt = 0; mt < 4; ++mt) {
        const float b1 = b44[mt];
#pragma unroll
        for (int nt = 0; nt < 4; ++nt) {
            f32x4 z = {0.f, 0.f, 0.f, 0.f};
            z = MFMA16(bfr[nt], af[mt], z);
            float la[4];
#pragma unroll
            for (int j = 0; j < 4; ++j) { const float v = z[j] + b1; la[j] = (fminf(v, 0.f) - __logf(1.0f + __expf(-fabsf(v)))) * 0.0625f; }
            u32x2 o; o.x = cvt_pk_bf16(la[0], la[1]); o.y = cvt_pk_bf16(la[2], la[3]);
            *(LAS u32x2*)(img + (16 * mt + fr) * GL_TSTR + (16 * nt + 4 * fq) * 2) = o;
        }
    }
}
__device__ __forceinline__ void gla_row(const LAS unsigned char* img, int lane, u32x4 (&r)[8]) {
#pragma unroll
    for (int i = 0; i < 8; ++i) r[i] = *(const LAS u32x4*)(img + lane * GL_TSTR + i * 16);
}
#define GLA_ROWV(r, t) ((((t) & 1) ? bfhi((r)[(t) >> 3][((t) >> 1) & 3]) : bflo((r)[(t) >> 3][((t) >> 1) & 3])))
__device__ __forceinline__ float gla_col(const LAS unsigned char* img, int t, int lane) { return bf2f(*(const LAS bf16*)(img + t * GL_TSTR + lane * 2)); }
__device__ __forceinline__ void gla_a_unit(const Frame& F, int l, int wu) {
    const int lane = F.lane, fq = lane >> 4, fr = lane & 15;
    const int bh = wu >> 6, n = wu & 63, b = bh >> 2, h = bh & 3, row0 = b * 4096 + n * 64;
    LAS unsigned char* ra = F.lds + F.wave * WAVE_LDS; LAS unsigned char* rb = ra + 64 * GL_TSTR;
    const bf16* vp = wsp<bf16>(F, WS_V) + (size_t)row0 * 512 + h * 128;
    u32x4 t1[8], tv[8];
    gla_ld_tile(wsp<bf16>(F, WS_K) + (size_t)row0 * 256 + h * 64, 256, t1, lane);
    gla_ld_tile(vp, 512, tv, lane);
    gla_loga_tile(F, l, row0, h, ra, lane);
    gla_st_tile(rb, t1, lane);
    CFENCE();
    u32x4 lg[8]; gla_row(ra, lane, lg);
    float tot = 0.f;
#pragma unroll
    for (int t = 0; t < 64; ++t) tot += GLA_ROWV(lg, t);
    wsp<float>(F, WS_DEC)[(size_t)wu * 64 + lane] = __expf(tot);
    float cum = 0.f; u32x4 pk[8];
#pragma unroll
    for (int t8 = 0; t8 < 8; ++t8) {
        float ke[8], kc[8];
#pragma unroll
        for (int tt = 0; tt < 8; ++tt) kc[tt] = gla_col(rb, t8 * 8 + tt, lane);
        CFENCE();
#pragma unroll
        for (int tt = 0; tt < 8; ++tt) { const int t = t8 * 8 + tt; cum += GLA_ROWV(lg, t); ke[tt] = kc[tt] * __expf(tot - cum); }
        pk[t8].x = cvt_pk_bf16(ke[0], ke[1]); pk[t8].y = cvt_pk_bf16(ke[2], ke[3]); pk[t8].z = cvt_pk_bf16(ke[4], ke[5]); pk[t8].w = cvt_pk_bf16(ke[6], ke[7]);
    }
    CFENCE();
#pragma unroll
    for (int t8 = 0; t8 < 8; ++t8) *(LAS u32x4*)(ra + lane * GL_TSTR + t8 * 16) = pk[t8];
    bf16* ut = (bf16*)(F.dout + DO_UT) + (size_t)wu * 8192;
#pragma unroll
    for (int hv = 0; hv < 2; ++hv) {
        CFENCE();
        gla_st_tile(rb, tv, lane);
        if (hv == 0) gla_ld_tile(vp + 64, 512, tv, lane);
        CFENCE();
#pragma unroll
        for (int mt = 0; mt < 4; ++mt)
#pragma unroll
            for (int nt = 0; nt < 4; ++nt) {
                f32x4 acc = {0.f, 0.f, 0.f, 0.f};
#pragma unroll
                for (int ks = 0; ks < 2; ++ks) acc = MFMA16(frag_row(ra, GL_TSTR, 16 * mt, 32 * ks, lane), frag_tr(rb, GL_TSTR, 32 * ks, 16 * nt, lane), acc);
                { u32x2 o; o.x = cvt_pk_bf16(acc[0], acc[1]); o.y = cvt_pk_bf16(acc[2], acc[3]);
                  *(u32x2*)(ut + (size_t)(hv * 64 + nt * 16 + fr) * 64 + mt * 16 + 4 * fq) = o; }
            }
    }
}
__device__ __forceinline__ void gla_b_scan(const Frame& F) {
    const bf16* ut = (const bf16*)(F.dout + DO_UT); bf16* st = (bf16*)(F.dout + DO_ST); const float* dec = wsp<float>(F, WS_DEC);
    LAS float* dl = (LAS float*)F.lds;
    for (int blk = F.bid; blk < 256; blk += F.G) {
        const int bh = blk >> 3, e = (blk & 7) * 1024 + F.tid * 2, k = e & 63;
        __syncthreads();
#pragma unroll
        for (int i = 0; i < 2; ++i) *(LAS f32x4*)(dl + (F.tid + 512 * i) * 4) = *(const f32x4*)(dec + (size_t)bh * 4096 + (size_t)(F.tid + 512 * i) * 4);
        __syncthreads();
        f32x2 s2 = {0.f, 0.f};
        const bf16* up = ut + (size_t)bh * 64 * 8192 + e; bf16* sp = st + (size_t)bh * 64 * 8192 + e;
        unsigned un16[16];
#pragma unroll
        for (int j = 0; j < 16; ++j) un16[j] = *(const unsigned*)(up + (size_t)j * 8192);
#pragma unroll 1
        for (int n0 = 0; n0 < 64; n0 += 16) {
            unsigned u16[16];
#pragma unroll
            for (int j = 0; j < 16; ++j) u16[j] = un16[j];
            if (n0 < 48) {
#pragma unroll
                for (int j = 0; j < 16; ++j) un16[j] = *(const unsigned*)(up + (size_t)(n0 + 16 + j) * 8192);
            }
            CFENCE();
#pragma unroll
            for (int j = 0; j < 16; ++j) {
                const f32x2 d = *(const LAS f32x2*)(dl + (n0 + j) * 64 + k);
                *(unsigned*)(sp + (size_t)(n0 + j) * 8192) = cvt_pk_bf16(s2[0], s2[1]);
                s2 = d * s2 + (f32x2){bflo(u16[j]), bfhi(u16[j])};
            }
        }
    }
}
__device__ __forceinline__ void gla_c_unit(const Frame& F, int l, int wu) {
    const int lane = F.lane, fq = lane >> 4, fr = lane & 15;
    const int bh = wu >> 6, n = wu & 63, b = bh >> 2, h = bh & 3, row0 = b * 4096 + n * 64;
    LAS unsigned char* qtt = F.lds + F.wave * WAVE_LDS; LAS unsigned char* ktt = qtt + 64 * GL_TSTR;
    const bf16* vp = wsp<bf16>(F, WS_V) + (size_t)row0 * 512 + h * 128;
    u32x4 t1[8], t2[8], tv[8];
    gla_loga_tile(F, l, row0, h, qtt, lane);
    CFENCE();
    gla_ld_tile(wsp<bf16>(F, WS_K) + (size_t)row0 * 256 + h * 64, 256, t1, lane);
    gla_ld_tile(wsp<bf16>(F, WS_Q) + (size_t)row0 * 256 + h * 64, 256, t2, lane);
    gla_st_tile(ktt, t1, lane);
    CFENCE();
    unsigned e1p[32]; float cum = 0.f; u32x4 pkk[8], pkq[8];
    u32x4 lg[8]; gla_row(qtt, lane, lg);
#pragma unroll
    for (int t8 = 0; t8 < 8; ++t8) {
        float kt[8], e8[8], kc[8];
#pragma unroll
        for (int tt = 0; tt < 8; ++tt) kc[tt] = gla_col(ktt, t8 * 8 + tt, lane);
        CFENCE();
#pragma unroll
        for (int tt = 0; tt < 8; ++tt) { const int t = t8 * 8 + tt; cum += GLA_ROWV(lg, t); e8[tt] = __expf(cum); kt[tt] = kc[tt] * __builtin_amdgcn_rcpf(e8[tt]); }
#pragma unroll
        for (int j = 0; j < 4; ++j) e1p[t8 * 4 + j] = cvt_pk_bf16(e8[2 * j], e8[2 * j + 1]);
        pkk[t8].x = cvt_pk_bf16(kt[0], kt[1]); pkk[t8].y = cvt_pk_bf16(kt[2], kt[3]); pkk[t8].z = cvt_pk_bf16(kt[4], kt[5]); pkk[t8].w = cvt_pk_bf16(kt[6], kt[7]);
    }
    CFENCE();
    gla_st_tile(qtt, t2, lane);
    gla_ld_tile(vp, 512, tv, lane);
    CFENCE();
#pragma unroll
    for (int t8 = 0; t8 < 8; ++t8) {
        float qt[8], qc[8];
#pragma unroll
        for (int tt = 0; tt < 8; ++tt) qc[tt] = gla_col(qtt, t8 * 8 + tt, lane);
        CFENCE();
#pragma unroll
        for (int tt = 0; tt < 8; ++tt) { const int t = t8 * 8 + tt; const unsigned ep = e1p[t >> 1]; qt[tt] = qc[tt] * ((t & 1) ? bfhi(ep) : bflo(ep)) * 0.125f; }
        pkq[t8].x = cvt_pk_bf16(qt[0], qt[1]); pkq[t8].y = cvt_pk_bf16(qt[2], qt[3]); pkq[t8].z = cvt_pk_bf16(qt[4], qt[5]); pkq[t8].w = cvt_pk_bf16(qt[6], qt[7]);
    }
    CFENCE();
#pragma unroll
    for (int t8 = 0; t8 < 8; ++t8) { *(LAS u32x4*)(qtt + lane * GL_TSTR + t8 * 16) = pkq[t8]; *(LAS u32x4*)(ktt + lane * GL_TSTR + t8 * 16) = pkk[t8]; }
    CFENCE();
    u32x2 sc[4][4];
#pragma unroll
    for (int mt = 0; mt < 4; ++mt)
#pragma unroll
        for (int nt = 0; nt < 4; ++nt) {
            if (mt > nt) { sc[mt][nt] = (u32x2){0u, 0u}; continue; }
            f32x4 acc = {0.f, 0.f, 0.f, 0.f};
#pragma unroll
            for (int ks = 0; ks < 2; ++ks) acc = MFMA16(frag_tr(ktt, GL_TSTR, 32 * ks, 16 * mt, lane), frag_tr(qtt, GL_TSTR, 32 * ks, 16 * nt, lane), acc);
            if (mt == nt) {
#pragma unroll
                for (int rg = 0; rg < 4; ++rg) if (4 * fq + rg > fr) acc[rg] = 0.f;
            }
            sc[mt][nt].x = cvt_pk_bf16(acc[0], acc[1]); sc[mt][nt].y = cvt_pk_bf16(acc[2], acc[3]);
        }
    const bf16* st = (const bf16*)(F.dout + DO_ST) + (size_t)wu * 8192;
    f32x4 o[8][4];
#pragma unroll
    for (int hv = 0; hv < 2; ++hv) {
        CFENCE();
        gla_st_tile(ktt, tv, lane);
        CFENCE();
#pragma unroll
        for (int dt = 0; dt < 4; ++dt) {
            const int dvt = hv * 4 + dt;
            bf16x8 sfr[2], vfr[2];
#pragma unroll
            for (int ks = 0; ks < 2; ++ks) { sfr[ks] = *(const bf16x8*)(st + (size_t)(dvt * 16 + fr) * 64 + 32 * ks + 8 * fq); vfr[ks] = frag_tr_perm(ktt, GL_TSTR, 32 * ks, 16 * dt, lane); }
#pragma unroll
            for (int nt = 0; nt < 4; ++nt) {
                f32x4 acc = {0.f, 0.f, 0.f, 0.f};
#pragma unroll
                for (int ks = 0; ks < 2; ++ks) {
                    if (2 * ks <= nt) {
                        const u32x4 bw = {sc[2 * ks][nt].x, sc[2 * ks][nt].y, sc[2 * ks + 1][nt].x, sc[2 * ks + 1][nt].y};
                        acc = MFMA16(vfr[ks], __builtin_bit_cast(bf16x8, bw), acc);
                    }
                    acc = MFMA16(sfr[ks], frag_tr(qtt, GL_TSTR, 32 * ks, 16 * nt, lane), acc);
                }
                o[dvt][nt] = acc;
            }
        }
        if (hv == 0) gla_ld_tile(vp + 64, 512, tv, lane);
    }
    const float* gn = F.in[16] + l * 512 + h * 128;
    const bf16* rp = wsp<bf16>(F, WS_R) + (size_t)row0 * 512 + h * 128;
    bf16* mx = wsp<bf16>(F, WS_MIXED) + (size_t)row0 * D + 512 + h * 128;
    float rs4[4];
#pragma unroll
    for (int nt = 0; nt < 4; ++nt) {
        float ss = 0.f;
#pragma unroll
        for (int dvt = 0; dvt < 8; ++dvt) { const f32x4 x = o[dvt][nt]; ss += (x[0] * x[0] + x[1] * x[1]) + (x[2] * x[2] + x[3] * x[3]); }
        ss += __shfl_xor(ss, 16); ss += __shfl_xor(ss, 32);
        rs4[nt] = rsqrtf(ss * (1.0f / 128.0f) + EPS);
    }
    f32x4 gN = *(const f32x4*)(gn + 4 * fq); u32x2 rN[4];
#pragma unroll
    for (int nt = 0; nt < 4; ++nt) rN[nt] = *(const u32x2*)(rp + (size_t)(16 * nt + fr) * 512 + 4 * fq);
#pragma unroll
    for (int dvt = 0; dvt < 8; ++dvt) {
        const int dv = 16 * dvt + 4 * fq;
        const f32x4 g = gN; u32x2 rc[4];
#pragma unroll
        for (int nt = 0; nt < 4; ++nt) rc[nt] = rN[nt];
        if (dvt < 7) {
            gN = *(const f32x4*)(gn + dv + 16);
#pragma unroll
            for (int nt = 0; nt < 4; ++nt) rN[nt] = *(const u32x2*)(rp + (size_t)(16 * nt + fr) * 512 + dv + 16);
        }
        CFENCE();
#pragma unroll
        for (int nt = 0; nt < 4; ++nt) {
            const int i = 16 * nt + fr; const float rs = rs4[nt]; const u32x2 rr = rc[nt]; const f32x4 x = o[dvt][nt];
            u32x2 w; w.x = cvt_pk_bf16(x[0] * rs * g[0] * siluf_(bflo(rr.x)), x[1] * rs * g[1] * siluf_(bfhi(rr.x))); w.y = cvt_pk_bf16(x[2] * rs * g[2] * siluf_(bflo(rr.y)), x[3] * rs * g[3] * siluf_(bfhi(rr.y)));
            *(u32x2*)(mx + (size_t)i * D + dv) = w;
        }
    }
}
__device__ __forceinline__ void s5_fin_rows(const Frame& F, int l) {
    const int lane = F.lane, gw = F.bid * 8 + F.wave, NGW = F.G * 8;
    const bf16* y = wsp<bf16>(F, WS_UGM); bf16* mx = wsp<bf16>(F, WS_MIXED);
    const float* gn = F.in[13] + l * 512 + lane * 8; const f32x4 g0 = *(const f32x4*)gn, g1 = *(const f32x4*)(gn + 4);
    u32x4 an = {0u, 0u, 0u, 0u};
    if (gw < M) an = *((const u32x4*)(y + (size_t)gw * 512) + lane);
    for (int row = gw; row < M; row += NGW) {
        const u32x4 a = an;
        if (row + NGW < M) an = *((const u32x4*)(y + (size_t)(row + NGW) * 512) + lane);
        CFENCE();
        float v[8] = {bflo(a.x), bfhi(a.x), bflo(a.y), bfhi(a.y), bflo(a.z), bfhi(a.z), bflo(a.w), bfhi(a.w)}; float s = 0.f;
#pragma unroll
        for (int j = 0; j < 8; ++j) s += v[j] * v[j];
        s = wave_sum(s); const float rs = rsqrtf(s * (1.0f / 512.0f) + EPS);
        u32x4 w; w.x = cvt_pk_bf16(v[0] * rs * g0[0], v[1] * rs * g0[1]); w.y = cvt_pk_bf16(v[2] * rs * g0[2], v[3] * rs * g0[3]); w.z = cvt_pk_bf16(v[4] * rs * g1[0], v[5] * rs * g1[1]); w.w = cvt_pk_bf16(v[6] * rs * g1[2], v[7] * rs * g1[3]);
        *((u32x4*)(mx + (size_t)row * D) + lane) = w;
    }
}
__device__ __forceinline__ void moe_router(const Frame& F) {
    const int lane = F.lane, fr = lane & 15, fq = lane >> 4;
    const float* gain = F.in[18] + D; const float* wr_ = F.in[22];
    constexpr int RT_OFF = 16384, RT_STR = 2064;
    {
        const int k0 = 2 * F.tid;
        const f32x2 g2 = *(const f32x2*)(gain + k0);
        const f32x4 wa = *(const f32x4*)(wr_ + k0 * 8), wb = *(const f32x4*)(wr_ + k0 * 8 + 4), wc_ = *(const f32x4*)(wr_ + k0 * 8 + 8), wd = *(const f32x4*)(wr_ + k0 * 8 + 12);
        const float w0[8] = {wa[0], wa[1], wa[2], wa[3], wb[0], wb[1], wb[2], wb[3]}, w1_[8] = {wc_[0], wc_[1], wc_[2], wc_[3], wd[0], wd[1], wd[2], wd[3]};
#pragma unroll
        for (int e = 0; e < 8; ++e) {
            const float a = g2[0] * w0[e], b2 = g2[1] * w1_[e];
            const unsigned ah = f2bf(a), bh = f2bf(b2), al = f2bf(a - bf2f(ah)), bl = f2bf(b2 - bf2f(bh));
            *(LAS unsigned*)(F.lds + RT_OFF + e * RT_STR + k0 * 2) = ah | (bh << 16);
            *(LAS unsigned*)(F.lds + RT_OFF + (8 + e) * RT_STR + k0 * 2) = al | (bl << 16);
        }
    }
    __syncthreads();
    bf16x8 wf[32];
#pragma unroll
    for (int ks = 0; ks < 32; ++ks) wf[ks] = *(const LAS bf16x8*)(F.lds + RT_OFF + fr * RT_STR + (32 * ks + 8 * fq) * 2);
    const bf16* xb = wsp<bf16>(F, WS_XB); int* tok = wsp<int>(F, WS_TOK); float* wl = wsp<float>(F, WS_WL); float* rl = wsp<float>(F, WS_RL);
    unsigned* cnt = wsp<unsigned>(F, WS_CTL) + CW_CNT;
    LAS int* lcnt = (LAS int*)F.lds; LAS int* lbase = lcnt + 16; LAS int* rinfo = lbase + 16; LAS float* rw = (LAS float*)(rinfo + 1024); LAS float* rr = rw + 1024;
    const int rows_per_wg = ((M + F.G - 1) / F.G + 15) & ~15, r0 = F.bid * rows_per_wg, r1 = (r0 + rows_per_wg < M) ? r0 + rows_per_wg : M;
    if (F.tid < 16) lcnt[F.tid] = 0;
    __syncthreads();
    for (int m0 = r0 + 16 * F.wave; m0 < r1; m0 += 128) {
        f32x4 acc = {0.f, 0.f, 0.f, 0.f}; float ss = 0.f;
        const bf16* xr = xb + (size_t)(m0 + fr) * D + 8 * fq;
#pragma unroll
        for (int kg = 0; kg < 4; ++kg) {
            u32x4 a8[8];
#pragma unroll
            for (int kk = 0; kk < 8; ++kk) a8[kk] = *(const u32x4*)(xr + 32 * (8 * kg + kk));
            CFENCE();
#pragma unroll
            for (int kk = 0; kk < 8; ++kk) {
                const u32x4 a = a8[kk];
                const float x0 = bflo(a.x), x1 = bfhi(a.x), x2 = bflo(a.y), x3 = bfhi(a.y), x4 = bflo(a.z), x5 = bfhi(a.z), x6 = bflo(a.w), x7 = bfhi(a.w);
                ss += (x0 * x0 + x1 * x1) + (x2 * x2 + x3 * x3) + (x4 * x4 + x5 * x5) + (x6 * x6 + x7 * x7);
                acc = MFMA16(wf[8 * kg + kk], __builtin_bit_cast(bf16x8, a), acc);
            }
        }
        ss += __shfl_xor(ss, 16); ss += __shfl_xor(ss, 32);
        float lg4[4];
#pragma unroll
        for (int j = 0; j < 4; ++j) lg4[j] = acc[j] + __shfl_xor(acc[j], 32);
        float lg[8];
#pragma unroll
        for (int j = 0; j < 4; ++j) { const float o = __shfl_xor(lg4[j], 16); lg[j] = (fq & 1) ? o : lg4[j]; lg[4 + j] = (fq & 1) ? lg4[j] : o; }
        const float rs = rsqrtf(ss * (1.0f / D) + EPS);
        int e1 = 0; float l1 = lg[0];
#pragma unroll
        for (int e = 1; e < 8; ++e) if (lg[e] > l1) { l1 = lg[e]; e1 = e; }
        int e2 = -1; float l2 = -3.0e38f;
#pragma unroll
        for (int e = 0; e < 8; ++e) if (e != e1 && lg[e] > l2) { l2 = lg[e]; e2 = e; }
        const float w1 = 1.0f / (1.0f + __expf((l2 - l1) * rs));
        if (fq == 0) {
            const int p1 = __hip_atomic_fetch_add(lcnt + e1, 1, __ATOMIC_RELAXED, __HIP_MEMORY_SCOPE_WORKGROUP);
            const int p2 = __hip_atomic_fetch_add(lcnt + 8 + e2, 1, __ATOMIC_RELAXED, __HIP_MEMORY_SCOPE_WORKGROUP);
            const int i = m0 + fr - r0; rinfo[i] = e1 | (e2 << 4) | (p1 << 8) | (p2 << 20); rw[i] = w1; rr[i] = rs;
        }
    }
    __syncthreads();
    if (F.tid < 16) lbase[F.tid] = (int)__hip_atomic_fetch_add(cnt + F.tid, (unsigned)lcnt[F.tid], __ATOMIC_RELAXED, __HIP_MEMORY_SCOPE_AGENT);
    __syncthreads();
    for (int i = F.tid; i < r1 - r0; i += 512) {
        const int inf = rinfo[i], e1 = inf & 15, e2 = (inf >> 4) & 15, p1 = lbase[e1] + ((inf >> 8) & 4095), p2 = lbase[8 + e2] + ((inf >> 20) & 4095);
        const float w1 = rw[i], rs = rr[i];
        tok[e1 * 32768 + p1] = r0 + i; wl[e1 * 32768 + p1] = w1; rl[e1 * 32768 + p1] = rs;
        tok[(8 + e2) * 32768 + p2] = r0 + i; wl[(8 + e2) * 32768 + p2] = 1.0f - w1; rl[(8 + e2) * 32768 + p2] = rs;
    }
    __syncthreads();
}
__device__ __forceinline__ void final_norm(const Frame& F, bool from_xb) {
    const int lane = F.lane, gw = F.bid * 8 + F.wave, NGW = F.G * 8;
    const bf16* xo = from_xb ? wsp<bf16>(F, WS_XB) : wsp<bf16>(F, WS_XO); const float* g = F.in[26]; float* out = (float*)F.dout;
    f32x4 gv[4];
#pragma unroll
    for (int hh = 0; hh < 2; ++hh) { gv[2 * hh] = *(const f32x4*)(g + hh * 512 + lane * 8); gv[2 * hh + 1] = *(const f32x4*)(g + hh * 512 + lane * 8 + 4); }
    u32x4 n0 = {0u, 0u, 0u, 0u}, n1 = n0;
    if (gw < M) { n0 = *((const u32x4*)(xo + (size_t)gw * D) + lane); n1 = *((const u32x4*)(xo + (size_t)gw * D + 512) + lane); }
    for (int m = gw; m < M; m += NGW) {
        const u32x4 a0 = n0, a1 = n1;
        if (m + NGW < M) { n0 = *((const u32x4*)(xo + (size_t)(m + NGW) * D) + lane); n1 = *((const u32x4*)(xo + (size_t)(m + NGW) * D + 512) + lane); }
        CFENCE();
        const float x[16] = {bflo(a0.x), bfhi(a0.x), bflo(a0.y), bfhi(a0.y), bflo(a0.z), bfhi(a0.z), bflo(a0.w), bfhi(a0.w), bflo(a1.x), bfhi(a1.x), bflo(a1.y), bfhi(a1.y), bflo(a1.z), bfhi(a1.z), bflo(a1.w), bfhi(a1.w)};
        float ss = 0.f;
#pragma unroll
        for (int j = 0; j < 16; ++j) ss += x[j] * x[j];
        ss = wave_sum(ss); const float rs = rsqrtf(ss * (1.0f / D) + EPS);
#pragma unroll
        for (int hh = 0; hh < 2; ++hh) {
            const f32x4 g0 = gv[2 * hh], g1 = gv[2 * hh + 1];
            f32x4 o0 = {x[hh * 8 + 0] * rs * g0[0], x[hh * 8 + 1] * rs * g0[1], x[hh * 8 + 2] * rs * g0[2], x[hh * 8 + 3] * rs * g0[3]};
            f32x4 o1 = {x[hh * 8 + 4] * rs * g1[0], x[hh * 8 + 5] * rs * g1[1], x[hh * 8 + 6] * rs * g1[2], x[hh * 8 + 7] * rs * g1[3]};
            *(f32x4*)(out + (size_t)m * D + hh * 512 + lane * 8) = o0; *(f32x4*)(out + (size_t)m * D + hh * 512 + lane * 8 + 4) = o1;
        }
    }
}

__global__ void __launch_bounds__(512, 2) mk_fwd(Args args) {
    extern __shared__ __attribute__((aligned(16))) unsigned char lds_raw[];
    Frame F0;
    F0.lds = (LAS unsigned char*)lds_raw; F0.tid = threadIdx.x; F0.lane = F0.tid & 63; F0.wave = __builtin_amdgcn_readfirstlane(F0.tid >> 6);
    F0.G = gridDim.x; F0.bid = blockIdx.x; F0.in = args.in; F0.ws = args.ws; F0.dout = (unsigned char*)args.out;
    const Frame& F = F0;
    volatile LAS unsigned* MISC = (volatile LAS unsigned*)(F.lds + MISC_OFF);
    for (int u = F.tid; u < (LDS_BYTES - MISC_OFF) / 4; u += 512) MISC[u] = 0u;
    __syncthreads();
#if MK_N_LAUNCHES == 1
    XcdBarrier bar = xcd_barrier_post(wsp<unsigned>(F, WS_CTL) + CW_BAR, MISC);
#define GRID_BAR() xcd_barrier(bar)
#else
#define GRID_BAR() do {} while (0)
#endif
    const int lo = args.ph_lo, hi = args.ph_hi;
#ifndef PH_MASK
#define PH_MASK 0xFFFFFFu
#endif
#define IN(k) ((((PH_MASK) >> ((k) > 7 && (k) < 13 ? (k) - 7 : (k))) & 1u) && lo <= (k) && (k) < hi)
#define SEAM(k) do { if (IN(k) && IN((k) + 1)) GRID_BAR(); } while (0)
    LAS unsigned char* ring = F.lds;
#define xb wsp<bf16>(F, WS_XB)
#define ssp wsp<float>(F, WS_SSP)
#ifndef REP_PHASE
#define REP_PHASE (-1)
#endif
#ifndef REP_N
#define REP_N 0
#endif
#define REPS(k) (((k) == REP_PHASE) ? 1 + REP_N : 1)
#define REP_BEGIN(k) for (int rep = 0; rep < REPS(k); ++rep) {
#define REP_END(k) if (rep + 1 < REPS(k)) GRID_BAR(); }
    if (IN(0)) { REP_BEGIN(0) p0_prologue(launder(F0)); REP_END(0) } SEAM(0);

#pragma unroll 1
    for (int l = 0; l < 2; ++l) {
        const int pb = 1 + 7 * l;
        if (IN(pb)) {
            REP_BEGIN(1)
            const Frame F = launder(F0);
            pg8::ProbPlain P{xb, wsp<bf16>(F, WS_WIN) + (size_t)l * NPROJ * D, D, D, D};
            pg8::StaticOrder S; S.init(M / 256, 8, F.G, F.bid);
            EpiInproj E{ssp, F.ws + WS_ACT};
            pg8::gemm_phase(ring, P, S, E);
            glow_pass(launder(F0), l);
            REP_END(1)
        } SEAM(pb);
        if (IN(pb + 1)) {
            REP_BEGIN(2)
            const Frame F = launder(F0);
#ifndef PROBE_SUB
#define PROBE_SUB 0
#endif
#pragma unroll 1
            for (int pr = 0; pr < (PROBE_SUB == 1 ? 2 : 1); ++pr) for (int un = F.bid; un < 256; un += F.G) s5_unit(F, l, un);
#pragma unroll 1
            for (int pr = 0; pr < (PROBE_SUB == 2 ? 2 : 1); ++pr) for (int wu = F.bid * 8 + F.wave; wu < 2048; wu += F.G * 8) gla_a_unit(F, l, wu);
            REP_END(2)
        } SEAM(pb + 1);
        if (IN(pb + 2)) {
            REP_BEGIN(3)
            const Frame F = launder(F0);
            pg8::ProbPlain P{(const bf16*)(F.dout + DO_YS5), wsp<bf16>(F, WS_WGLU) + (size_t)l * 512 * 512, 512, 512, 512};
            pg8::StaticOrder S; S.init(M / 256, 2, F.G, F.bid);
            EpiGlu E{(const bf16*)(F.dout + DO_YS5), wsp<bf16>(F, WS_UGM), F.in[12] + l * 512};
            pg8::gemm_phase(ring, P, S, E);
#pragma unroll 1
            for (int pr = 0; pr < (PROBE_SUB == 3 ? 2 : 1); ++pr) gla_b_scan(launder(F0));
            REP_END(3)
        } SEAM(pb + 2);
        if (IN(pb + 3)) {
            REP_BEGIN(4)
            const Frame F = launder(F0);
#pragma unroll 1
            for (int pr = 0; pr < (PROBE_SUB == 4 ? 2 : 1); ++pr) for (int wu = F.bid * 8 + F.wave; wu < 2048; wu += F.G * 8) gla_c_unit(F, l, wu);
#pragma unroll 1
            for (int pr = 0; pr < (PROBE_SUB == 5 ? 2 : 1); ++pr) { s5_fin_rows(launder(F0), l); }
            REP_END(4)
        } SEAM(pb + 3);
        if (IN(pb + 4)) {
            REP_BEGIN(5)
            const Frame F = launder(F0);
            pg8::ProbPlain P{wsp<bf16>(F, WS_MIXED), wsp<bf16>(F, WS_WOUT) + (size_t)l * D * D, D, D, D};
            pg8::StaticOrder S; S.init(M / 256, 4, F.G, F.bid);
            const bool want8 = (l == 0) ? (USE_F8_FFN != 0) : (USE_F8_MOE != 0);
            EpiResid E{xb, ssp, rep ? (bf16*)F.dout : xb, rep == 0, (want8 && rep == 0) ? wsp<unsigned char>(F, WS_X8) : nullptr, 1.0f};
            pg8::gemm_phase(ring, P, S, E);
            REP_END(5)
        } SEAM(pb + 4);
        if (l == 0) {
            if (IN(6)) {
                REP_BEGIN(6)
                const Frame F = launder(F0);
                constexpr int KU = USE_F8_FFN ? D / 2 : D;
                pg8::ProbPlainT<USE_F8_FFN != 0> P{USE_F8_FFN ? wsp<bf16>(F, WS_X8) : xb, wsp<bf16>(F, WS_WFGU), KU, KU, KU};
                pg8::StaticOrder S; S.init(M / 256, 2 * DFF / 256, F.G, F.bid);
                EpiSwigluT<USE_F8_FFN != 0, (USE_F8_FFN || USE_F8_FFN_DOWN)> E{ssp, wsp<bf16>(F, WS_HD), DFF};
                pg8::gemm_phase(ring, P, S, E);
                REP_END(6)
            } SEAM(6);
            if (IN(7)) {
                REP_BEGIN(7)
                const Frame F = launder(F0);
                constexpr bool F8D = USE_F8_FFN || USE_F8_FFN_DOWN;
                constexpr int KD = F8D ? DFF / 2 : DFF;
                pg8::ProbPlainT<F8D, true> P{wsp<bf16>(F, WS_HD), wsp<bf16>(F, WS_WFD), KD, KD, KD};
                pg8::StaticOrder S; S.init(M / 256, 4, F.G, F.bid);
                EpiResid E{xb, ssp, rep ? (bf16*)F.dout : xb, rep == 0, nullptr, F8D ? 1.0f / (F8_SH * F8_SW_DN) : 1.0f};
                pg8::gemm_phase(ring, P, S, E);
                REP_END(7)
            } SEAM(7);
        }
    }
    if (IN(13)) { moe_router(launder(F0)); } SEAM(13);
#pragma unroll 1
    for (int s = 0; s < 5; ++s) {
        if (IN(14 + s)) {
            const Frame F = launder(F0);
            if (s == 0 || lo == 14 + s) moe_build_tables(F);
            const MoeTab T = moe_tab(F);
            int nheavy = 0;
            if (s >= 1) {
                REP_BEGIN(15)
                constexpr int KD = DFE * MOE_ESZ / 2;
                ProbMoeDown P{((s - 1) & 1) ? (void*)wsp<bf16>(F, WS_H1) : (void*)F.dout, wsp<bf16>(F, WS_MD), KD, KD, KD};
                MoeOrder S; S.init(T, s - 1, 4, F.G, F.bid, 0, 0);
                nheavy = S.nheavy_next();
                EpiMoeDown E{wsp<int>(F, WS_TOK), wsp<float>(F, WS_WL), xb, wsp<bf16>(F, WS_XO), T, rep != 0};
                pg8::gemm_phase(ring, P, S, E);
                REP_END(15)
            }
            if (s < 4) {
                REP_BEGIN(14)
                constexpr int KU = D * MOE_ESZ / 2;
                ProbMoeUp P{USE_F8_MOE ? (const void*)wsp<unsigned char>(F, WS_X8) : (const void*)xb, wsp<bf16>(F, WS_MGU), wsp<int>(F, WS_TOK), T, KU, KU, KU};
                MoeOrder S; S.init(T, s, 2 * DFE / 256, F.G, F.bid, nheavy, 3);
                EpiSwigluMoe E{wsp<float>(F, WS_RL), (s & 1) ? (void*)wsp<bf16>(F, WS_H1) : (void*)F.dout, T};
                pg8::gemm_phase(ring, P, S, E);
                REP_END(14)
            }
        } SEAM(14 + s);
    }
    if (IN(19)) { REP_BEGIN(19) final_norm(launder(F0), hi > 50); REP_END(19) }
#undef xb
#undef ssp
#undef IN
#undef SEAM
}

extern "C" void kernel_launch(void* const* d_in, const int* in_sizes, int n_in, void* d_out, int out_size, void* d_ws, size_t ws_size, hipStream_t stream) {
    static int grid = 0;
    if (grid == 0) {
        if (n_in != 27 || in_sizes[0] != M * D || out_size != M * D || ws_size < WS_END) { fprintf(stderr, "kernel_launch: unexpected shapes (n_in %d, ws %zu < %zu?)\n", n_in, ws_size, (size_t)WS_END); grid = -1; return; }
        int dev = 0, cus = 0, per_cu = 0;
        if (hipGetDevice(&dev) != hipSuccess || hipDeviceGetAttribute(&cus, hipDeviceAttributeMultiprocessorCount, dev) != hipSuccess) { grid = -1; return; }
        if (hipFuncSetAttribute((const void*)mk_fwd, hipFuncAttributeMaxDynamicSharedMemorySize, LDS_BYTES) != hipSuccess) { fprintf(stderr, "kernel_launch: hipFuncSetAttribute failed\n"); grid = -1; return; }
        if (hipOccupancyMaxActiveBlocksPerMultiprocessor(&per_cu, (const void*)mk_fwd, 512, LDS_BYTES) != hipSuccess || per_cu < 1) fprintf(stderr, "kernel_launch: occupancy query says %d\n", per_cu);
        (void)hipGetLastError();
        grid = cus;
    }
    if (grid < 0) return;
    if (hipMemsetAsync((char*)d_ws + WS_CTL, 0, CTL_ZERO_BYTES, stream) != hipSuccess) return;
    Args a{};
    for (int i = 0; i < 27; ++i) a.in[i] = (const float*)d_in[i];
    a.out = (float*)d_out; a.ws = (unsigned char*)d_ws;
#if MK_N_LAUNCHES == 1
#ifdef PROBE_PREFIX
    a.ph_lo = 0; a.ph_hi = PROBE_PREFIX + 1;
    hipLaunchKernelGGL(mk_fwd, dim3(grid), dim3(512), LDS_BYTES, stream, a);
    if (hipMemsetAsync((char*)d_ws + WS_CTL, 0, CTL_ZERO_BYTES, stream) != hipSuccess) return;
#endif
    a.ph_lo = 0; a.ph_hi = NPHASE;
    hipLaunchKernelGGL(mk_fwd, dim3(grid), dim3(512), LDS_BYTES, stream, a);
#else
#ifdef EXP_STOP
    for (int p = 0; p <= EXP_STOP; ++p) { a.ph_lo = p; a.ph_hi = p + 1; hipLaunchKernelGGL(mk_fwd, dim3(grid), dim3(512), LDS_BYTES, stream, a); }
    a.ph_lo = 19; a.ph_hi = 100; hipLaunchKernelGGL(mk_fwd, dim3(grid), dim3(512), LDS_BYTES, stream, a);
#else
    for (int p = 0; p < NPHASE; ++p) { a.ph_lo = p; a.ph_hi = p + 1; hipLaunchKernelGGL(mk_fwd, dim3(grid), dim3(512), LDS_BYTES, stream, a); }
#endif
#endif
}
```
